# Optimizing an MI355X kernel written in HIP

```python
import math
import jax, jax.numpy as jnp
from jax import lax
import numpy as np

D_MODEL = 1024
BATCH = 16
SEQ = 2048
DEPTH = 2
DEC_BATCH = 16
DEC_SEQ = 64
PAST_LEN = 4096

CHUNK = 64
N_A = DEPTH // 2
N_B = DEPTH - N_A
EPS = 1e-6
D_INNER = 2 * D_MODEL
SSM_HEAD_DIM = 64
SSM_HEADS = D_INNER // SSM_HEAD_DIM
SSM_GROUPS = 4
HEADS_PER_GROUP = SSM_HEADS // SSM_GROUPS
SSM_STATE = 128
CONV_W = 4
CONV_DIM = D_INNER + 2 * SSM_GROUPS * SSM_STATE
IN_PROJ = D_INNER + CONV_DIM + SSM_HEADS
ATT_HEAD_DIM = 64
ATT_HEADS = D_MODEL // ATT_HEAD_DIM
ATT_DIM = ATT_HEADS * ATT_HEAD_DIM
BAND_CHUNKS = 8
BAND_PAST = BAND_CHUNKS * CHUNK
REL_CLIP = 256
FFN_HIDDEN = ((8 * D_MODEL + 3 * 256 - 1) // (3 * 256)) * 256

kernel_name = 'hybrid_ssd_chunkband_stream_step'


def rmsnorm(x, w):
    xf = x.astype(jnp.float32)
    y = xf * lax.rsqrt(jnp.mean(xf * xf, axis=-1, keepdims=True) + EPS)
    return (y * w.astype(jnp.float32)).astype(x.dtype)


def swiglu(u, w_in, w_out):
    g, up = jnp.split(u @ w_in, 2, axis=-1)
    return (jax.nn.silu(g) * up) @ w_out


def ssd_scan(x, dt, A, Bm, Cm, h0):
    b, L = x.shape[:2]
    Q = CHUNK if L % CHUNK == 0 else L
    nc = L // Q
    G, J, P, N = SSM_GROUPS, HEADS_PER_GROUP, SSM_HEAD_DIM, SSM_STATE
    xd = (x * dt[..., None]).reshape(b, nc, Q, G, J, P)
    Bc = Bm.reshape(b, nc, Q, G, N)
    Cc = Cm.reshape(b, nc, Q, G, N)
    dA = jnp.moveaxis((dt * A).reshape(b, nc, Q, G, J), 2, -1)
    Acs = jnp.cumsum(dA, axis=-1)
    causal = jnp.tril(jnp.ones((Q, Q), dtype=bool))
    Lm = jnp.exp(jnp.where(causal, Acs[..., :, None] - Acs[..., None, :], -jnp.inf))
    CB = jnp.einsum('bcqgn,bcsgn->bcgqs', Cc, Bc)
    y_diag = jnp.einsum('bcgjqs,bcsgjp->bcqgjp', CB[:, :, :, None] * Lm, xd)
    decay_to_end = jnp.moveaxis(jnp.exp(Acs[..., -1:] - Acs), -1, 2)
    chunk_states = jnp.einsum('bcsgn,bcsgjp->cbgjpn', Bc, xd * decay_to_end[..., None])
    chunk_decay = jnp.moveaxis(jnp.exp(Acs[..., -1]), 1, 0)

    def step(h, inp):
        s, d = inp
        return h * d[..., None, None] + s, h

    h_final, h_prev = lax.scan(step, h0.reshape(b, G, J, P, N), (chunk_states, chunk_decay))
    y_off = jnp.einsum('bcqgn,cbgjpn->bcqgjp', Cc, h_prev) * jnp.moveaxis(jnp.exp(Acs), -1, 2)[..., None]
    y = (y_diag + y_off).reshape(b, L, SSM_HEADS, P)
    return y, h_final.reshape(b, SSM_HEADS, P, N)


def ssd_mixer(u, h0, conv_prev, w_in, conv_w, conv_b, dt_bias, A_log, D_skip, gnorm_w, w_out):
    b, L, _ = u.shape
    zxbcdt = u @ w_in
    z = zxbcdt[..., :D_INNER]
    xbc = zxbcdt[..., D_INNER:D_INNER + CONV_DIM]
    dt_raw = zxbcdt[..., D_INNER + CONV_DIM:]
    padded = jnp.concatenate([conv_prev.astype(xbc.dtype), xbc], axis=1)
    conv = conv_b
    for k in range(CONV_W):
        conv = conv + padded[:, k:k + L] * conv_w[k]
    new_conv = padded[:, L:]
    xbc = jax.nn.silu(conv).astype(jnp.float32)
    xs = xbc[..., :D_INNER].reshape(b, L, SSM_HEADS, SSM_HEAD_DIM)
    Bm = xbc[..., D_INNER:D_INNER + SSM_GROUPS * SSM_STATE].reshape(b, L, SSM_GROUPS, SSM_STATE)
    Cm = xbc[..., D_INNER + SSM_GROUPS * SSM_STATE:].reshape(b, L, SSM_GROUPS, SSM_STATE)
    dt = jax.nn.softplus(dt_raw.astype(jnp.float32) + dt_bias.astype(jnp.float32))
    A = -jnp.exp(A_log.astype(jnp.float32))
    y, h_final = ssd_scan(xs, dt, A, Bm, Cm, h0.astype(jnp.float32))
    y = y + xs * D_skip.astype(jnp.float32)[:, None]
    y = y.reshape(b, L, D_INNER) * jax.nn.silu(z.astype(jnp.float32))
    yg = y.reshape(b, L, SSM_GROUPS, D_INNER // SSM_GROUPS)
    yg = yg * lax.rsqrt(jnp.mean(yg * yg, axis=-1, keepdims=True) + EPS)
    y = (yg.reshape(b, L, D_INNER) * gnorm_w.astype(jnp.float32)).astype(u.dtype)
    return y @ w_out, h_final.astype(u.dtype), new_conv


def shared_kv(x, kv_norm_w, w_kv):
    b, L, _ = x.shape
    kv = (rmsnorm(x, kv_norm_w) @ w_kv).reshape(b, L, 2, ATT_HEADS, ATT_HEAD_DIM)
    return kv[:, :, 0], kv[:, :, 1]


def band_attend(q, k, v, qpos, kpos, rel_bias):
    dist = jnp.clip(qpos[:, None] - kpos[None, :], -REL_CLIP, REL_CLIP) + REL_CLIP
    bias = rel_bias[:, dist].astype(jnp.float32)
    qc = qpos // CHUNK
    kc = kpos // CHUNK
    valid = (kpos[None, :] >= 0) & (kc[None, :] <= qc[:, None]) & (kc[None, :] >= qc[:, None] - BAND_CHUNKS)
    s = jnp.einsum('bqhd,bkhd->bhqk', q, k).astype(jnp.float32) * (ATT_HEAD_DIM ** -0.5) + bias
    s = jnp.where(valid, s, -jnp.inf)
    p = jax.nn.softmax(s, axis=-1).astype(v.dtype)
    return jnp.einsum('bhqk,bkhd->bqhd', p, v)


def prompt_band_attention(q, k, v, rel_bias):
    b, L = q.shape[:2]
    nc = L // CHUNK
    band = BAND_PAST + CHUNK
    pad = jnp.zeros((b, BAND_PAST, ATT_HEADS, ATT_HEAD_DIM), k.dtype)
    kp = jnp.concatenate([pad, k], axis=1)
    vp = jnp.concatenate([pad, v], axis=1)

    def one_chunk(c):
        start = c * CHUNK
        qc = lax.dynamic_slice_in_dim(q, start, CHUNK, axis=1)
        kc = lax.dynamic_slice_in_dim(kp, start, band, axis=1)
        vc = lax.dynamic_slice_in_dim(vp, start, band, axis=1)
        qpos = start + jnp.arange(CHUNK)
        kpos = start - BAND_PAST + jnp.arange(band)
        return band_attend(qc, kc, vc, qpos, kpos, rel_bias)

    out = lax.map(one_chunk, jnp.arange(nc))
    return jnp.moveaxis(out, 0, 1).reshape(b, L, ATT_DIM)


def sample_band_attention(q, k_new, v_new, k_cache, v_cache, rel_bias):
    b, L = q.shape[:2]
    R = k_cache.shape[1]
    k = jnp.concatenate([k_cache.astype(k_new.dtype), k_new], axis=1)
    v = jnp.concatenate([v_cache.astype(v_new.dtype), v_new], axis=1)
    qpos = PAST_LEN + jnp.arange(L)
    kpos = jnp.concatenate([PAST_LEN - R + jnp.arange(R), PAST_LEN + jnp.arange(L)])
    return band_attend(q, k, v, qpos, kpos, rel_bias).reshape(b, L, ATT_DIM)


def setup_inputs(seed: int = 0) -> dict:
    key = jax.random.key(seed)
    ks = jax.random.split(key, 24)
    f32 = jnp.float32

    def nrm(k, shape, scale):
        return scale * jax.random.normal(k, shape, f32)

    cache_rows = min(BAND_PAST, PAST_LEN)
    dt0 = jnp.exp(jax.random.uniform(ks[10], (N_A, SSM_HEADS), f32, math.log(1e-3), math.log(1e-1)))
    dt_bias = dt0 + jnp.log(-jnp.expm1(-dt0))
    A_log = jnp.log(jax.random.uniform(ks[11], (N_A, SSM_HEADS), f32, 1.0, 16.0))
    return {
        'x_prompt': nrm(ks[0], (BATCH, SEQ, D_MODEL), 1.0),
        'x_sample': nrm(ks[1], (DEC_BATCH, DEC_SEQ, D_MODEL), 1.0),
        'state_ssm': nrm(ks[2], (N_A, DEC_BATCH, SSM_HEADS, SSM_HEAD_DIM, SSM_STATE), 0.5),
        'state_conv': nrm(ks[3], (N_A, DEC_BATCH, CONV_W - 1, CONV_DIM), 1.0),
        'cache_k': nrm(ks[4], (DEC_BATCH, cache_rows, ATT_HEADS, ATT_HEAD_DIM), 1.0),
        'cache_v': nrm(ks[5], (DEC_BATCH, cache_rows, ATT_HEADS, ATT_HEAD_DIM), 1.0),
        'norm_w': 1.0 + nrm(ks[6], (DEPTH, 4, D_MODEL), 0.05),
        'ssm_w_in': nrm(ks[7], (N_A, D_MODEL, IN_PROJ), D_MODEL ** -0.5),
        'ssm_conv_w': nrm(ks[8], (N_A, CONV_W, CONV_DIM), CONV_W ** -0.5),
        'ssm_conv_b': nrm(ks[9], (N_A, CONV_DIM), 0.02),
        'ssm_dt_bias': dt_bias,
        'ssm_A_log': A_log,
        'ssm_D': 1.0 + nrm(ks[12], (N_A, SSM_HEADS), 0.1),
        'ssm_norm_w': 1.0 + nrm(ks[13], (N_A, D_INNER), 0.05),
        'ssm_w_out': nrm(ks[14], (N_A, D_INNER, D_MODEL), D_INNER ** -0.5),
        'kv_norm_w': 1.0 + nrm(ks[15], (D_MODEL,), 0.05),
        'w_kv': nrm(ks[16], (D_MODEL, 2 * ATT_DIM), D_MODEL ** -0.5),
        'attn_w_q': nrm(ks[17], (N_B, D_MODEL, ATT_DIM), D_MODEL ** -0.5),
        'attn_rel_bias': nrm(ks[18], (N_B, ATT_HEADS, 2 * REL_CLIP + 1), 0.3),
        'attn_w_o': nrm(ks[19], (N_B, ATT_DIM, D_MODEL), ATT_DIM ** -0.5),
        'ffn_w_in': nrm(ks[20], (DEPTH, D_MODEL, 2 * FFN_HIDDEN), D_MODEL ** -0.5),
        'ffn_w_out': nrm(ks[21], (DEPTH, FFN_HIDDEN, D_MODEL), FFN_HIDDEN ** -0.5),
    }


def reference(x_prompt, x_sample, state_ssm, state_conv, cache_k, cache_v, norm_w,
              ssm_w_in, ssm_conv_w, ssm_conv_b, ssm_dt_bias, ssm_A_log, ssm_D, ssm_norm_w, ssm_w_out,
              kv_norm_w, w_kv, attn_w_q, attn_rel_bias, attn_w_o, ffn_w_in, ffn_w_out):
    xp, xs = x_prompt, x_sample
    bp, bs = xp.shape[0], xs.shape[0]
    ssm_p, conv_p, ssm_s, conv_s = [], [], [], []
    kp = vp = ks = vs = None
    for layer in range(DEPTH):
        nw = norm_w[layer]
        if layer < N_A:
            a = layer
            params = (ssm_w_in[a], ssm_conv_w[a], ssm_conv_b[a], ssm_dt_bias[a], ssm_A_log[a],
                      ssm_D[a], ssm_norm_w[a], ssm_w_out[a])
            h0 = jnp.zeros((bp, SSM_HEADS, SSM_HEAD_DIM, SSM_STATE), jnp.float32)
            c0 = jnp.zeros((bp, CONV_W - 1, CONV_DIM), xp.dtype)
            mp, hp_new, cp_new = ssd_mixer(rmsnorm(xp, nw[0]), h0, c0, *params)
            ms, hs_new, cs_new = ssd_mixer(rmsnorm(xs, nw[0]), state_ssm[a], state_conv[a], *params)
            ssm_p.append(hp_new)
            conv_p.append(cp_new)
            ssm_s.append(hs_new)
            conv_s.append(cs_new)
        else:
            if layer == N_A:
                kp, vp = shared_kv(xp, kv_norm_w, w_kv)
                ks, vs = shared_kv(xs, kv_norm_w, w_kv)
            i = layer - N_A
            qp = (rmsnorm(xp, nw[0]) @ attn_w_q[i]).reshape(bp, -1, ATT_HEADS, ATT_HEAD_DIM)
            qs = (rmsnorm(xs, nw[0]) @ attn_w_q[i]).reshape(bs, -1, ATT_HEADS, ATT_HEAD_DIM)
            mp = prompt_band_attention(qp, kp, vp, attn_rel_bias[i]) @ attn_w_o[i]
            ms = sample_band_attention(qs, ks, vs, cache_k, cache_v, attn_rel_bias[i]) @ attn_w_o[i]
        xp = xp + rmsnorm(mp, nw[1])
        xs = xs + rmsnorm(ms, nw[1])
        xp = xp + rmsnorm(swiglu(rmsnorm(xp, nw[2]), ffn_w_in[layer], ffn_w_out[layer]), nw[3])
        xs = xs + rmsnorm(swiglu(rmsnorm(xs, nw[2]), ffn_w_in[layer], ffn_w_out[layer]), nw[3])
    rows_p = min(BAND_PAST, xp.shape[1])
    return (xp, xs, jnp.stack(ssm_p), jnp.stack(conv_p), kp[:, -rows_p:], vp[:, -rows_p:],
            jnp.stack(ssm_s), jnp.stack(conv_s), ks, vs)
```

```cpp
#include <hip/hip_runtime.h>
#include <hip/hip_cooperative_groups.h>
#include <cstdio>
#include <cstdint>
namespace cg = cooperative_groups;

namespace pg8 {
#define PG8_LAS __attribute__((address_space(3)))
typedef unsigned short bf16_t;
typedef short bf16x8 __attribute__((ext_vector_type(8)));
typedef float f32x4 __attribute__((ext_vector_type(4)));
typedef unsigned u32x4 __attribute__((ext_vector_type(4)));
constexpr int BM = 256, BK = 64, HALF = 128, HTB = HALF * BK * 2, STAGE_BYTES = 8 * HTB, NXCD = 8, WGM = 8;

__host__ __device__ __forceinline__ int lds_byte(int r, int c) { const int st = (r >> 4) * 2 + (c >> 5), rr = r & 15, cc = c & 31, ob = rr * 64 + cc * 2; return st * 1024 + (ob ^ (((ob >> 9) & 1) << 5)); }
__host__ __device__ __forceinline__ void stage_rc(int b, int& R, int& C) { const int st = b / 1024, sb = b % 1024, swz = sb ^ (((sb >> 9) & 1) << 5); R = (st >> 1) * 16 + swz / 64; C = (st & 1) * 32 + (swz % 64) / 2; }
__host__ __device__ __forceinline__ int perm32(int rho) { const int n = rho >> 4, i = rho & 15; return 8 * (i >> 2) + 4 * n + (i & 3); }

struct Unit { int pm, pn; };
struct Gemm { const bf16_t* A; const bf16_t* Bt; int M, N, K; };

struct StaticOrder {
    int nM, nN, nwg, G, c;
    __host__ __device__ void init(int M, int N, int G_, int c_) { nM = M / BM; nN = N / BM; nwg = nM * nN; G = G_; c = c_; }
    __host__ __device__ bool next(int i, Unit& u) const {
        const long L = (long)i * G + c; if (L >= nwg) return false;
        int wgid = (int)L; { const int q = nwg / NXCD, r = nwg % NXCD, xcd = wgid % NXCD, off = wgid / NXCD; wgid = (xcd < r ? xcd * (q + 1) : r * (q + 1) + (xcd - r) * q) + off; }
        const int nig = WGM * nN, gid = wgid / nig, fm = gid * WGM, gsz = (nM - fm) < WGM ? (nM - fm) : WGM;
        u.pm = fm + ((wgid % nig) % gsz); u.pn = (wgid % nig) / gsz; return true;
    }
    __device__ __forceinline__ void a_ready(const Unit&) const {}
    __device__ __forceinline__ void done(const Unit&) const {}
};

template <class Epi, class Sched, bool ALIGN_EPI = false, bool SP2 = false>
__device__ __forceinline__ void gemm_phase(PG8_LAS unsigned char* lds, const Gemm g, const Sched& S, const Epi& E) {
    int tid_ = threadIdx.x; asm volatile("" : "+v"(tid_));
    const int tid = tid_, wid = __builtin_amdgcn_readfirstlane(tid >> 6), lane = tid & 63, wr = wid >> 2, wc = wid & 3, fr = lane & 15, fq = lane >> 4;
    const int K = g.K, nt = K / BK;
    unsigned voffA[2], voffB[2];
#pragma unroll
    for (int i = 0; i < 2; ++i) { int R, C; stage_rc(tid * 16 + i * 8192, R, C); const int Rb = Epi::PERM ? ((R & ~31) + perm32(R & 31)) : R;
        voffA[i] = (unsigned)(R * K + C) * 2u; voffB[i] = (unsigned)(Rb * K + C) * 2u; }
    const size_t kstep = (size_t)(BK * 2);
    const size_t hstep = (size_t)HALF * K * 2;
    const size_t tstep = 2 * hstep;
    const unsigned ldsw = (unsigned)wid * 1024u;
    const int aoff = lds_byte(wr * 64 + fr, fq * 8), boff = lds_byte(wc * 32 + fr, fq * 8);
#define PG8_SA(b, h) (((b) * 2 + (h)) * HTB)
#define PG8_SB(b, h) ((4 + (b) * 2 + (h)) * HTB)
#define PG8_STAGE(bufoff, gbase, voff) do { _Pragma("unroll") for (int _i = 0; _i < 2; ++_i) \
        __builtin_amdgcn_global_load_lds((const unsigned*)((const char*)(gbase) + (voff)[_i]), (PG8_LAS unsigned*)(lds + (bufoff) + ldsw + _i * 8192), 16, 0, 0); } while (0)
#define PG8_LDA(dst, b, h) do { _Pragma("unroll") for (int m = 0; m < 4; ++m) _Pragma("unroll") for (int k = 0; k < 2; ++k) dst[m][k] = *(const PG8_LAS bf16x8*)(lds + PG8_SA(b, h) + aoff + m * 2048 + k * 1024); } while (0)
#define PG8_LDB(dst, b, h) do { _Pragma("unroll") for (int n = 0; n < 2; ++n) _Pragma("unroll") for (int k = 0; k < 2; ++k) dst[n][k] = *(const PG8_LAS bf16x8*)(lds + PG8_SB(b, h) + boff + n * 2048 + k * 1024); } while (0)
#define PG8_MMA(ai, bj, At, Bt) do { __builtin_amdgcn_s_setprio(1); _Pragma("unroll") for (int m = 0; m < 4; ++m) _Pragma("unroll") for (int n = 0; n < 2; ++n) _Pragma("unroll") for (int k = 0; k < 2; ++k) \
        acc[ai][bj][m][n] = __builtin_amdgcn_mfma_f32_16x16x32_bf16(Bt[n][k], At[m][k], acc[ai][bj][m][n], 0, 0, 0); __builtin_amdgcn_s_setprio(0); } while (0)
#define PG8_WAIT_V(n) asm volatile("s_waitcnt vmcnt(" #n ")" ::: "memory")
#define PG8_WAIT_L(n) asm volatile("s_waitcnt lgkmcnt(" #n ")" ::: "memory")
#define PG8_BAR __builtin_amdgcn_s_barrier()
#define PG8_SCHED __builtin_amdgcn_sched_barrier(0)
    Unit cur, nxt; int ui = 0;
    if (!S.next(0, cur)) return;
    f32x4 acc[2][2][4][2];
#pragma unroll
    for (int a = 0; a < 2; ++a)
#pragma unroll
        for (int b = 0; b < 2; ++b)
#pragma unroll
            for (int m = 0; m < 4; ++m)
#pragma unroll
                for (int n = 0; n < 2; ++n) acc[a][b][m][n] = (f32x4){0.f, 0.f, 0.f, 0.f};
    bf16x8 At[4][2], B0[2][2], B1[2][2];
    const char* cA = (const char*)g.A + (size_t)cur.pm * tstep; const char* cB = (const char*)g.Bt + (size_t)cur.pn * tstep;
    S.a_ready(cur);
    if constexpr (SP2) {
        PG8_STAGE(PG8_SB(0, 0), cB, voffB); PG8_STAGE(PG8_SB(0, 1), cB + hstep, voffB); PG8_STAGE(PG8_SA(0, 0), cA, voffA); PG8_STAGE(PG8_SA(0, 1), cA + hstep, voffA);
        if (wr == 1) PG8_BAR;
        PG8_WAIT_V(2); PG8_BAR;
        PG8_STAGE(PG8_SB(1, 0), cB + kstep, voffB); PG8_STAGE(PG8_SA(1, 0), cA + kstep, voffA); PG8_STAGE(PG8_SB(1, 1), cB + hstep + kstep, voffB);
        PG8_WAIT_V(6); PG8_BAR;
    } else {
        PG8_STAGE(PG8_SB(0, 0), cB, voffB); PG8_STAGE(PG8_SA(0, 0), cA, voffA); PG8_STAGE(PG8_SB(0, 1), cB + hstep, voffB); PG8_STAGE(PG8_SA(0, 1), cA + hstep, voffA);
        if (wr == 1) PG8_BAR;
        PG8_WAIT_V(4); PG8_BAR;
        PG8_STAGE(PG8_SB(1, 0), cB + kstep, voffB); PG8_STAGE(PG8_SA(1, 0), cA + kstep, voffA); PG8_STAGE(PG8_SB(1, 1), cB + hstep + kstep, voffB);
        PG8_WAIT_V(6); PG8_BAR;
    }
    for (;;) {
        const bool has_next = S.next(ui + 1, nxt);
        const char* nA = has_next ? (const char*)g.A + (size_t)nxt.pm * tstep : cA; const char* nB = has_next ? (const char*)g.Bt + (size_t)nxt.pn * tstep : cB;
        for (int t = 0; t < nt; t += 2) {
            const bool last = (t == nt - 2);
            const char* a1 = cA + (size_t)(t + 1) * kstep;
            const char* a2 = last ? nA : cA + (size_t)(t + 2) * kstep; const char* b2 = last ? nB : cB + (size_t)(t + 2) * kstep;
            const char* a3 = a2 + kstep; const char* b3 = b2 + kstep;
            if (last && has_next) S.a_ready(nxt);
            if constexpr (SP2) {
            PG8_LDB(B0, 0, 0); PG8_LDB(B1, 0, 1); PG8_SCHED; PG8_LDA(At, 0, 0); PG8_STAGE(PG8_SA(1, 1), a1 + hstep, voffA);
            PG8_WAIT_V(8); PG8_WAIT_L(0); PG8_BAR; PG8_MMA(0, 0, At, B0); PG8_MMA(0, 1, At, B1); PG8_BAR; PG8_SCHED;
            PG8_LDA(At, 0, 1); PG8_STAGE(PG8_SB(0, 0), b2, voffB); PG8_STAGE(PG8_SB(0, 1), b2 + hstep, voffB); PG8_STAGE(PG8_SA(0, 0), a2, voffA);
            PG8_WAIT_V(8); PG8_WAIT_L(0); PG8_BAR; PG8_MMA(1, 0, At, B0); PG8_MMA(1, 1, At, B1); PG8_BAR; PG8_SCHED;
            PG8_LDB(B0, 1, 0); PG8_LDB(B1, 1, 1); PG8_SCHED; PG8_LDA(At, 1, 0); PG8_STAGE(PG8_SA(0, 1), a2 + hstep, voffA);
            PG8_WAIT_V(8); PG8_WAIT_L(0); PG8_BAR; PG8_MMA(0, 0, At, B0); PG8_MMA(0, 1, At, B1); PG8_BAR; PG8_SCHED;
            PG8_LDA(At, 1, 1); PG8_STAGE(PG8_SB(1, 0), b3, voffB); PG8_STAGE(PG8_SB(1, 1), b3 + hstep, voffB); PG8_STAGE(PG8_SA(1, 0), a3, voffA);
            PG8_WAIT_V(8); PG8_WAIT_L(0); PG8_BAR; PG8_MMA(1, 0, At, B0); PG8_MMA(1, 1, At, B1); PG8_BAR; PG8_SCHED;
            } else {
            PG8_LDB(B0, 0, 0); PG8_SCHED; PG8_LDA(At, 0, 0); PG8_STAGE(PG8_SA(1, 1), a1 + hstep, voffA);
            PG8_WAIT_L(8); PG8_BAR; PG8_WAIT_L(0); PG8_MMA(0, 0, At, B0); PG8_BAR; PG8_SCHED;
            PG8_LDB(B1, 0, 1); PG8_STAGE(PG8_SB(0, 0), b2, voffB);
            PG8_BAR; PG8_WAIT_L(0); PG8_MMA(0, 1, At, B1); PG8_BAR;
            PG8_LDA(At, 0, 1); PG8_STAGE(PG8_SA(0, 0), a2, voffA);
            PG8_BAR; PG8_WAIT_L(0); PG8_MMA(1, 0, At, B0); PG8_BAR; PG8_SCHED;
            PG8_STAGE(PG8_SB(0, 1), b2 + hstep, voffB);
            PG8_WAIT_V(6); PG8_BAR; PG8_MMA(1, 1, At, B1); PG8_BAR;
            PG8_LDB(B0, 1, 0); PG8_SCHED; PG8_LDA(At, 1, 0); PG8_STAGE(PG8_SA(0, 1), a2 + hstep, voffA);
            PG8_WAIT_L(8); PG8_BAR; PG8_WAIT_L(0); PG8_MMA(0, 0, At, B0); PG8_BAR; PG8_SCHED;
            PG8_LDB(B1, 1, 1); PG8_STAGE(PG8_SB(1, 0), b3, voffB);
            PG8_BAR; PG8_WAIT_L(0); PG8_MMA(0, 1, At, B1); PG8_BAR;
            PG8_LDA(At, 1, 1); PG8_STAGE(PG8_SA(1, 0), a3, voffA);
            PG8_BAR; PG8_WAIT_L(0); PG8_MMA(1, 0, At, B0); PG8_BAR; PG8_SCHED;
            PG8_STAGE(PG8_SB(1, 1), b3 + hstep, voffB);
            PG8_WAIT_V(6); PG8_BAR; PG8_MMA(1, 1, At, B1); PG8_BAR;
            }
        }
        if constexpr (ALIGN_EPI) { if (wr == 0) PG8_BAR; }
        E(acc, cur, wr, wc, fr, fq); S.done(cur);
        if (!has_next) break;
#pragma unroll
        for (int a = 0; a < 2; ++a)
#pragma unroll
            for (int b = 0; b < 2; ++b)
#pragma unroll
                for (int m = 0; m < 4; ++m)
#pragma unroll
                    for (int n = 0; n < 2; ++n) acc[a][b][m][n] = (f32x4){0.f, 0.f, 0.f, 0.f};
        cur = nxt; cA = nA; cB = nB; ++ui;
        if constexpr (ALIGN_EPI) { if (wr == 1) PG8_BAR; }
    }
    PG8_WAIT_V(0);
    if constexpr (!ALIGN_EPI) { if (wr == 0) PG8_BAR; }
    PG8_BAR;
#undef PG8_SA
#undef PG8_SB
#undef PG8_STAGE
#undef PG8_LDA
#undef PG8_LDB
#undef PG8_MMA
#undef PG8_WAIT_V
#undef PG8_WAIT_L
#undef PG8_BAR
#undef PG8_SCHED
}
}

constexpr int NTHREADS = 512, NWAVES = 8;
constexpr int LDS_BYTES = 147456;
constexpr int DM = 1024, TP = 32768, TS = 1024, TT = TP + TS;
constexpr int DI = 2048, NH = 32, HD = 64, NG = 4, NS = 128, CONVD = 3072, INPROJ = 5152, INPROJ_PAD = 5376;
constexpr int FF = 2816, FF2 = 5632;
constexpr int AH = 16;
constexpr float EPS = 1e-6f;
constexpr size_t O_Y = 0, O_SSM_P = 34603008, O_CONV_P = 38797312, O_CK_P = 38944768, O_CV_P = 47333376,
                 O_SSM_S = 55721984, O_CONV_S = 59916288, O_CK_S = 60063744, O_CV_S = 61112320, O_TOTAL = 62160896;
constexpr size_t MiB = 1u << 20;
constexpr size_t WS_CTL = 0;
constexpr size_t WS_WIN = 2 * MiB;
constexpr size_t WS_WOUT = WS_WIN + (size_t)INPROJ_PAD * DM * 2;
constexpr size_t WS_WF1 = WS_WOUT + (size_t)DM * DI * 2;
constexpr size_t WS_WF2 = WS_WF1 + 2 * (size_t)FF2 * DM * 2;
constexpr size_t WS_WKQ = WS_WF2 + 2 * (size_t)DM * FF * 2;
constexpr size_t WS_WV = WS_WKQ + (size_t)2048 * DM * 2;
constexpr size_t WS_WO = WS_WV + (size_t)DM * DM * 2;
constexpr size_t WS_WEND = WS_WO + (size_t)DM * DM * 2;
constexpr size_t WS_SSQ = 60 * MiB;
constexpr size_t WS_XN = 64 * MiB;
constexpr size_t WS_R = 130 * MiB;
constexpr size_t WS_Z = WS_R;
constexpr size_t WS_XBC = WS_R + 132 * MiB;
constexpr size_t WS_DT = WS_R + 330 * MiB;
constexpr size_t WS_END = WS_R + 336 * MiB;
constexpr size_t WS_M = WS_R + 264 * MiB;
constexpr size_t WS_H = WS_R;
constexpr size_t WS_KHP = WS_R, WS_QHP = WS_R + 64 * MiB, WS_VTP = WS_R + 128 * MiB;
constexpr size_t WS_KHS = WS_R + 192 * MiB, WS_VTS = WS_R + 210 * MiB, WS_QHS = WS_R + 228 * MiB;
constexpr size_t WS_AO = WS_XN;
constexpr int SKV = 576;
static_assert(WS_WEND <= WS_SSQ, "weights overflow");

#define GAS __attribute__((address_space(1)))
#define LAS __attribute__((address_space(3)))
typedef unsigned short bf16;
typedef unsigned v4u __attribute__((ext_vector_type(4)));
typedef unsigned v2u __attribute__((ext_vector_type(2)));
typedef float f32x4 __attribute__((ext_vector_type(4)));
typedef short bf16x8 __attribute__((ext_vector_type(8)));
#define LDS_WAIT() asm volatile("s_waitcnt lgkmcnt(0)" ::: "memory")

__device__ __forceinline__ unsigned f2bf(float f) { unsigned u = __builtin_bit_cast(unsigned, f); return (u + 0x7fffu + ((u >> 16) & 1u)) >> 16; }
__device__ __forceinline__ unsigned pk2(float lo, float hi) { return f2bf(lo) | (f2bf(hi) << 16); }
__device__ __forceinline__ float bflo(unsigned u) { return __builtin_bit_cast(float, u << 16); }
__device__ __forceinline__ float bfhi(unsigned u) { return __builtin_bit_cast(float, u & 0xffff0000u); }
__device__ __forceinline__ float wave_sum(float v) {
#pragma unroll
    for (int o = 1; o < 64; o <<= 1) v += __shfl_xor(v, o);
    return v;
}

struct Args { const float* in[22]; float* out; unsigned char* ws; int dbg; int pad; };

__device__ __forceinline__ void tr_item(const float* W, int Nsrc, int K, bf16* WT, int r0, int c0, int k0, const float* kscale, float cmul, LAS float* scr, int lane) {
#pragma unroll 8
    for (int i = 0; i < 32; ++i) { const int kk = 2 * i + (lane >> 5);
        float v = 0.f; if (c0 >= 0) { v = W[(size_t)(k0 + kk) * Nsrc + c0 + (lane & 31)]; if (kscale) v *= kscale[k0 + kk]; v *= cmul; }
        scr[kk * 33 + (lane & 31)] = v; }
    LDS_WAIT(); asm volatile("" ::: "memory");
    const int c = lane & 7;
#pragma unroll
    for (int j = 0; j < 4; ++j) { const int n = (lane >> 3) + 8 * j; const LAS float* s = scr + (8 * c) * 33 + n;
        v4u o; o.x = pk2(s[0 * 33], s[1 * 33]); o.y = pk2(s[2 * 33], s[3 * 33]); o.z = pk2(s[4 * 33], s[5 * 33]); o.w = pk2(s[6 * 33], s[7 * 33]);
        *(GAS v4u*)(WT + (size_t)(r0 + n) * K + k0 + 8 * c) = o; }
    LDS_WAIT(); asm volatile("" ::: "memory");
}
__device__ __forceinline__ void rms_row_to_bf16(const float* xrow, bf16* orow, int lane) {
    const GAS f32x4* xr = (const GAS f32x4*)xrow + lane;
    f32x4 v[4]; float s = 0.f;
#pragma unroll
    for (int j = 0; j < 4; ++j) { v[j] = xr[64 * j]; s += (v[j].x * v[j].x + v[j].y * v[j].y) + (v[j].z * v[j].z + v[j].w * v[j].w); }
    const float rstd = 1.f / sqrtf(wave_sum(s) * (1.f / DM) + EPS);
    GAS unsigned long long* o8 = (GAS unsigned long long*)orow + lane;
#pragma unroll
    for (int j = 0; j < 4; ++j) o8[64 * j] = (unsigned long long)pk2(v[j].x * rstd, v[j].y * rstd) | ((unsigned long long)pk2(v[j].z * rstd, v[j].w * rstd) << 32);
}

struct EpiInProj {
    static constexpr bool PERM = true;
    bf16* Z; bf16* XBC; float* DT; float* out;
    __device__ __forceinline__ void operator()(const f32x4 (&acc)[2][2][4][2], const pg8::Unit& u, int wr, int wc, int fr, int fq) const {
        const int row0 = u.pm * 256 + wr * 64 + fr; const int ct = u.pn; const int cl = wc * 32 + 8 * fq;
#pragma unroll
        for (int ai = 0; ai < 2; ++ai)
#pragma unroll
            for (int m = 0; m < 4; ++m) {
                const int row = row0 + ai * 128 + m * 16;
#pragma unroll
                for (int bj = 0; bj < 2; ++bj) {
                    const f32x4 v0 = acc[ai][bj][m][0], v1 = acc[ai][bj][m][1];
                    v4u w; w.x = pk2(v0[0], v0[1]); w.y = pk2(v0[2], v0[3]); w.z = pk2(v1[0], v1[1]); w.w = pk2(v1[2], v1[3]);
                    const int c = bj * 128 + cl;
                    if (ct < 8) { *(GAS v4u*)(Z + (size_t)row * DI + ct * 256 + c) = w; }
                    else if (ct < 20) {
                        const int col = (ct - 8) * 256 + c;
                        *(GAS v4u*)(XBC + (size_t)row * CONVD + col) = w;
                        int pos, b; size_t ob; int L;
                        if (row < TP) { b = row >> 11; pos = row & 2047; L = 2048; ob = O_CONV_P; } else { b = (row - TP) >> 6; pos = (row - TP) & 63; L = 64; ob = O_CONV_S; }
                        if (pos >= L - 3) { float* o = out + ob + (size_t)(b * 3 + (pos - (L - 3))) * CONVD + col; *(GAS f32x4*)o = v0; *(GAS f32x4*)(o + 4) = v1; }
                    } else {
                        if (bj == 0 && wc == 0) { float* o = DT + (size_t)row * 32 + 8 * fq; *(GAS f32x4*)o = v0; *(GAS f32x4*)(o + 4) = v1; }
                    }
                }
            }
    }
};

struct EpiPlain {
    static constexpr bool PERM = true;
    bf16* O; int ldc;
    __device__ __forceinline__ void operator()(const f32x4 (&acc)[2][2][4][2], const pg8::Unit& u, int wr, int wc, int fr, int fq) const {
        const int row0 = u.pm * 256 + wr * 64 + fr, col0 = u.pn * 256 + wc * 32 + 8 * fq;
#pragma unroll
        for (int ai = 0; ai < 2; ++ai)
#pragma unroll
            for (int m = 0; m < 4; ++m) { bf16* rowp = O + (size_t)(row0 + ai * 128 + m * 16) * ldc + col0;
#pragma unroll
                for (int bj = 0; bj < 2; ++bj) { const f32x4 v0 = acc[ai][bj][m][0], v1 = acc[ai][bj][m][1];
                    v4u w; w.x = pk2(v0[0], v0[1]); w.y = pk2(v0[2], v0[3]); w.z = pk2(v1[0], v1[1]); w.w = pk2(v1[2], v1[3]);
                    *(GAS v4u*)(rowp + bj * 128) = w; } }
    }
};
__device__ __forceinline__ float silu_f(float v) { return v / (1.f + __expf(-v)); }
struct EpiSwiGLU {
    static constexpr bool PERM = true;
    bf16* H;
    __device__ __forceinline__ void operator()(const f32x4 (&acc)[2][2][4][2], const pg8::Unit& u, int wr, int wc, int fr, int fq) const {
        const int row0 = u.pm * 256 + wr * 64 + fr, col0 = u.pn * 128 + wc * 32 + 8 * fq;
#pragma unroll
        for (int ai = 0; ai < 2; ++ai)
#pragma unroll
            for (int m = 0; m < 4; ++m) {
                const f32x4 g0 = acc[ai][0][m][0], g1 = acc[ai][0][m][1], u0 = acc[ai][1][m][0], u1 = acc[ai][1][m][1];
                v4u w; w.x = pk2(silu_f(g0[0]) * u0[0], silu_f(g0[1]) * u0[1]); w.y = pk2(silu_f(g0[2]) * u0[2], silu_f(g0[3]) * u0[3]);
                w.z = pk2(silu_f(g1[0]) * u1[0], silu_f(g1[1]) * u1[1]); w.w = pk2(silu_f(g1[2]) * u1[2], silu_f(g1[3]) * u1[3]);
                *(GAS v4u*)(H + (size_t)(row0 + ai * 128 + m * 16) * FF + col0) = w; }
    }
};
struct EpiKQ {
    static constexpr bool PERM = true;
    bf16 *KHp, *QHp, *KHs, *QHs; float* out;
    __device__ __forceinline__ void operator()(const f32x4 (&acc)[2][2][4][2], const pg8::Unit& u, int wr, int wc, int fr, int fq) const {
        const int row0 = u.pm * 256 + wr * 64 + fr;
#pragma unroll
        for (int ai = 0; ai < 2; ++ai)
#pragma unroll
            for (int m = 0; m < 4; ++m) {
                const int row = row0 + ai * 128 + m * 16;
                const bool smp = row >= TP; const int b = smp ? (row - TP) >> 6 : row >> 11, pos = smp ? (row - TP) & 63 : row & 2047;
#pragma unroll
                for (int bj = 0; bj < 2; ++bj) {
                    const f32x4 v0 = acc[ai][bj][m][0], v1 = acc[ai][bj][m][1];
                    v4u w; w.x = pk2(v0[0], v0[1]); w.y = pk2(v0[2], v0[3]); w.z = pk2(v1[0], v1[1]); w.w = pk2(v1[2], v1[3]);
                    const int col = u.pn * 256 + bj * 128 + wc * 32 + 8 * fq;
                    if (col < 1024) {
                        const int hd = col >> 6, d = col & 63;
                        bf16* dst = smp ? KHs + ((size_t)((b * AH + hd) * SKV + 512 + pos)) * 64 + d : KHp + ((size_t)((b * AH + hd) * 2048 + pos)) * 64 + d;
                        *(GAS v4u*)dst = w;
                        if (smp) { float* o = out + O_CK_S + (size_t)(b * 64 + pos) * 1024 + col; *(GAS f32x4*)o = v0; *(GAS f32x4*)(o + 4) = v1; }
                        else if (pos >= 1536) { float* o = out + O_CK_P + (size_t)(b * 512 + pos - 1536) * 1024 + col; *(GAS f32x4*)o = v0; *(GAS f32x4*)(o + 4) = v1; }
                    } else {
                        const int cq = col - 1024, hd = cq >> 6, d = cq & 63;
                        bf16* dst = smp ? QHs + ((size_t)((b * AH + hd) * 64 + pos)) * 64 + d : QHp + ((size_t)((b * AH + hd) * 2048 + pos)) * 64 + d;
                        *(GAS v4u*)dst = w;
                    }
                }
            }
    }
};
struct EpiVT {
    static constexpr bool PERM = true;
    bf16 *VTp, *VTs; float* out;
    __device__ __forceinline__ void operator()(const f32x4 (&acc)[2][2][4][2], const pg8::Unit& u, int wr, int wc, int fr, int fq) const {
        const int f0 = u.pm * 256 + wr * 64 + fr;
#pragma unroll
        for (int ai = 0; ai < 2; ++ai)
#pragma unroll
            for (int m = 0; m < 4; ++m) {
                const int f = f0 + ai * 128 + m * 16, hd = f >> 6, d = f & 63;
#pragma unroll
                for (int bj = 0; bj < 2; ++bj) {
                    const f32x4 v0 = acc[ai][bj][m][0], v1 = acc[ai][bj][m][1];
                    v4u w; w.x = pk2(v0[0], v0[1]); w.y = pk2(v0[2], v0[3]); w.z = pk2(v1[0], v1[1]); w.w = pk2(v1[2], v1[3]);
                    const int t0 = u.pn * 256 + bj * 128 + wc * 32 + 8 * fq;
                    if (t0 < TP) { const int b = t0 >> 11, pos = t0 & 2047;
                        *(GAS v4u*)(VTp + ((size_t)((b * AH + hd) * 64 + d)) * 2048 + pos) = w;
                        if (pos >= 1536) { float* o = out + O_CV_P + (size_t)(b * 512 + pos - 1536) * 1024 + f;
#pragma unroll
                            for (int e = 0; e < 4; ++e) { o[(size_t)e * 1024] = v0[e]; o[(size_t)(e + 4) * 1024] = v1[e]; } }
                    } else { const int b = (t0 - TP) >> 6, pos = (t0 - TP) & 63;
                        *(GAS v4u*)(VTs + ((size_t)((b * AH + hd) * 64 + d)) * SKV + 512 + pos) = w;
                        float* o = out + O_CV_S + (size_t)(b * 64 + pos) * 1024 + f;
#pragma unroll
                        for (int e = 0; e < 4; ++e) { o[(size_t)e * 1024] = v0[e]; o[(size_t)(e + 4) * 1024] = v1[e]; } }
                }
            }
    }
};

__device__ __forceinline__ void norm_row(const bf16* Mrow, const float* xin, float* xout, bf16* xn, const float* wpost, int lane, bool want_xn) {
    f32x4 mv[4], xv[4], wv[4]; float s = 0.f;
#pragma unroll
    for (int j = 0; j < 4; ++j) { const v2u mm = *(const GAS v2u*)(Mrow + 4 * lane + 256 * j); mv[j] = (f32x4){bflo(mm.x), bfhi(mm.x), bflo(mm.y), bfhi(mm.y)};
        xv[j] = *(const GAS f32x4*)(xin + 4 * lane + 256 * j); wv[j] = *(const GAS f32x4*)(wpost + 4 * lane + 256 * j);
        s += (mv[j].x * mv[j].x + mv[j].y * mv[j].y) + (mv[j].z * mv[j].z + mv[j].w * mv[j].w); }
    const float r1 = 1.f / sqrtf(wave_sum(s) * (1.f / DM) + EPS); float s2 = 0.f;
#pragma unroll
    for (int j = 0; j < 4; ++j) { xv[j] = xv[j] + mv[j] * r1 * wv[j]; *(GAS f32x4*)(xout + 4 * lane + 256 * j) = xv[j];
        s2 += (xv[j].x * xv[j].x + xv[j].y * xv[j].y) + (xv[j].z * xv[j].z + xv[j].w * xv[j].w); }
    if (want_xn) { const float r2 = 1.f / sqrtf(wave_sum(s2) * (1.f / DM) + EPS);
#pragma unroll
        for (int j = 0; j < 4; ++j) { v2u o; o.x = pk2(xv[j].x * r2, xv[j].y * r2); o.y = pk2(xv[j].z * r2, xv[j].w * r2); *(GAS v2u*)(xn + 4 * lane + 256 * j) = o; } }
}

typedef float f32x16 __attribute__((ext_vector_type(16)));
__device__ __forceinline__ bf16x8 pack8(const float* v) { v4u w; w.x = pk2(v[0], v[1]); w.y = pk2(v[2], v[3]); w.z = pk2(v[4], v[5]); w.w = pk2(v[6], v[7]); return __builtin_bit_cast(bf16x8, w); }
#define MFMA16(a, b, c) __builtin_amdgcn_mfma_f32_16x16x32_bf16((a), (b), (c), 0, 0, 0)
#define MFMA32(a, b, c) __builtin_amdgcn_mfma_f32_32x32x16_bf16((a), (b), (c), 0, 0, 0)
constexpr int S_XT = 0, S_BT = 18432, S_BN = 36864, S_CN = 54272, S_CB = 71680, S_HS = 89088, S_DT = 123904, S_CUM = 124416, S_W = 124928, S_CEND = 125440;

__global__ void __launch_bounds__(NTHREADS, 2) mk_fwd(Args a) {
    extern __shared__ __attribute__((aligned(16))) unsigned char lds[];
    cg::grid_group grid = cg::this_grid();
    const int G = gridDim.x, bx = blockIdx.x, NGW = G * NWAVES;
    const size_t gsz = (size_t)G * NTHREADS;
#define PHASE_IDS int tid = threadIdx.x; asm volatile("" : "+v"(tid)); const int lane = tid & 63, wave = __builtin_amdgcn_readfirstlane(tid >> 6), gw = bx * NWAVES + wave; const size_t gtid = (size_t)bx * NTHREADS + tid; (void)lane; (void)gw; (void)gtid;
#define PHASE_PTRS const Args __attribute__((address_space(4)))* ap_ = (const Args __attribute__((address_space(4)))*)__builtin_amdgcn_kernarg_segment_ptr(); asm volatile("" : "+s"(ap_)); \
    unsigned char* ws = ap_->ws; float* out = ap_->out; (void)out; const float* x_p = ap_->in[0]; const float* x_s = ap_->in[1]; const float* norm_w = ap_->in[6]; (void)x_p; (void)x_s; (void)norm_w; \
    bf16* Win_t = (bf16*)(ws + WS_WIN); bf16* Wout_t = (bf16*)(ws + WS_WOUT); bf16* Wf1_t = (bf16*)(ws + WS_WF1); bf16* Wf2_t = (bf16*)(ws + WS_WF2); \
    bf16* Wkq_t = (bf16*)(ws + WS_WKQ); bf16* Wv_t = (bf16*)(ws + WS_WV); bf16* Wo_t = (bf16*)(ws + WS_WO); \
    bf16* XN = (bf16*)(ws + WS_XN); bf16* Z = (bf16*)(ws + WS_Z); bf16* XBC = (bf16*)(ws + WS_XBC); float* DT = (float*)(ws + WS_DT); \
    float* SSQ = (float*)(ws + WS_SSQ); bf16* MB = (bf16*)(ws + WS_M); bf16* HB = (bf16*)(ws + WS_H); \
    bf16* KHp = (bf16*)(ws + WS_KHP); bf16* QHp = (bf16*)(ws + WS_QHP); bf16* VTp = (bf16*)(ws + WS_VTP); \
    bf16* KHs = (bf16*)(ws + WS_KHS); bf16* QHs = (bf16*)(ws + WS_QHS); bf16* VTs = (bf16*)(ws + WS_VTS); bf16* AO = (bf16*)(ws + WS_AO); \
    (void)Win_t; (void)Wout_t; (void)Wf1_t; (void)Wf2_t; (void)Wkq_t; (void)Wv_t; (void)Wo_t; (void)XN; (void)Z; (void)XBC; (void)DT; (void)SSQ; (void)MB; (void)HB; \
    (void)KHp; (void)QHp; (void)VTp; (void)KHs; (void)QHs; (void)VTs; (void)AO;
#define AIN(k) (ap_->in[k])
    LAS unsigned char* L = (LAS unsigned char*)lds;
    const int dbg = a.dbg;

    {
        PHASE_IDS PHASE_PTRS
        LAS float* scr = (LAS float*)(L + wave * 16384);
        constexpr float C2 = 0.125f * 1.4426950408889634f;
        constexpr int I_IN = (INPROJ_PAD / 32) * (DM / 64);
        constexpr int I_OUT = (DM / 32) * (DI / 64);
        constexpr int I_F1 = (FF2 / 32) * (DM / 64);
        constexpr int I_F2 = (DM / 32) * (FF / 64);
        constexpr int I_KQ = (2048 / 32) * (DM / 64);
        constexpr int I_V = (DM / 32) * (DM / 64);
        constexpr int NITEMS = I_IN + I_OUT + 2 * I_F1 + 2 * I_F2 + I_KQ + 2 * I_V;
        for (int it = gw; it < NITEMS; it += NGW) {
            int r = it;
            if (r < I_IN) { const int rb = r / 16, kb = r % 16, r0 = rb * 32; tr_item(ap_->in[7], INPROJ, DM, Win_t, r0, r0 < INPROJ ? r0 : -1, kb * 64, norm_w, 1.f, scr, lane); continue; } r -= I_IN;
            if (r < I_OUT) { const int rb = r / 32, kb = r % 32, r0 = rb * 32; tr_item(ap_->in[14], DM, DI, Wout_t, r0, r0, kb * 64, ap_->in[13], 1.f, scr, lane); continue; } r -= I_OUT;
            if (r < 2 * I_F1) { const int l = r / I_F1; r -= l * I_F1; const int rb = r / 16, kb = r % 16, r0 = rb * 32;
                const int c0 = ((r0 >> 7) & 1) * FF + (r0 >> 8) * 128 + (r0 & 127);
                tr_item(ap_->in[20] + (size_t)l * DM * FF2, FF2, DM, Wf1_t + (size_t)l * FF2 * DM, r0, c0, kb * 64, norm_w + (l * 4 + 2) * DM, 1.f, scr, lane); continue; } r -= 2 * I_F1;
            if (r < 2 * I_F2) { const int l = r / I_F2; r -= l * I_F2; const int rb = r / 44, kb = r % 44, r0 = rb * 32;
                tr_item(ap_->in[21] + (size_t)l * FF * DM, DM, FF, Wf2_t + (size_t)l * DM * FF, r0, r0, kb * 64, nullptr, 1.f, scr, lane); continue; } r -= 2 * I_F2;
            if (r < I_KQ) { const int rb = r / 16, kb = r % 16, r0 = rb * 32;
                if (r0 < 1024) tr_item(ap_->in[16], 2048, DM, Wkq_t, r0, r0, kb * 64, ap_->in[15], 1.f, scr, lane);
                else tr_item(ap_->in[17], DM, DM, Wkq_t, r0, r0 - 1024, kb * 64, norm_w + 4 * DM, C2, scr, lane);
                continue; } r -= I_KQ;
            if (r < I_V) { const int rb = r / 16, kb = r % 16, r0 = rb * 32; tr_item(ap_->in[16], 2048, DM, Wv_t, r0, 1024 + r0, kb * 64, ap_->in[15], 1.f, scr, lane); continue; } r -= I_V;
            { const int rb = r / 16, kb = r % 16, r0 = rb * 32; tr_item(ap_->in[19], DM, DM, Wo_t, r0, r0, kb * 64, nullptr, 1.f, scr, lane); }
        }
        for (int m = gw; m < TT; m += NGW) rms_row_to_bf16(m < TP ? x_p + (size_t)m * DM : x_s + (size_t)(m - TP) * DM, XN + (size_t)m * DM, lane);
        for (size_t i = gtid; i < (size_t)TT * 4; i += gsz) SSQ[i] = 0.f;
        if (dbg) for (size_t i = gtid; i < O_TOTAL / 4; i += gsz) ((GAS f32x4*)out)[i] = (f32x4){0.f, 0.f, 0.f, 0.f};
    }
    __syncthreads();
    grid.sync();

    {
        PHASE_PTRS
        pg8::Gemm g{XN, Win_t, TT, INPROJ_PAD, DM}; pg8::StaticOrder S; S.init(TT, INPROJ_PAD, G, bx);
        EpiInProj E{Z, XBC, DT, out};
        pg8::gemm_phase<EpiInProj, pg8::StaticOrder, true, true>(L, g, S, E);
    }
    grid.sync();
    if (dbg == 1) { PHASE_IDS PHASE_PTRS for (size_t i = gtid; i < 147456; i += gsz) { out[O_CONV_P + i] *= 4.f; out[O_CONV_S + i] *= 4.f; } return; }

    {
        PHASE_IDS PHASE_PTRS
        LAS bf16* XT = (LAS bf16*)(L + S_XT); LAS bf16* BT = (LAS bf16*)(L + S_BT); LAS bf16* BN = (LAS bf16*)(L + S_BN); LAS bf16* CN = (LAS bf16*)(L + S_CN);
        LAS float* CBs = (LAS float*)(L + S_CB); LAS bf16* HS = (LAS bf16*)(L + S_HS);
        LAS float* dtS = (LAS float*)(L + S_DT); LAS float* cumS = (LAS float*)(L + S_CUM); LAS float* wS = (LAS float*)(L + S_W); LAS float* cendS = (LAS float*)(L + S_CEND);
        const float* conv_w = ap_->in[8]; const float* conv_b = ap_->in[9]; const float* dt_bias = ap_->in[10]; const float* A_log = ap_->in[11]; const float* Dskip = ap_->in[12];
        const float* state_ssm = ap_->in[2]; const float* state_conv = ap_->in[3];
        const int fr = lane & 15, fq = lane >> 4, hh = wave >> 2, qd = wave & 3;
        for (int wi = bx; wi < 512; wi += G) {
            const bool smp = wi >= 256; const int sq = (wi & 255) >> 4, hp = wi & 15, h0 = 2 * hp, grp = hp >> 2, h = h0 + hh;
            const int nchunk = smp ? 1 : 32;
            const size_t row_base = smp ? (size_t)TP + sq * 64 : (size_t)sq * 2048;
            const float Dh = Dskip[h];
            f32x4 sacc[2][4];
#pragma unroll
            for (int n2 = 0; n2 < 2; ++n2)
#pragma unroll
                for (int pt = 0; pt < 4; ++pt) {
                    const int p = 16 * pt + fr, n = 32 * qd + 16 * n2 + 4 * fq;
                    sacc[n2][pt] = smp ? *(const GAS f32x4*)(state_ssm + ((size_t)((sq * NH + h) * 64 + p)) * 128 + n) : (f32x4){0.f, 0.f, 0.f, 0.f};
                    v2u w; w.x = pk2(sacc[n2][pt][0], sacc[n2][pt][1]); w.y = pk2(sacc[n2][pt][2], sacc[n2][pt][3]);
                    *(LAS v2u*)(HS + (hh * 64 + p) * 136 + n) = w;
                }
            unsigned raw[3][11]; float dtraw = 0.f;
#define SSD_LOAD(c) do { \
            _Pragma("unroll") for (int i = 0; i < 3; ++i) { const int it = tid + 512 * i, cp = it % 192, sb = it / 192; \
                const int col = cp < 64 ? h0 * 64 + 2 * cp : (cp < 128 ? DI + grp * 128 + 2 * (cp - 64) : DI + 512 + grp * 128 + 2 * (cp - 128)); \
                _Pragma("unroll") for (int r = 0; r < 11; ++r) { const int srow = 64 * (c) + 8 * sb + r - 3; \
                    unsigned v = 0u; \
                    if (srow >= 0) v = *(const GAS unsigned*)(XBC + (row_base + srow) * CONVD + col); \
                    else if (smp) { const float* sc = state_conv + (size_t)(sq * 3 + srow + 3) * CONVD + col; v = pk2(sc[0], sc[1]); } \
                    raw[i][r] = v; } } \
            if (wave < 2) dtraw = DT[(row_base + 64 * (c) + lane) * 32 + h0 + wave]; } while (0)
            SSD_LOAD(0);
            for (int c = 0; c < nchunk; ++c) {
                const float* cw_ = conv_w; const float* cb_ = conv_b; asm volatile("" : "+s"(cw_), "+s"(cb_));
#pragma unroll
                for (int i = 0; i < 3; ++i) { const int it = tid + 512 * i, cp = it % 192, sb = it / 192, typ = cp >> 6, cl = 2 * (cp & 63);
                    const int col = cp < 64 ? h0 * 64 + 2 * cp : (cp < 128 ? DI + grp * 128 + 2 * (cp - 64) : DI + 512 + grp * 128 + 2 * (cp - 128));
                    float w0[4], w1[4];
#pragma unroll
                    for (int k = 0; k < 4; ++k) { w0[k] = cw_[k * CONVD + col]; w1[k] = cw_[k * CONVD + col + 1]; }
                    const float b0 = cb_[col], b1 = cb_[col + 1];
                    float o0[8], o1[8];
#pragma unroll
                    for (int s = 0; s < 8; ++s) { float a0 = b0, a1 = b1;
#pragma unroll
                        for (int k = 0; k < 4; ++k) { const unsigned uu = raw[i][s + k]; a0 += w0[k] * bflo(uu); a1 += w1[k] * bfhi(uu); }
                        o0[s] = silu_f(a0); o1[s] = silu_f(a1); }
                    if (typ == 0) { *(LAS bf16x8*)(XT + cl * 72 + 8 * sb) = pack8(o0); *(LAS bf16x8*)(XT + (cl + 1) * 72 + 8 * sb) = pack8(o1); }
                    else if (typ == 1) { *(LAS bf16x8*)(BT + cl * 72 + 8 * sb) = pack8(o0); *(LAS bf16x8*)(BT + (cl + 1) * 72 + 8 * sb) = pack8(o1);
#pragma unroll
                        for (int s = 0; s < 8; ++s) *(LAS unsigned*)(BN + (8 * sb + s) * 136 + cl) = pk2(o0[s], o1[s]); }
                    else {
#pragma unroll
                        for (int s = 0; s < 8; ++s) *(LAS unsigned*)(CN + (8 * sb + s) * 136 + cl) = pk2(o0[s], o1[s]); }
                }
                if (wave < 2) { const int hd = h0 + wave;
                    const float xx = dtraw + dt_bias[hd];
                    const float dtv = fmaxf(xx, 0.f) + log1pf(__expf(-fabsf(xx)));
                    const float Ah = -__expf(A_log[hd]);
                    float cum = dtv * Ah;
#pragma unroll
                    for (int o = 1; o < 64; o <<= 1) { const float t = __shfl_up(cum, o); if (lane >= o) cum += t; }
                    const float cend = __shfl(cum, 63);
                    dtS[wave * 64 + lane] = dtv; cumS[wave * 64 + lane] = cum; wS[wave * 64 + lane] = dtv * __expf(cend - cum);
                    if (lane == 63) cendS[wave] = cend; }
                __syncthreads();
                if (c + 1 < nchunk) SSD_LOAD(c + 1);
                { const int st = wave >> 1, qt0 = 2 * (wave & 1);
                    f32x4 cacc[2] = {(f32x4){0.f, 0.f, 0.f, 0.f}, (f32x4){0.f, 0.f, 0.f, 0.f}};
#pragma unroll
                    for (int ks = 0; ks < 4; ++ks) { const bf16x8 af = *(const LAS bf16x8*)(BN + (16 * st + fr) * 136 + 8 * fq + 32 * ks);
#pragma unroll
                        for (int t = 0; t < 2; ++t) { const bf16x8 bfr = *(const LAS bf16x8*)(CN + (16 * (qt0 + t) + fr) * 136 + 8 * fq + 32 * ks); cacc[t] = MFMA16(af, bfr, cacc[t]); } }
#pragma unroll
                    for (int t = 0; t < 2; ++t) *(LAS f32x4*)(CBs + (16 * (qt0 + t) + fr) * 68 + 16 * st + 4 * fq) = cacc[t]; }
                __syncthreads();
                bf16x8 xt[4][2];
#pragma unroll
                for (int pt = 0; pt < 4; ++pt)
#pragma unroll
                    for (int ks = 0; ks < 2; ++ks) xt[pt][ks] = *(const LAS bf16x8*)(XT + (hh * 64 + 16 * pt + fr) * 72 + 8 * fq + 32 * ks);
                { f32x4 yacc[4];
#pragma unroll
                    for (int pt = 0; pt < 4; ++pt) yacc[pt] = (f32x4){0.f, 0.f, 0.f, 0.f};
                    const int q = 16 * qd + fr;
#pragma unroll
                    for (int ks = 0; ks < 4; ++ks) { const bf16x8 bfr = *(const LAS bf16x8*)(CN + q * 136 + 8 * fq + 32 * ks);
#pragma unroll
                        for (int pt = 0; pt < 4; ++pt) { const bf16x8 af = *(const LAS bf16x8*)(HS + (hh * 64 + 16 * pt + fr) * 136 + 8 * fq + 32 * ks); yacc[pt] = MFMA16(af, bfr, yacc[pt]); } }
                    const float cq = cumS[hh * 64 + q]; const float eq = __expf(cq);
#pragma unroll
                    for (int pt = 0; pt < 4; ++pt) yacc[pt] = yacc[pt] * eq;
#pragma unroll
                    for (int ks = 0; ks < 2; ++ks) { const int s0 = 8 * fq + 32 * ks;
                        const f32x4 cb0 = *(const LAS f32x4*)(CBs + q * 68 + s0), cb1 = *(const LAS f32x4*)(CBs + q * 68 + s0 + 4);
                        const f32x4 cs0 = *(const LAS f32x4*)(cumS + hh * 64 + s0), cs1 = *(const LAS f32x4*)(cumS + hh * 64 + s0 + 4);
                        const f32x4 d0 = *(const LAS f32x4*)(dtS + hh * 64 + s0), d1 = *(const LAS f32x4*)(dtS + hh * 64 + s0 + 4);
                        float mv[8];
#pragma unroll
                        for (int e = 0; e < 8; ++e) { const int s = s0 + e; const float cbv = e < 4 ? cb0[e & 3] : cb1[e & 3], csv = e < 4 ? cs0[e & 3] : cs1[e & 3], dv = e < 4 ? d0[e & 3] : d1[e & 3];
                            float t = cbv * __expf(fminf(cq - csv, 0.f)) * dv; t = (s <= q) ? t : 0.f; if (s == q) t += Dh; mv[e] = t; }
                        const bf16x8 mf = pack8(mv);
#pragma unroll
                        for (int pt = 0; pt < 4; ++pt) yacc[pt] = MFMA16(xt[pt][ks], mf, yacc[pt]); }
                    const size_t m = row_base + 64 * c + q;
                    bf16* zp = Z + m * DI + h * 64 + 4 * fq; float ss = 0.f;
#pragma unroll
                    for (int pt = 0; pt < 4; ++pt) { const v2u zz = *(const GAS v2u*)(zp + 16 * pt);
                        const float y0 = yacc[pt][0] * silu_f(bflo(zz.x)), y1 = yacc[pt][1] * silu_f(bfhi(zz.x)), y2 = yacc[pt][2] * silu_f(bflo(zz.y)), y3 = yacc[pt][3] * silu_f(bfhi(zz.y));
                        ss += (y0 * y0 + y1 * y1) + (y2 * y2 + y3 * y3);
                        v2u o; o.x = pk2(y0, y1); o.y = pk2(y2, y3); *(GAS v2u*)(zp + 16 * pt) = o; }
                    ss += __shfl_xor(ss, 16); ss += __shfl_xor(ss, 32);
                    if (fq == 0) atomicAdd(SSQ + m * 4 + grp, ss);
                }
                { const float dec = __expf(cendS[hh]);
#pragma unroll
                    for (int n2 = 0; n2 < 2; ++n2)
#pragma unroll
                        for (int pt = 0; pt < 4; ++pt) sacc[n2][pt] = sacc[n2][pt] * dec;
#pragma unroll
                    for (int ks = 0; ks < 2; ++ks) { const int s0 = 8 * fq + 32 * ks;
                        const f32x4 w0 = *(const LAS f32x4*)(wS + hh * 64 + s0), w1 = *(const LAS f32x4*)(wS + hh * 64 + s0 + 4);
#pragma unroll
                        for (int n2 = 0; n2 < 2; ++n2) { const v4u rw = *(const LAS v4u*)(BT + (32 * qd + 16 * n2 + fr) * 72 + s0);
                            float bv[8]; bv[0] = bflo(rw.x) * w0[0]; bv[1] = bfhi(rw.x) * w0[1]; bv[2] = bflo(rw.y) * w0[2]; bv[3] = bfhi(rw.y) * w0[3];
                            bv[4] = bflo(rw.z) * w1[0]; bv[5] = bfhi(rw.z) * w1[1]; bv[6] = bflo(rw.w) * w1[2]; bv[7] = bfhi(rw.w) * w1[3];
                            const bf16x8 af = pack8(bv);
#pragma unroll
                            for (int pt = 0; pt < 4; ++pt) sacc[n2][pt] = MFMA16(af, xt[pt][ks], sacc[n2][pt]); } }
                }
                __syncthreads();
#pragma unroll
                for (int n2 = 0; n2 < 2; ++n2)
#pragma unroll
                    for (int pt = 0; pt < 4; ++pt) { v2u w; w.x = pk2(sacc[n2][pt][0], sacc[n2][pt][1]); w.y = pk2(sacc[n2][pt][2], sacc[n2][pt][3]);
                        *(LAS v2u*)(HS + (hh * 64 + 16 * pt + fr) * 136 + 32 * qd + 16 * n2 + 4 * fq) = w; }
            }
#undef SSD_LOAD
            { float* so = out + (smp ? O_SSM_S : O_SSM_P);
#pragma unroll
                for (int n2 = 0; n2 < 2; ++n2)
#pragma unroll
                    for (int pt = 0; pt < 4; ++pt) *(GAS f32x4*)(so + ((size_t)((sq * NH + h) * 64 + 16 * pt + fr)) * 128 + 32 * qd + 16 * n2 + 4 * fq) = sacc[n2][pt]; }
        }
    }
    grid.sync();
    if (dbg == 2) { PHASE_IDS PHASE_PTRS for (size_t i = gtid; i < 4194304; i += gsz) { out[O_SSM_P + i] *= 4.f; out[O_SSM_S + i] *= 4.f; } return; }

    { PHASE_IDS PHASE_PTRS
    for (int m = gw; m < TT; m += NGW) {
#pragma unroll
        for (int j = 0; j < 4; ++j) { bf16* p = Z + (size_t)m * DI + 512 * j + 8 * lane; const v4u w = *(const GAS v4u*)p;
            const float rs = 1.f / sqrtf(SSQ[(size_t)m * 4 + j] * (1.f / 512.f) + EPS);
            v4u o; o.x = pk2(bflo(w.x) * rs, bfhi(w.x) * rs); o.y = pk2(bflo(w.y) * rs, bfhi(w.y) * rs); o.z = pk2(bflo(w.z) * rs, bfhi(w.z) * rs); o.w = pk2(bflo(w.w) * rs, bfhi(w.w) * rs);
            *(GAS v4u*)p = o; }
    } }
    grid.sync();

    { PHASE_PTRS pg8::Gemm g{Z, Wout_t, TT, DM, DI}; pg8::StaticOrder S; S.init(TT, DM, G, bx); EpiPlain E{MB, DM};
      pg8::gemm_phase<EpiPlain, pg8::StaticOrder, true, true>(L, g, S, E); }
    grid.sync();
    { PHASE_IDS PHASE_PTRS for (int m = gw; m < TT; m += NGW) norm_row(MB + (size_t)m * DM, m < TP ? x_p + (size_t)m * DM : x_s + (size_t)(m - TP) * DM, out + O_Y + (size_t)m * DM, XN + (size_t)m * DM, norm_w + 1 * DM, lane, true); }
    grid.sync();

    for (int layer = 0; layer < 2; ++layer) {
        if (layer == 1) {
            { PHASE_PTRS pg8::Gemm g{XN, Wkq_t, TT, 2048, DM}; pg8::StaticOrder S; S.init(TT, 2048, G, bx); EpiKQ E{KHp, QHp, KHs, QHs, out};
              pg8::gemm_phase<EpiKQ, pg8::StaticOrder, true, true>(L, g, S, E); }
            { PHASE_PTRS pg8::Gemm g{Wv_t, XN, DM, TT, DM}; pg8::StaticOrder S; S.init(DM, TT, G, bx); EpiVT E{VTp, VTs, out};
              pg8::gemm_phase<EpiVT, pg8::StaticOrder, true, true>(L, g, S, E); }
            grid.sync();
            if (dbg == 3) { PHASE_IDS PHASE_PTRS for (size_t i = gtid; i < 8388608; i += gsz) { out[O_CK_P + i] *= 4.f; out[O_CV_P + i] *= 4.f; }
                            for (size_t i = gtid; i < 1048576; i += gsz) { out[O_CK_S + i] *= 4.f; out[O_CV_S + i] *= 4.f; } return; }
            {
                PHASE_IDS PHASE_PTRS
                LAS float* biasL = (LAS float*)L;
                const float* rel_bias = ap_->in[18];
                for (int i = tid; i < AH * 513; i += NTHREADS) biasL[i] = rel_bias[i] * 1.4426950408889634f;
                __syncthreads();
                const int r32 = lane & 31, hi = lane >> 5;
                for (int u = gw; u < 16896; u += NGW) {
                    const bool smp = u >= 16384; int b, hd, qb;
                    if (!smp) { b = u >> 10; hd = (u >> 6) & 15; qb = u & 63; } else { const int v = u - 16384; b = v >> 5; hd = (v >> 1) & 15; qb = v & 1; }
                    const int cq = smp ? 8 : (qb >> 1), kt_lo = cq > 8 ? cq - 8 : 0, Lk = smp ? SKV : 2048;
                    const bf16* KHb = smp ? KHs + (size_t)((b * AH + hd) * SKV) * 64 : KHp + (size_t)((b * AH + hd) * 2048) * 64;
                    const bf16* VTb = smp ? VTs + (size_t)((b * AH + hd) * 64) * SKV : VTp + (size_t)((b * AH + hd) * 64) * 2048;
                    const bf16* Qb = smp ? QHs + (size_t)((b * AH + hd) * 64 + 32 * qb) * 64 : QHp + (size_t)((b * AH + hd) * 2048 + 32 * qb) * 64;
                    const size_t m0 = smp ? (size_t)TP + b * 64 + 32 * qb : (size_t)b * 2048 + 32 * qb;
                    const int qloc = 64 * cq + 32 * (qb & 1) + r32;
                    bf16x8 qf[4];
#pragma unroll
                    for (int ks = 0; ks < 4; ++ks) qf[ks] = *(const GAS bf16x8*)(Qb + r32 * 64 + 8 * hi + 16 * ks);
                    float m_run = -1e30f, l_run = 0.f; f32x16 o0, o1;
#pragma unroll
                    for (int r = 0; r < 16; ++r) { o0[r] = 0.f; o1[r] = 0.f; }
                    for (int kt = kt_lo; kt <= cq; ++kt) {
                        const bf16* Kt = KHb + (size_t)(kt * 64) * 64;
                        f32x16 p0, p1;
#pragma unroll
                        for (int r = 0; r < 16; ++r) { p0[r] = 0.f; p1[r] = 0.f; }
#pragma unroll
                        for (int ks = 0; ks < 4; ++ks) { const bf16x8 a0 = *(const GAS bf16x8*)(Kt + r32 * 64 + 8 * hi + 16 * ks), a1 = *(const GAS bf16x8*)(Kt + (32 + r32) * 64 + 8 * hi + 16 * ks);
                            p0 = MFMA32(a0, qf[ks], p0); p1 = MFMA32(a1, qf[ks], p1); }
                        if (cq - kt >= 5) { const float bc = biasL[hd * 513 + 512];
#pragma unroll
                            for (int r = 0; r < 16; ++r) { p0[r] += bc; p1[r] += bc; } }
                        else { const int base = qloc - 64 * kt - 4 * hi + 256;
#pragma unroll
                            for (int r = 0; r < 16; ++r) { const int d0 = base - ((r & 3) + 8 * (r >> 2)); const int i0 = d0 > 512 ? 512 : d0, i1 = (d0 - 32) > 512 ? 512 : (d0 - 32);
                                p0[r] += biasL[hd * 513 + i0]; p1[r] += biasL[hd * 513 + i1]; } }
                        float mx = p0[0];
#pragma unroll
                        for (int r = 0; r < 16; ++r) { mx = fmaxf(mx, p0[r]); mx = fmaxf(mx, p1[r]); }
                        mx = fmaxf(mx, __shfl_xor(mx, 32));
                        const float mnew = fmaxf(m_run, mx), alpha = exp2f(m_run - mnew); m_run = mnew;
                        float ls = 0.f;
#pragma unroll
                        for (int r = 0; r < 16; ++r) { p0[r] = exp2f(p0[r] - mnew); p1[r] = exp2f(p1[r] - mnew); ls += p0[r] + p1[r]; }
                        l_run = l_run * alpha + ls;
#pragma unroll
                        for (int r = 0; r < 16; ++r) { o0[r] *= alpha; o1[r] *= alpha; }
                        bf16x8 pb[4];
                        { float t[8];
#pragma unroll
                          for (int j = 0; j < 8; ++j) t[j] = p0[j]; pb[0] = pack8(t);
#pragma unroll
                          for (int j = 0; j < 8; ++j) t[j] = p0[8 + j]; pb[1] = pack8(t);
#pragma unroll
                          for (int j = 0; j < 8; ++j) t[j] = p1[j]; pb[2] = pack8(t);
#pragma unroll
                          for (int j = 0; j < 8; ++j) t[j] = p1[8 + j]; pb[3] = pack8(t); }
#pragma unroll
                        for (int s4 = 0; s4 < 4; ++s4) {
                            const bf16* vp0 = VTb + (size_t)r32 * Lk + 64 * kt + 16 * s4 + 4 * hi; const bf16* vp1 = vp0 + (size_t)32 * Lk;
                            const v2u a0l = *(const GAS v2u*)vp0, a0h = *(const GAS v2u*)(vp0 + 8), a1l = *(const GAS v2u*)vp1, a1h = *(const GAS v2u*)(vp1 + 8);
                            const v4u A0 = {a0l.x, a0l.y, a0h.x, a0h.y}, A1 = {a1l.x, a1l.y, a1h.x, a1h.y};
                            o0 = MFMA32(__builtin_bit_cast(bf16x8, A0), pb[s4], o0); o1 = MFMA32(__builtin_bit_cast(bf16x8, A1), pb[s4], o1); }
                    }
                    const float inv = 1.f / (l_run + __shfl_xor(l_run, 32));
                    bf16* op = AO + (m0 + r32) * DM + hd * 64 + 4 * hi;
#pragma unroll
                    for (int r4 = 0; r4 < 4; ++r4) { v2u w; w.x = pk2(o0[4 * r4] * inv, o0[4 * r4 + 1] * inv); w.y = pk2(o0[4 * r4 + 2] * inv, o0[4 * r4 + 3] * inv); *(GAS v2u*)(op + 8 * r4) = w;
                        v2u w2; w2.x = pk2(o1[4 * r4] * inv, o1[4 * r4 + 1] * inv); w2.y = pk2(o1[4 * r4 + 2] * inv, o1[4 * r4 + 3] * inv); *(GAS v2u*)(op + 32 + 8 * r4) = w2; }
                }
            }
            grid.sync();
            { PHASE_PTRS pg8::Gemm g{AO, Wo_t, TT, DM, DM}; pg8::StaticOrder S; S.init(TT, DM, G, bx); EpiPlain E{MB, DM};
              pg8::gemm_phase<EpiPlain, pg8::StaticOrder, true, true>(L, g, S, E); }
            grid.sync();
            { PHASE_IDS PHASE_PTRS for (int m = gw; m < TT; m += NGW) norm_row(MB + (size_t)m * DM, out + O_Y + (size_t)m * DM, out + O_Y + (size_t)m * DM, XN + (size_t)m * DM, norm_w + (4 + 1) * DM, lane, true); }
            grid.sync();
        }
        { PHASE_PTRS pg8::Gemm g{XN, Wf1_t + (size_t)layer * FF2 * DM, TT, FF2, DM}; pg8::StaticOrder S; S.init(TT, FF2, G, bx); EpiSwiGLU E{HB};
          pg8::gemm_phase<EpiSwiGLU, pg8::StaticOrder, true, true>(L, g, S, E); }
        grid.sync();
        { PHASE_PTRS pg8::Gemm g{HB, Wf2_t + (size_t)layer * DM * FF, TT, DM, FF}; pg8::StaticOrder S; S.init(TT, DM, G, bx); EpiPlain E{MB, DM};
          pg8::gemm_phase<EpiPlain, pg8::StaticOrder, true, true>(L, g, S, E); }
        grid.sync();
        { PHASE_IDS PHASE_PTRS
        for (int m = gw; m < TT; m += NGW) norm_row(MB + (size_t)m * DM, out + O_Y + (size_t)m * DM, out + O_Y + (size_t)m * DM, XN + (size_t)m * DM, norm_w + (layer * 4 + 3) * DM, lane, layer == 0);
        if (layer == 0) {
            const float* cache_k = ap_->in[4]; const float* cache_v = ap_->in[5];
            for (size_t i = gtid; i < (size_t)16 * 512 * 16 * 8; i += gsz) { const int d8 = i & 7, hd = (i >> 3) & 15, r = (i >> 7) & 511, b = (int)(i >> 16);
                const float* s = cache_k + ((size_t)((b * 512 + r) * 16 + hd)) * 64 + 8 * d8; const f32x4 v0 = *(const GAS f32x4*)s, v1 = *(const GAS f32x4*)(s + 4);
                v4u w; w.x = pk2(v0[0], v0[1]); w.y = pk2(v0[2], v0[3]); w.z = pk2(v1[0], v1[1]); w.w = pk2(v1[2], v1[3]);
                *(GAS v4u*)(KHs + ((size_t)((b * AH + hd) * SKV + r)) * 64 + 8 * d8) = w; }
            for (int it = gw; it < 16 * 16 * 64; it += NGW) { const int r8 = it & 63, hd = (it >> 6) & 15, b = it >> 10;
                float v[8];
#pragma unroll
                for (int e = 0; e < 8; ++e) v[e] = cache_v[((size_t)((b * 512 + 8 * r8 + e) * 16 + hd)) * 64 + lane];
                v4u w; w.x = pk2(v[0], v[1]); w.y = pk2(v[2], v[3]); w.z = pk2(v[4], v[5]); w.w = pk2(v[6], v[7]);
                *(GAS v4u*)(VTs + ((size_t)((b * AH + hd) * 64 + lane)) * SKV + 8 * r8) = w; }
        } }
        if (layer == 0) grid.sync();
    }
}

extern "C" void kernel_launch(void* const* d_in, const int* in_sizes, int n_in, void* d_out, int out_size, void* d_ws, size_t ws_size, hipStream_t stream) {
    static int grid = 0;
    if (grid == 0) {
        int dev = 0, cus = 0, per_cu = 0;
        (void)hipGetDevice(&dev);
        (void)hipDeviceGetAttribute(&cus, hipDeviceAttributeMultiprocessorCount, dev);
        (void)hipFuncSetAttribute((const void*)mk_fwd, hipFuncAttributeMaxDynamicSharedMemorySize, LDS_BYTES);
        (void)hipOccupancyMaxActiveBlocksPerMultiprocessor(&per_cu, (const void*)mk_fwd, NTHREADS, LDS_BYTES);
        fprintf(stderr, "kernel_launch: cus %d per_cu %d ws_size %zu n_in %d out_size %d\n", cus, per_cu, ws_size, n_in, out_size);
        if (ws_size < WS_END || n_in != 22 || (size_t)out_size != O_TOTAL) { fprintf(stderr, "kernel_launch: unexpected sizes\n"); grid = -1; return; }
        grid = cus;
    }
    if (grid < 0) return;
    (void)hipMemsetAsync((char*)d_ws + WS_CTL, 0, 1 * MiB, stream);
    Args a{};
    for (int i = 0; i < 22; ++i) a.in[i] = (const float*)d_in[i];
    a.out = (float*)d_out; a.ws = (unsigned char*)d_ws; a.dbg = 0; a.pad = 0;
    void* args[] = {&a};
    hipError_t e = hipLaunchCooperativeKernel((const void*)mk_fwd, dim3(grid), dim3(NTHREADS), args, LDS_BYTES, stream);
    if (e != hipSuccess) fprintf(stderr, "cooperative launch failed: %s (grid %d)\n", hipGetErrorString(e), grid);
}
```

```cpp
#include <hip/hip_runtime.h>
#include <hip/hip_cooperative_groups.h>
#include <cstdio>
#include <cstdint>
namespace cg = cooperative_groups;
#define PROF_K (-1)

__device__ __forceinline__ int fresh_lane() { unsigned z = 0u; asm volatile("" : "+v"(z)); return (int)__builtin_amdgcn_mbcnt_hi(~0u, __builtin_amdgcn_mbcnt_lo(~0u, z)); }
namespace pg8 {
#define PG8_LAS __attribute__((address_space(3)))
typedef unsigned short bf16_t;
typedef short bf16x8 __attribute__((ext_vector_type(8)));
typedef float f32x4 __attribute__((ext_vector_type(4)));
typedef unsigned u32x4 __attribute__((ext_vector_type(4)));
constexpr int BM = 256, BK = 64, HALF = 128, HTB = HALF * BK * 2, STAGE_BYTES = 8 * HTB, NXCD = 8, WGM = 8;

__host__ __device__ __forceinline__ int lds_byte(int r, int c) { const int st = (r >> 4) * 2 + (c >> 5), rr = r & 15, cc = c & 31, ob = rr * 64 + cc * 2; return st * 1024 + (ob ^ (((ob >> 9) & 1) << 5)); }
__host__ __device__ __forceinline__ void stage_rc(int b, int& R, int& C) { const int st = b / 1024, sb = b % 1024, swz = sb ^ (((sb >> 9) & 1) << 5); R = (st >> 1) * 16 + swz / 64; C = (st & 1) * 32 + (swz % 64) / 2; }
__host__ __device__ __forceinline__ int perm32(int rho) { const int n = rho >> 4, i = rho & 15; return 8 * (i >> 2) + 4 * n + (i & 3); }

struct Unit { int pm, pn, w; };
struct Gemm { const bf16_t* A; const bf16_t* Bt; int M, N, K, ld; };

struct StaticOrder {
    int nM, nN, nwg, G, c;
    __host__ __device__ void init(int M, int N, int G_, int c_) { nM = M / BM; nN = N / BM; nwg = nM * nN; G = G_; c = c_; }
    __host__ __device__ bool next(int i, Unit& u) const {
        const long L = (long)i * G + c; if (L >= nwg) return false;
        int wgid = (int)L; { const int q = nwg / NXCD, r = nwg % NXCD, xcd = wgid % NXCD, off = wgid / NXCD; wgid = (xcd < r ? xcd * (q + 1) : r * (q + 1) + (xcd - r) * q) + off; }
        const int nig = WGM * nN, gid = wgid / nig, fm = gid * WGM, gsz = (nM - fm) < WGM ? (nM - fm) : WGM;
        u.pm = fm + ((wgid % nig) % gsz); u.pn = (wgid % nig) / gsz; u.w = 0; return true;
    }
    __device__ __forceinline__ void a_ready(const Unit&) const {}
    __device__ __forceinline__ void done(const Unit&) const {}
    __device__ __forceinline__ long offA(const Unit&) const { return 0; }
    __device__ __forceinline__ long offB(const Unit&) const { return 0; }
    __device__ __forceinline__ int nt(const Unit&, int d) const { return d; }
};
struct SplitOrder2 {
    int c; long koff;
    __device__ __forceinline__ bool next(int i, Unit& u) const { if (i > 0 || c >= 32) return false; const int t = c >> 1; u.pm = t >> 2; u.pn = t & 3; u.w = c & 1; return true; }
    __device__ __forceinline__ void a_ready(const Unit&) const {}
    __device__ __forceinline__ void done(const Unit&) const {}
    __device__ __forceinline__ long offA(const Unit& u) const { return u.w ? koff : 0; }
    __device__ __forceinline__ long offB(const Unit& u) const { return u.w ? koff : 0; }
    __device__ __forceinline__ int nt(const Unit&, int d) const { return d; }
};
struct DualOrder {
    int nM0, nN0, nM1, nN1, n0, n1, G, c; long dA, dB;
    __device__ __forceinline__ void init(int M0, int N0, int M1, int N1, int G_, int c_) { nM0 = M0 / BM; nN0 = N0 / BM; nM1 = M1 / BM; nN1 = N1 / BM; n0 = nM0 * nN0; n1 = nM1 * nN1; G = G_; c = c_; }
    __device__ __forceinline__ bool next(int i, Unit& u) const {
        const int Lx = i * G + c; if (Lx >= n0 + n1) return false;
        const int w = Lx >= n0 ? 1 : 0; const int nwg = w ? n1 : n0, nN = w ? nN1 : nN0, nM = w ? nM1 : nM0;
        int wgid = w ? Lx - n0 : Lx; { const int q = nwg / NXCD, r = nwg % NXCD, xcd = wgid % NXCD, off = wgid / NXCD; wgid = (xcd < r ? xcd * (q + 1) : r * (q + 1) + (xcd - r) * q) + off; }
        const int nig = WGM * nN, gid = wgid / nig, fm = gid * WGM, gsz = (nM - fm) < WGM ? (nM - fm) : WGM;
        u.pm = fm + ((wgid % nig) % gsz); u.pn = (wgid % nig) / gsz; u.w = w; return true; }
    __device__ __forceinline__ void a_ready(const Unit&) const {}
    __device__ __forceinline__ void done(const Unit&) const {}
    __device__ __forceinline__ long offA(const Unit& u) const { return u.w ? dA : 0; }
    __device__ __forceinline__ long offB(const Unit& u) const { return u.w ? dB : 0; }
    __device__ __forceinline__ int nt(const Unit&, int d) const { return d; }
};
struct KqvtOrder {
    int G, c; long dA, dB;
    __device__ __forceinline__ bool next(int i, Unit& u) const {
        const int Lx = i * G + c; if (Lx >= 1728) return false;
        if (Lx >= 1536) { const int q = Lx - 1536, kq = q & 3, tile = q >> 2;
            if (tile < 32) { u.pm = 128 + (tile >> 3); u.pn = tile & 7; u.w = 2 + 2 * kq; } else { const int t2 = tile - 32; u.pm = t2 >> 2; u.pn = 128 + (t2 & 3); u.w = 3 + 2 * kq; }
            return true; }
        const int w = Lx >= 1024 ? 1 : 0; const int nwg = w ? 512 : 1024, nN = w ? 128 : 8, nM = w ? 4 : 128;
        int wgid = w ? Lx - 1024 : Lx; { const int q = nwg / NXCD, xcd = wgid % NXCD, off = wgid / NXCD; wgid = xcd * q + off; }
        const int nig = WGM * nN, gid = wgid / nig, fm = gid * WGM, gsz = (nM - fm) < WGM ? (nM - fm) : WGM;
        u.pm = fm + ((wgid % nig) % gsz); u.pn = (wgid % nig) / gsz; u.w = w; return true; }
    __device__ __forceinline__ void a_ready(const Unit&) const {}
    __device__ __forceinline__ void done(const Unit&) const {}
    __device__ __forceinline__ long offA(const Unit& u) const { return ((u.w & 1) ? dA : 0) + (u.w >= 2 ? (long)((u.w - 2) >> 1) * 512 : 0); }
    __device__ __forceinline__ long offB(const Unit& u) const { return ((u.w & 1) ? dB : 0) + (u.w >= 2 ? (long)((u.w - 2) >> 1) * 512 : 0); }
    __device__ __forceinline__ int nt(const Unit& u, int d) const { return u.w >= 2 ? 4 : d; }
};

template <class Epi, class Sched, bool ALIGN_EPI = false, bool SP2 = false>
__device__ __forceinline__ void gemm_phase(PG8_LAS unsigned char* lds, const Gemm g, const Sched& S, const Epi& E, int wave_id) {
    int tid_ = wave_id * 64 + fresh_lane(); asm volatile("" : "+v"(tid_));
    const int tid = tid_, wid = __builtin_amdgcn_readfirstlane(tid >> 6), lane = tid & 63, wr = wid >> 2, wc = wid & 3, fr = lane & 15, fq = lane >> 4;
    const int K = g.K, nt = K / BK;
    unsigned voffA[2], voffB[2];
#pragma unroll
    for (int i = 0; i < 2; ++i) { int R, C; stage_rc(tid * 16 + i * 8192, R, C); const int Rb = Epi::PERM ? ((R & ~31) + perm32(R & 31)) : R;
        voffA[i] = (unsigned)(R * g.ld + C) * 2u; voffB[i] = (unsigned)(Rb * g.ld + C) * 2u; }
    const size_t kstep = (size_t)(BK * 2);
    const size_t hstep = (size_t)HALF * g.ld * 2;
    const size_t tstep = 2 * hstep;
    const unsigned ldsw = (unsigned)wid * 1024u;
    const int aoff = lds_byte(wr * 64 + fr, fq * 8), boff = lds_byte(wc * 32 + fr, fq * 8);
#define PG8_SA(b, h) (((b) * 2 + (h)) * HTB)
#define PG8_SB(b, h) ((4 + (b) * 2 + (h)) * HTB)
#define PG8_STAGE(bufoff, gbase, voff) do { _Pragma("unroll") for (int _i = 0; _i < 2; ++_i) \
        __builtin_amdgcn_global_load_lds((const unsigned*)((const char*)(gbase) + (voff)[_i]), (PG8_LAS unsigned*)(lds + (bufoff) + ldsw + _i * 8192), 16, 0, 0); } while (0)
#define PG8_LDA(dst, b, h) do { _Pragma("unroll") for (int m = 0; m < 4; ++m) _Pragma("unroll") for (int k = 0; k < 2; ++k) dst[m][k] = *(const PG8_LAS bf16x8*)(lds + PG8_SA(b, h) + aoff + m * 2048 + k * 1024); } while (0)
#define PG8_LDB(dst, b, h) do { _Pragma("unroll") for (int n = 0; n < 2; ++n) _Pragma("unroll") for (int k = 0; k < 2; ++k) dst[n][k] = *(const PG8_LAS bf16x8*)(lds + PG8_SB(b, h) + boff + n * 2048 + k * 1024); } while (0)
#define PG8_MMA(ai, bj, At, Bt) do { __builtin_amdgcn_s_setprio(1); _Pragma("unroll") for (int m = 0; m < 4; ++m) _Pragma("unroll") for (int n = 0; n < 2; ++n) _Pragma("unroll") for (int k = 0; k < 2; ++k) \
        acc[ai][bj][m][n] = __builtin_amdgcn_mfma_f32_16x16x32_bf16(Bt[n][k], At[m][k], acc[ai][bj][m][n], 0, 0, 0); __builtin_amdgcn_s_setprio(0); } while (0)
#define PG8_WAIT_V(n) asm volatile("s_waitcnt vmcnt(" #n ")" ::: "memory")
#define PG8_WAIT_L(n) asm volatile("s_waitcnt lgkmcnt(" #n ")" ::: "memory")
#define PG8_BAR __builtin_amdgcn_s_barrier()
#define PG8_SCHED __builtin_amdgcn_sched_barrier(0)
    Unit cur, nxt; int ui = 0;
    if (!S.next(0, cur)) return;
    f32x4 acc[2][2][4][2];
#pragma unroll
    for (int a = 0; a < 2; ++a)
#pragma unroll
        for (int b = 0; b < 2; ++b)
#pragma unroll
            for (int m = 0; m < 4; ++m)
#pragma unroll
                for (int n = 0; n < 2; ++n) acc[a][b][m][n] = (f32x4){0.f, 0.f, 0.f, 0.f};
    bf16x8 At[4][2], B0[2][2], B1[2][2];
    const char* cA = (const char*)g.A + (size_t)cur.pm * tstep + S.offA(cur); const char* cB = (const char*)g.Bt + (size_t)cur.pn * tstep + S.offB(cur);
    S.a_ready(cur);
    if constexpr (SP2) {
        PG8_STAGE(PG8_SB(0, 0), cB, voffB); PG8_STAGE(PG8_SB(0, 1), cB + hstep, voffB); PG8_STAGE(PG8_SA(0, 0), cA, voffA); PG8_STAGE(PG8_SA(0, 1), cA + hstep, voffA);
        if (wr == 1) PG8_BAR;
        PG8_WAIT_V(2); PG8_BAR;
        PG8_STAGE(PG8_SB(1, 0), cB + kstep, voffB); PG8_STAGE(PG8_SA(1, 0), cA + kstep, voffA); PG8_STAGE(PG8_SB(1, 1), cB + hstep + kstep, voffB);
        PG8_WAIT_V(6); PG8_BAR;
    } else {
        PG8_STAGE(PG8_SB(0, 0), cB, voffB); PG8_STAGE(PG8_SA(0, 0), cA, voffA); PG8_STAGE(PG8_SB(0, 1), cB + hstep, voffB); PG8_STAGE(PG8_SA(0, 1), cA + hstep, voffA);
        if (wr == 1) PG8_BAR;
        PG8_WAIT_V(4); PG8_BAR;
        PG8_STAGE(PG8_SB(1, 0), cB + kstep, voffB); PG8_STAGE(PG8_SA(1, 0), cA + kstep, voffA); PG8_STAGE(PG8_SB(1, 1), cB + hstep + kstep, voffB);
        PG8_WAIT_V(6); PG8_BAR;
    }
    for (;;) {
        const bool has_next = S.next(ui + 1, nxt);
        const char* nA = has_next ? (const char*)g.A + (size_t)nxt.pm * tstep + S.offA(nxt) : cA; const char* nB = has_next ? (const char*)g.Bt + (size_t)nxt.pn * tstep + S.offB(nxt) : cB;
        const int ntc = S.nt(cur, nt);
        for (int t = 0; t < ntc; t += 2) {
            const bool last = (t == ntc - 2);
            const char* a1 = cA + (size_t)(t + 1) * kstep;
            const char* a2 = last ? nA : cA + (size_t)(t + 2) * kstep; const char* b2 = last ? nB : cB + (size_t)(t + 2) * kstep;
            const char* a3 = a2 + kstep; const char* b3 = b2 + kstep;
            if (last && has_next) S.a_ready(nxt);
            if constexpr (Epi::KSCALE) { if (t == 0) E.unit_begin(cur, ui, lds, tid); else if ((t & 7) == 0) E.kscale(acc, ui, t >> 3, lds, wr, fr); }
            if constexpr (SP2) {
            PG8_LDB(B0, 0, 0); PG8_LDB(B1, 0, 1); PG8_SCHED; PG8_LDA(At, 0, 0); PG8_STAGE(PG8_SA(1, 1), a1 + hstep, voffA);
            PG8_WAIT_V(8); PG8_WAIT_L(0); PG8_BAR; PG8_MMA(0, 0, At, B0); PG8_MMA(0, 1, At, B1); PG8_BAR; PG8_SCHED;
            PG8_LDA(At, 0, 1); PG8_STAGE(PG8_SB(0, 0), b2, voffB); PG8_STAGE(PG8_SB(0, 1), b2 + hstep, voffB); PG8_STAGE(PG8_SA(0, 0), a2, voffA);
            PG8_WAIT_V(8); PG8_WAIT_L(0); PG8_BAR; PG8_MMA(1, 0, At, B0); PG8_MMA(1, 1, At, B1); PG8_BAR; PG8_SCHED;
            PG8_LDB(B0, 1, 0); PG8_LDB(B1, 1, 1); PG8_SCHED; PG8_LDA(At, 1, 0); PG8_STAGE(PG8_SA(0, 1), a2 + hstep, voffA);
            PG8_WAIT_V(8); PG8_WAIT_L(0); PG8_BAR; PG8_MMA(0, 0, At, B0); PG8_MMA(0, 1, At, B1); PG8_BAR; PG8_SCHED;
            PG8_LDA(At, 1, 1); PG8_STAGE(PG8_SB(1, 0), b3, voffB); PG8_STAGE(PG8_SB(1, 1), b3 + hstep, voffB); PG8_STAGE(PG8_SA(1, 0), a3, voffA);
            PG8_WAIT_V(8); PG8_WAIT_L(0); PG8_BAR; PG8_MMA(1, 0, At, B0); PG8_MMA(1, 1, At, B1); PG8_BAR; PG8_SCHED;
            } else {
            PG8_LDB(B0, 0, 0); PG8_SCHED; PG8_LDA(At, 0, 0); PG8_STAGE(PG8_SA(1, 1), a1 + hstep, voffA);
            PG8_WAIT_L(8); PG8_BAR; PG8_WAIT_L(0); PG8_MMA(0, 0, At, B0); PG8_BAR; PG8_SCHED;
            PG8_LDB(B1, 0, 1); PG8_STAGE(PG8_SB(0, 0), b2, voffB);
            PG8_BAR; PG8_WAIT_L(0); PG8_MMA(0, 1, At, B1); PG8_BAR;
            PG8_LDA(At, 0, 1); PG8_STAGE(PG8_SA(0, 0), a2, voffA);
            PG8_BAR; PG8_WAIT_L(0); PG8_MMA(1, 0, At, B0); PG8_BAR; PG8_SCHED;
            PG8_STAGE(PG8_SB(0, 1), b2 + hstep, voffB);
            PG8_WAIT_V(6); PG8_BAR; PG8_MMA(1, 1, At, B1); PG8_BAR;
            PG8_LDB(B0, 1, 0); PG8_SCHED; PG8_LDA(At, 1, 0); PG8_STAGE(PG8_SA(0, 1), a2 + hstep, voffA);
            PG8_WAIT_L(8); PG8_BAR; PG8_WAIT_L(0); PG8_MMA(0, 0, At, B0); PG8_BAR; PG8_SCHED;
            PG8_LDB(B1, 1, 1); PG8_STAGE(PG8_SB(1, 0), b3, voffB);
            PG8_BAR; PG8_WAIT_L(0); PG8_MMA(0, 1, At, B1); PG8_BAR;
            PG8_LDA(At, 1, 1); PG8_STAGE(PG8_SA(1, 0), a3, voffA);
            PG8_BAR; PG8_WAIT_L(0); PG8_MMA(1, 0, At, B0); PG8_BAR; PG8_SCHED;
            PG8_STAGE(PG8_SB(1, 1), b3 + hstep, voffB);
            PG8_WAIT_V(6); PG8_BAR; PG8_MMA(1, 1, At, B1); PG8_BAR;
            }
        }
        if constexpr (ALIGN_EPI) { if (wr == 0) PG8_BAR; }
        if constexpr (Epi::KSCALE) E.final(acc, cur, ui, lds, wr, wc, fr, fq); else E(acc, cur, wr, wc, fr, fq);
        S.done(cur);
        if (!has_next) break;
#pragma unroll
        for (int a = 0; a < 2; ++a)
#pragma unroll
            for (int b = 0; b < 2; ++b)
#pragma unroll
                for (int m = 0; m < 4; ++m)
#pragma unroll
                    for (int n = 0; n < 2; ++n) acc[a][b][m][n] = (f32x4){0.f, 0.f, 0.f, 0.f};
        cur = nxt; cA = nA; cB = nB; ++ui;
        if constexpr (ALIGN_EPI) { if (wr == 1) PG8_BAR; }
    }
    PG8_WAIT_V(0);
    if constexpr (!ALIGN_EPI) { if (wr == 0) PG8_BAR; }
    PG8_BAR;
#undef PG8_SA
#undef PG8_SB
#undef PG8_STAGE
#undef PG8_LDA
#undef PG8_LDB
#undef PG8_MMA
#undef PG8_WAIT_V
#undef PG8_WAIT_L
#undef PG8_BAR
#undef PG8_SCHED
}
}

constexpr int NTHREADS = 512, NWAVES = 8;
constexpr int LDS_BYTES = 147456;
constexpr int DM = 1024, TP = 32768, TS = 1024, TT = TP + TS;
constexpr int DI = 2048, NH = 32, HD = 64, NG = 4, NS = 128, CONVD = 3072, INPROJ = 5152, INPROJ_PAD = 5376;
constexpr int FF = 2816, FF2 = 5632;
constexpr int AH = 16;
constexpr float EPS = 1e-6f;
constexpr size_t O_Y = 0, O_SSM_P = 34603008, O_CONV_P = 38797312, O_CK_P = 38944768, O_CV_P = 47333376,
                 O_SSM_S = 55721984, O_CONV_S = 59916288, O_CK_S = 60063744, O_CV_S = 61112320, O_TOTAL = 62160896;
constexpr size_t MiB = 1u << 20;
constexpr size_t WS_CTL = 0;
constexpr size_t WS_WIN = 2 * MiB;
constexpr size_t WS_WOUT = WS_WIN + (size_t)INPROJ_PAD * DM * 2;
constexpr size_t WS_WF1 = WS_WOUT + (size_t)DM * DI * 2;
constexpr size_t WS_WF2 = WS_WF1 + 2 * (size_t)FF2 * DM * 2;
constexpr size_t WS_WKQ = WS_WF2 + 2 * (size_t)DM * FF * 2;
constexpr size_t WS_WV = WS_WKQ + (size_t)2048 * DM * 2;
constexpr size_t WS_WO = WS_WV + (size_t)DM * DM * 2;
constexpr size_t WS_WEND = WS_WO + (size_t)DM * DM * 2;
constexpr size_t WS_SSQ = 60 * MiB;
constexpr size_t WS_XN = 64 * MiB;
constexpr size_t WS_R = 130 * MiB;
constexpr size_t WS_Z = WS_R;
constexpr size_t WS_XBC = WS_R + 132 * MiB;
constexpr size_t WS_DT = WS_R + 330 * MiB;
constexpr size_t WS_END = WS_R + 336 * MiB;
constexpr size_t WS_M = WS_R + 264 * MiB;
constexpr size_t WS_H = WS_R;
constexpr size_t WS_KHP = WS_R, WS_QHP = WS_R + 64 * MiB, WS_VTP = WS_R + 128 * MiB;
constexpr size_t WS_KHS = WS_END, WS_VTS = WS_END + 18 * MiB, WS_QHS = WS_END + 36 * MiB, WS_END2 = WS_END + 38 * MiB, WS_SLAB = WS_END2, WS_END3 = WS_END2 + 8 * MiB;
constexpr size_t WS_AO = WS_R + 192 * MiB;
constexpr size_t WS_SQ = 61 * MiB;
constexpr int SKV = 576;
static_assert(WS_WEND <= WS_SSQ, "weights overflow");

#define GAS __attribute__((address_space(1)))
#define LAS __attribute__((address_space(3)))
typedef unsigned short bf16;
typedef unsigned v4u __attribute__((ext_vector_type(4)));
typedef unsigned v2u __attribute__((ext_vector_type(2)));
typedef float f32x4 __attribute__((ext_vector_type(4)));
typedef short bf16x8 __attribute__((ext_vector_type(8)));
#define LDS_WAIT() asm volatile("s_waitcnt lgkmcnt(0)" ::: "memory")

__device__ __forceinline__ unsigned f2bf(float f) { unsigned u = __builtin_bit_cast(unsigned, f); return (u + 0x7fffu + ((u >> 16) & 1u)) >> 16; }
typedef float f32x2_t __attribute__((ext_vector_type(2))); typedef __bf16 bf16x2_t __attribute__((ext_vector_type(2)));
__device__ __forceinline__ unsigned pk2(float lo, float hi) { const f32x2_t v = {lo, hi}; const bf16x2_t b = __builtin_convertvector(v, bf16x2_t); return __builtin_bit_cast(unsigned, b); }
__device__ __forceinline__ float bflo(unsigned u) { return __builtin_bit_cast(float, u << 16); }
__device__ __forceinline__ float bfhi(unsigned u) { return __builtin_bit_cast(float, u & 0xffff0000u); }
__device__ __forceinline__ float wave_sum(float v) {
#pragma unroll
    for (int o = 1; o < 64; o <<= 1) v += __shfl_xor(v, o);
    return v;
}

__device__ __forceinline__ float xor32_f(float v) { const auto rr = __builtin_amdgcn_permlane32_swap(__builtin_bit_cast(unsigned, v), __builtin_bit_cast(unsigned, v), false, false); const unsigned lo = rr[0], hi = rr[1];
    return __builtin_bit_cast(float, (fresh_lane() & 32) ? lo : hi); }
#define DPP_ADD(x, ctrl, rmask) ((x) + __builtin_bit_cast(float, __builtin_amdgcn_update_dpp(0, __builtin_bit_cast(int, (x)), (ctrl), (rmask), 0xf, false)))
__device__ __forceinline__ float wave_scan_incl(float x) {
    x = DPP_ADD(x, 0x111, 0xf); x = DPP_ADD(x, 0x112, 0xf); x = DPP_ADD(x, 0x114, 0xf); x = DPP_ADD(x, 0x118, 0xf);
    x = DPP_ADD(x, 0x142, 0xa); x = DPP_ADD(x, 0x143, 0xc); return x; }
__device__ __forceinline__ float xor32_max_(float v) { const auto rr = __builtin_amdgcn_permlane32_swap(__builtin_bit_cast(unsigned, v), __builtin_bit_cast(unsigned, v), false, false); return fmaxf(__builtin_bit_cast(float, (unsigned)rr[0]), __builtin_bit_cast(float, (unsigned)rr[1])); }
__device__ __forceinline__ float xor32_sum_(float v) { const auto rr = __builtin_amdgcn_permlane32_swap(__builtin_bit_cast(unsigned, v), __builtin_bit_cast(unsigned, v), false, false); return __builtin_bit_cast(float, (unsigned)rr[0]) + __builtin_bit_cast(float, (unsigned)rr[1]); }
__device__ __forceinline__ float max3f_(float a, float b, float c) { float r; asm("v_max3_f32 %0, %1, %2, %3" : "=v"(r) : "v"(a), "v"(b), "v"(c)); return r; }
struct Args { const float* in[22]; float* out; unsigned char* ws; int dbg; int pad; };

__device__ __forceinline__ void tr_item(const float* W, int Nsrc, int K, bf16* WT, int r0, int c0, int k0, const float* kscale, float cmul, LAS float* scr, int lane) {
    const int kq = lane >> 3, n4 = (lane & 7) * 4;
    f32x4 v[8]; float sc[8];
#pragma unroll
    for (int i = 0; i < 8; ++i) { const int kk = kq + 8 * i;
        v[i] = (c0 >= 0) ? __builtin_nontemporal_load((const GAS f32x4*)(W + (size_t)(k0 + kk) * Nsrc + c0 + n4)) : (f32x4){0.f, 0.f, 0.f, 0.f};
        sc[i] = kscale ? kscale[k0 + kk] * cmul : cmul; }
#pragma unroll
    for (int i = 0; i < 8; ++i) { const int kk = kq + 8 * i; LAS float* d = scr + kk * 33 + n4; d[0] = v[i][0] * sc[i]; d[1] = v[i][1] * sc[i]; d[2] = v[i][2] * sc[i]; d[3] = v[i][3] * sc[i]; }
    LDS_WAIT(); asm volatile("" ::: "memory");
    const int c = lane & 7;
#pragma unroll
    for (int j = 0; j < 4; ++j) { const int n = (lane >> 3) + 8 * j; const LAS float* s = scr + (8 * c) * 33 + n;
        v4u o; o.x = pk2(s[0 * 33], s[1 * 33]); o.y = pk2(s[2 * 33], s[3 * 33]); o.z = pk2(s[4 * 33], s[5 * 33]); o.w = pk2(s[6 * 33], s[7 * 33]);
        *(GAS v4u*)(WT + (size_t)(r0 + n) * K + k0 + 8 * c) = o; }
    LDS_WAIT(); asm volatile("" ::: "memory");
}
__device__ __forceinline__ void rms_row2_to_bf16(const float* xrow, bf16* orow, int lane) {
    f32x4 v[2][4]; float s[2] = {0.f, 0.f};
#pragma unroll
    for (int r = 0; r < 2; ++r)
#pragma unroll
        for (int j = 0; j < 4; ++j) { v[r][j] = __builtin_nontemporal_load((const GAS f32x4*)(xrow + r * DM + 4 * lane + 256 * j)); s[r] += (v[r][j].x * v[r][j].x + v[r][j].y * v[r][j].y) + (v[r][j].z * v[r][j].z + v[r][j].w * v[r][j].w); }
#pragma unroll
    for (int r = 0; r < 2; ++r) { const float rstd = __builtin_amdgcn_rsqf(wave_sum(s[r]) * (1.f / DM) + EPS);
#pragma unroll
        for (int j = 0; j < 4; ++j) { v2u o; o.x = pk2(v[r][j].x * rstd, v[r][j].y * rstd); o.y = pk2(v[r][j].z * rstd, v[r][j].w * rstd); *(GAS v2u*)(orow + r * DM + 4 * lane + 256 * j) = o; } }
}

struct EpiInProj {
    static constexpr bool PERM = true, KSCALE = false;
    bf16* Z; bf16* XBC; float* DT; float* out;
    __device__ __forceinline__ void operator()(const f32x4 (&acc)[2][2][4][2], const pg8::Unit& u, int wr, int wc, int fr, int fq) const {
        const int row0 = u.pm * 256 + wr * 64 + fr; const int ct = u.pn; const int cl = wc * 32 + 8 * fq;
#pragma unroll
        for (int ai = 0; ai < 2; ++ai)
#pragma unroll
            for (int m = 0; m < 4; ++m) {
                const int row = row0 + ai * 128 + m * 16;
#pragma unroll
                for (int bj = 0; bj < 2; ++bj) {
                    const f32x4 v0 = acc[ai][bj][m][0], v1 = acc[ai][bj][m][1];
                    v4u w; w.x = pk2(v0[0], v0[1]); w.y = pk2(v0[2], v0[3]); w.z = pk2(v1[0], v1[1]); w.w = pk2(v1[2], v1[3]);
                    const int c = bj * 128 + cl;
                    if (ct < 8) { *(GAS v4u*)(Z + (size_t)row * DI + ct * 256 + c) = w; }
                    else if (ct < 20) {
                        const int col = (ct - 8) * 256 + c;
                        *(GAS v4u*)(XBC + (size_t)row * CONVD + col) = w;
                        int pos, b; size_t ob; int L;
                        if (row < TP) { b = row >> 11; pos = row & 2047; L = 2048; ob = O_CONV_P; } else { b = (row - TP) >> 6; pos = (row - TP) & 63; L = 64; ob = O_CONV_S; }
                        if (pos >= L - 3) { float* o = out + ob + (size_t)(b * 3 + (pos - (L - 3))) * CONVD + col; *(GAS f32x4*)o = v0; *(GAS f32x4*)(o + 4) = v1; }
                    } else {
                        if (bj == 0 && wc == 0) { float* o = DT + (size_t)row * 32 + 8 * fq; *(GAS f32x4*)o = v0; *(GAS f32x4*)(o + 4) = v1; }
                    }
                }
            }
    }
};

struct EpiPlain {
    static constexpr bool PERM = true, KSCALE = false;
    bf16* O; int ldc;
    __device__ __forceinline__ void operator()(const f32x4 (&acc)[2][2][4][2], const pg8::Unit& u, int wr, int wc, int fr, int fq) const {
        const int row0 = u.pm * 256 + wr * 64 + fr, col0 = u.pn * 256 + wc * 32 + 8 * fq;
#pragma unroll
        for (int ai = 0; ai < 2; ++ai)
#pragma unroll
            for (int m = 0; m < 4; ++m) { bf16* rowp = O + (size_t)(row0 + ai * 128 + m * 16) * ldc + col0;
#pragma unroll
                for (int bj = 0; bj < 2; ++bj) { const f32x4 v0 = acc[ai][bj][m][0], v1 = acc[ai][bj][m][1];
                    v4u w; w.x = pk2(v0[0], v0[1]); w.y = pk2(v0[2], v0[3]); w.z = pk2(v1[0], v1[1]); w.w = pk2(v1[2], v1[3]);
                    *(GAS v4u*)(rowp + bj * 128) = w; } }
    }
};
constexpr int KS_OFF = 135168;
struct EpiOutProj {
    static constexpr bool PERM = true, KSCALE = true;
    bf16* O; int ldc; const float* ssq;
    __device__ __forceinline__ void unit_begin(const pg8::Unit& u, int ui, PG8_LAS unsigned char* lds, int tid) const {
        asm volatile("" : "+v"(tid));
        if (tid < 256) { const f32x4 v = *(const GAS f32x4*)(ssq + (size_t)(u.pm * 256 + tid) * 4);
            const float a0 = v[0] * (1.f / 512.f) + EPS, a1 = v[1] * (1.f / 512.f) + EPS, a2 = v[2] * (1.f / 512.f) + EPS, a3 = v[3] * (1.f / 512.f) + EPS;
            f32x4 r; r[0] = __builtin_amdgcn_rsqf(a0) * __builtin_amdgcn_sqrtf(a1); r[1] = __builtin_amdgcn_rsqf(a1) * __builtin_amdgcn_sqrtf(a2); r[2] = __builtin_amdgcn_rsqf(a2) * __builtin_amdgcn_sqrtf(a3); r[3] = __builtin_amdgcn_rsqf(a3);
            *(PG8_LAS f32x4*)(lds + KS_OFF + (ui & 1) * 4096 + tid * 16) = r; }
    }
    __device__ __forceinline__ void kscale(f32x4 (&acc)[2][2][4][2], int ui, int g, PG8_LAS unsigned char* lds, int wr, int fr) const {
        asm volatile("" : "+v"(fr));
        const PG8_LAS float* rt = (const PG8_LAS float*)(lds + KS_OFF + (ui & 1) * 4096) + (wr * 64 + fr) * 4 + (g - 1);
#pragma unroll
        for (int ai = 0; ai < 2; ++ai)
#pragma unroll
            for (int m = 0; m < 4; ++m) { const float ratio = rt[(ai * 128 + m * 16) * 4];
#pragma unroll
                for (int bj = 0; bj < 2; ++bj)
#pragma unroll
                    for (int n = 0; n < 2; ++n) acc[ai][bj][m][n] = acc[ai][bj][m][n] * ratio; }
    }
    __device__ __forceinline__ void final(const f32x4 (&acc)[2][2][4][2], const pg8::Unit& u, int ui, PG8_LAS unsigned char* lds, int wr, int wc, int fr, int fq) const {
        asm volatile("" : "+v"(fr), "+v"(fq));
        const int row0 = u.pm * 256 + wr * 64 + fr, col0 = u.pn * 256 + wc * 32 + 8 * fq;
        const PG8_LAS float* rt = (const PG8_LAS float*)(lds + KS_OFF + (ui & 1) * 4096) + (wr * 64 + fr) * 4 + 3;
#pragma unroll
        for (int ai = 0; ai < 2; ++ai)
#pragma unroll
            for (int m = 0; m < 4; ++m) { const int row = row0 + ai * 128 + m * 16; bf16* rowp = O + (size_t)row * ldc + col0;
                const float s3 = rt[(ai * 128 + m * 16) * 4];
#pragma unroll
                for (int bj = 0; bj < 2; ++bj) { const f32x4 v0 = acc[ai][bj][m][0] * s3, v1 = acc[ai][bj][m][1] * s3;
                    v4u w; w.x = pk2(v0[0], v0[1]); w.y = pk2(v0[2], v0[3]); w.z = pk2(v1[0], v1[1]); w.w = pk2(v1[2], v1[3]);
                    *(GAS v4u*)(rowp + bj * 128) = w; } }
    }
    __device__ __forceinline__ void operator()(const f32x4 (&acc)[2][2][4][2], const pg8::Unit& u, int wr, int wc, int fr, int fq) const {}
};
__device__ __forceinline__ float silu_f(float v) { return v * __builtin_amdgcn_rcpf(1.f + __expf(-v)); }
struct EpiSwiGLU {
    static constexpr bool PERM = true, KSCALE = false;
    bf16* H;
    __device__ __forceinline__ void operator()(const f32x4 (&acc)[2][2][4][2], const pg8::Unit& u, int wr, int wc, int fr, int fq) const {
        const int row0 = u.pm * 256 + wr * 64 + fr, col0 = u.pn * 128 + wc * 32 + 8 * fq;
#pragma unroll
        for (int ai = 0; ai < 2; ++ai)
#pragma unroll
            for (int m = 0; m < 4; ++m) {
                const f32x4 g0 = acc[ai][0][m][0], g1 = acc[ai][0][m][1], u0 = acc[ai][1][m][0], u1 = acc[ai][1][m][1];
                v4u w; w.x = pk2(silu_f(g0[0]) * u0[0], silu_f(g0[1]) * u0[1]); w.y = pk2(silu_f(g0[2]) * u0[2], silu_f(g0[3]) * u0[3]);
                w.z = pk2(silu_f(g1[0]) * u1[0], silu_f(g1[1]) * u1[1]); w.w = pk2(silu_f(g1[2]) * u1[2], silu_f(g1[3]) * u1[3]);
                *(GAS v4u*)(H + (size_t)(row0 + ai * 128 + m * 16) * FF + col0) = w; }
    }
};
struct EpiKQ {
    static constexpr bool PERM = true, KSCALE = false;
    bf16 *KHp, *QHp, *KHs, *QHs; float* out;
    __device__ __forceinline__ void operator()(const f32x4 (&acc)[2][2][4][2], const pg8::Unit& u, int wr, int wc, int fr, int fq) const {
        const int row_t = u.pm * 256, b = row_t >> 11, pos_t = row_t & 2047; const bool isK = u.pn < 4, cache = isK && pos_t >= 1536;
        const int hd0 = (u.pn & 3) * 4 + (wc >> 1), d = (wc & 1) * 32 + 8 * fq, ro = wr * 64 + fr;
        bf16* dstb = (isK ? KHp : QHp) + ((size_t)((b * AH + hd0) * 2048 + pos_t + ro)) * 64 + d;
        float* ob = out + O_CK_P + (size_t)(b * 512 + pos_t - 1536 + ro) * 1024 + u.pn * 256 + wc * 32 + 8 * fq;
#pragma unroll
        for (int ai = 0; ai < 2; ++ai)
#pragma unroll
            for (int m = 0; m < 4; ++m)
#pragma unroll
                for (int bj = 0; bj < 2; ++bj) {
                    const f32x4 v0 = acc[ai][bj][m][0], v1 = acc[ai][bj][m][1];
                    v4u w; w.x = pk2(v0[0], v0[1]); w.y = pk2(v0[2], v0[3]); w.z = pk2(v1[0], v1[1]); w.w = pk2(v1[2], v1[3]);
                    *(GAS v4u*)(dstb + (size_t)(bj * 2 * 2048 + ai * 128 + m * 16) * 64) = w;
                    if (cache) { float* o = ob + (size_t)(ai * 128 + m * 16) * 1024 + bj * 128; *(GAS f32x4*)o = v0; *(GAS f32x4*)(o + 4) = v1; }
                }
    }
};
struct EpiVT {
    static constexpr bool PERM = true, KSCALE = false;
    bf16 *VTp, *VTs; float* out;
    __device__ __forceinline__ void operator()(const f32x4 (&acc)[2][2][4][2], const pg8::Unit& u, int wr, int wc, int fr, int fq) const {
        const int b = u.pn >> 3, pos_t = (u.pn & 7) * 256; const bool cache = pos_t >= 1536;
        const int hd0 = u.pm * 4 + wr, po = wc * 32 + 8 * fq;
        bf16* dstb = VTp + ((size_t)((b * AH + hd0) * 64 + fr)) * 2048 + pos_t + po;
        float* ob = out + O_CV_P + (size_t)(b * 512 + pos_t - 1536 + po) * 1024 + u.pm * 256 + wr * 64 + fr;
#pragma unroll
        for (int ai = 0; ai < 2; ++ai)
#pragma unroll
            for (int m = 0; m < 4; ++m)
#pragma unroll
                for (int bj = 0; bj < 2; ++bj) {
                    const f32x4 v0 = acc[ai][bj][m][0], v1 = acc[ai][bj][m][1];
                    v4u w; w.x = pk2(v0[0], v0[1]); w.y = pk2(v0[2], v0[3]); w.z = pk2(v1[0], v1[1]); w.w = pk2(v1[2], v1[3]);
                    *(GAS v4u*)(dstb + (size_t)((ai * 2 * 64 + m * 16) * 2048 + bj * 128)) = w;
                    if (cache) { float* o = ob + (size_t)(bj * 128) * 1024 + ai * 128 + m * 16;
#pragma unroll
                        for (int e = 0; e < 4; ++e) { o[(size_t)e * 1024] = v0[e]; o[(size_t)(e + 4) * 1024] = v1[e]; } }
                }
    }
};

struct EpiSlab {
    static constexpr bool PERM = true, KSCALE = false;
    float* slab;
    __device__ __forceinline__ void operator()(const f32x4 (&acc)[2][2][4][2], const pg8::Unit& u, int wr, int wc, int fr, int fq) const {
        const int row0 = u.pm * 256 + wr * 64 + fr, col0 = u.pn * 256 + wc * 32 + 8 * fq; float* base = slab + (size_t)u.w * (TS * DM);
#pragma unroll
        for (int ai = 0; ai < 2; ++ai)
#pragma unroll
            for (int m = 0; m < 4; ++m) { float* rowp = base + (size_t)(row0 + ai * 128 + m * 16) * DM + col0;
#pragma unroll
                for (int bj = 0; bj < 2; ++bj) { *(GAS f32x4*)(rowp + bj * 128) = acc[ai][bj][m][0]; *(GAS f32x4*)(rowp + bj * 128 + 4) = acc[ai][bj][m][1]; } }
    }
};
constexpr size_t KQS_SLAB = (size_t)TS * 3072;
struct EpiKQVT {
    static constexpr bool PERM = true, KSCALE = false;
    EpiKQ kq; EpiVT vt; float* slab;
    __device__ __forceinline__ void operator()(const f32x4 (&acc)[2][2][4][2], const pg8::Unit& u, int wr, int wc, int fr, int fq) const {
        if (u.w == 0) kq(acc, u, wr, wc, fr, fq); else if (u.w == 1) vt(acc, u, wr, wc, fr, fq);
        else { const bool isv = u.w & 1; const int row0 = (isv ? u.pm : u.pm - 128) * 256 + wr * 64 + fr, col0 = (isv ? 2048 + (u.pn - 128) * 256 : u.pn * 256) + wc * 32 + 8 * fq;
            float* base = slab + (size_t)((u.w - 2) >> 1) * KQS_SLAB;
#pragma unroll
            for (int ai = 0; ai < 2; ++ai)
#pragma unroll
                for (int m = 0; m < 4; ++m) { float* rowp = base + (size_t)(row0 + ai * 128 + m * 16) * 3072 + col0;
#pragma unroll
                    for (int bj = 0; bj < 2; ++bj) { *(GAS f32x4*)(rowp + bj * 128) = acc[ai][bj][m][0]; *(GAS f32x4*)(rowp + bj * 128 + 4) = acc[ai][bj][m][1]; } } }
    }
};
__device__ __forceinline__ void norm_row2(const bf16* Mrow, const float* mf, const float* xf, bf16* xn, float* sq, float* yout, const float* wpost, int lane) {
    f32x4 mv[2][4], xv[2][4], wv[4]; float s[2] = {0.f, 0.f};
#pragma unroll
    for (int j = 0; j < 4; ++j) wv[j] = *(const GAS f32x4*)(wpost + 4 * lane + 256 * j);
#pragma unroll
    for (int r = 0; r < 2; ++r) {
        const float sqr = xf ? 1.f : sq[r];
#pragma unroll
        for (int j = 0; j < 4; ++j) {
            if (mf) mv[r][j] = *(const GAS f32x4*)(mf + r * DM + 4 * lane + 256 * j) + *(const GAS f32x4*)(mf + (size_t)TS * DM + r * DM + 4 * lane + 256 * j);
            else { const v2u mm = __builtin_nontemporal_load((const GAS v2u*)(Mrow + r * DM + 4 * lane + 256 * j)); mv[r][j] = (f32x4){bflo(mm.x), bfhi(mm.x), bflo(mm.y), bfhi(mm.y)}; }
            if (xf) xv[r][j] = __builtin_nontemporal_load((const GAS f32x4*)(xf + r * DM + 4 * lane + 256 * j));
            else { const v2u xx = *(const GAS v2u*)(xn + r * DM + 4 * lane + 256 * j); xv[r][j] = (f32x4){bflo(xx.x) * sqr, bfhi(xx.x) * sqr, bflo(xx.y) * sqr, bfhi(xx.y) * sqr}; }
            s[r] += (mv[r][j].x * mv[r][j].x + mv[r][j].y * mv[r][j].y) + (mv[r][j].z * mv[r][j].z + mv[r][j].w * mv[r][j].w); } }
    float s2[2] = {0.f, 0.f};
#pragma unroll
    for (int r = 0; r < 2; ++r) { const float r1 = __builtin_amdgcn_rsqf(wave_sum(s[r]) * (1.f / DM) + EPS);
#pragma unroll
        for (int j = 0; j < 4; ++j) { xv[r][j] = xv[r][j] + mv[r][j] * r1 * wv[j];
            if (yout) *(GAS f32x4*)(yout + r * DM + 4 * lane + 256 * j) = xv[r][j];
            s2[r] += (xv[r][j].x * xv[r][j].x + xv[r][j].y * xv[r][j].y) + (xv[r][j].z * xv[r][j].z + xv[r][j].w * xv[r][j].w); } }
    if (!yout) {
#pragma unroll
        for (int r = 0; r < 2; ++r) { const float ms = wave_sum(s2[r]) * (1.f / DM) + EPS; const float r2 = __builtin_amdgcn_rsqf(ms);
            if (lane == 0) sq[r] = ms * r2;
#pragma unroll
            for (int j = 0; j < 4; ++j) { v2u o; o.x = pk2(xv[r][j].x * r2, xv[r][j].y * r2); o.y = pk2(xv[r][j].z * r2, xv[r][j].w * r2); *(GAS v2u*)(xn + r * DM + 4 * lane + 256 * j) = o; } } }
}

typedef float f32x16 __attribute__((ext_vector_type(16)));
__device__ __forceinline__ bf16x8 pack8(const float* v) { v4u w; w.x = pk2(v[0], v[1]); w.y = pk2(v[2], v[3]); w.z = pk2(v[4], v[5]); w.w = pk2(v[6], v[7]); return __builtin_bit_cast(bf16x8, w); }
#define MFMA16(a, b, c) __builtin_amdgcn_mfma_f32_16x16x32_bf16((a), (b), (c), 0, 0, 0)
#define MFMA32(a, b, c) __builtin_amdgcn_mfma_f32_32x32x16_bf16((a), (b), (c), 0, 0, 0)
constexpr int S_XT = 0, S_BT = 18432, S_BN = 36864, S_CN = 54272, S_CB = 71680, S_HS = 89088, S_DT = 123904, S_CUM = 124416, S_W = 124928, S_CEND = 125440;


#define XB_TMO      128
#define XB_XCNT(j)  (256  + 64 * (j))
#define XB_XSUB(j)  (1280 + 64 * (j))
#define XB_XGEN(j)  (2304 + 64 * (j))
#define XB_TOP      3328
#define XB_TOPGEN   3392
#define XCD_BAR_WORDS 3456
#define XB_SPIN_CAP (1u << 22)
__device__ __forceinline__ unsigned xb_ld(unsigned* p)              { return __hip_atomic_load(p, __ATOMIC_RELAXED, __HIP_MEMORY_SCOPE_AGENT); }
__device__ __forceinline__ unsigned xb_add(unsigned* p, unsigned v) { return __hip_atomic_fetch_add(p, v, __ATOMIC_RELAXED, __HIP_MEMORY_SCOPE_AGENT); }
__device__ __forceinline__ unsigned xb_xcc_id() { return (unsigned)__builtin_amdgcn_s_getreg((3 << 11) | 20) & 0xFu; }
#define XB_SPIN(cond, bar) do { unsigned _sp = 0; while (cond) { __builtin_amdgcn_s_sleep(1); \
    if ((++_sp & 255u) == 0u) { if (xb_ld(&(bar)[XB_TMO])) break; if (_sp > XB_SPIN_CAP) { atomicAdd(&(bar)[XB_TMO], 1u); break; } } } } while (0)
struct XcdBarrier { unsigned* bar; unsigned x; volatile LAS unsigned* st; };
__device__ __forceinline__ bool is_thread0(int wave_id) { return wave_id == 0 && fresh_lane() == 0; }
__device__ __forceinline__ XcdBarrier xcd_barrier_post(unsigned* bar, volatile LAS unsigned* st, int wave_id) {
    XcdBarrier b; b.bar = bar; b.x = xb_xcc_id(); b.st = st;
    if (is_thread0(wave_id)) (void)xb_add(&bar[XB_XCNT(b.x)], 1u);
    return b;
}
__device__ __forceinline__ void xcd_barrier_complete(unsigned* bar, unsigned x, unsigned& nloc, unsigned& nx) {
    const unsigned G = gridDim.x * gridDim.y * gridDim.z;
    unsigned sum, cnt, mine, sp = 0u;
    for (;;) {
        sum = 0u; cnt = 0u; mine = 0u;
#pragma unroll
        for (unsigned j = 0; j < 16; ++j) { const unsigned c = xb_ld(&bar[XB_XCNT(j)]); sum += c; cnt += (c > 0u) ? 1u : 0u; mine = (j == x) ? c : mine; }
        if (sum == G) break;
        __builtin_amdgcn_s_sleep(1);
        if ((++sp & 255u) == 0u) { if (xb_ld(&bar[XB_TMO])) break; if (sp > XB_SPIN_CAP) { atomicAdd(&bar[XB_TMO], 1u); break; } }
    }
    nloc = mine > 0u ? mine : 1u; nx = cnt > 0u ? cnt : 1u;
}
__device__ __forceinline__ void xcd_barrier(const XcdBarrier& b, int wave_id) {
    asm volatile("s_waitcnt vmcnt(0)" ::: "memory");
    __syncthreads();
    if (is_thread0(wave_id)) {
        unsigned* bar = b.bar;
        __builtin_amdgcn_s_waitcnt(0);
        unsigned nloc = b.st[0], nx = b.st[1];
        if (nloc == 0u) { xcd_barrier_complete(bar, b.x, nloc, nx); b.st[0] = nloc; b.st[1] = nx; }
        const unsigned old = xb_add(&bar[XB_XSUB(b.x)], 1u);
        const unsigned gen = old / nloc;
        if (old + 1u == (gen + 1u) * nloc) {
            __builtin_amdgcn_fence(__ATOMIC_RELEASE, "agent");
            asm volatile("s_waitcnt vmcnt(0)" ::: "memory");
            const unsigned og = xb_add(&bar[XB_TOP], 1u);
            const unsigned tg = og / nx;
            if (og + 1u == (tg + 1u) * nx) xb_add(&bar[XB_TOPGEN], 1u);
            else XB_SPIN(xb_ld(&bar[XB_TOPGEN]) == tg, bar);
            __builtin_amdgcn_fence(__ATOMIC_ACQUIRE, "agent");
            xb_add(&bar[XB_XGEN(b.x)], 1u);
            asm volatile("s_waitcnt vmcnt(0)" ::: "memory");
        } else {
            XB_SPIN(xb_ld(&bar[XB_XGEN(b.x)]) == gen, bar);
            __builtin_amdgcn_fence(__ATOMIC_ACQUIRE, "agent");
            asm volatile("s_waitcnt vmcnt(0)" ::: "memory");
        }
    }
    __syncthreads();
}
constexpr int MISC_OFF = 146432;

__global__ void __launch_bounds__(NTHREADS, 2) mk_fwd(Args a) {
    extern __shared__ __attribute__((aligned(16))) unsigned char lds[];
    cg::grid_group grid = cg::this_grid();
    const int wave_s = __builtin_amdgcn_readfirstlane((int)threadIdx.x >> 6);
    const int G = gridDim.x, bx = blockIdx.x, NGW = G * NWAVES;
    const size_t gsz = (size_t)G * NTHREADS;
#define PHASE_IDS int tid = wave_s * 64 + fresh_lane(); asm volatile("" : "+v"(tid)); const int lane = tid & 63, wave = __builtin_amdgcn_readfirstlane(tid >> 6), gw = bx * NWAVES + wave; const size_t gtid = (size_t)bx * NTHREADS + tid; (void)lane; (void)gw; (void)gtid;
#define PHASE_PTRS const Args __attribute__((address_space(4)))* ap_ = (const Args __attribute__((address_space(4)))*)__builtin_amdgcn_kernarg_segment_ptr(); asm volatile("" : "+s"(ap_)); \
    unsigned char* ws = ap_->ws; float* out = ap_->out; (void)out; const float* x_p = ap_->in[0]; const float* x_s = ap_->in[1]; const float* norm_w = ap_->in[6]; (void)x_p; (void)x_s; (void)norm_w; \
    bf16* Win_t = (bf16*)(ws + WS_WIN); bf16* Wout_t = (bf16*)(ws + WS_WOUT); bf16* Wf1_t = (bf16*)(ws + WS_WF1); bf16* Wf2_t = (bf16*)(ws + WS_WF2); \
    bf16* Wkq_t = (bf16*)(ws + WS_WKQ); bf16* Wv_t = (bf16*)(ws + WS_WV); bf16* Wo_t = (bf16*)(ws + WS_WO); \
    bf16* XN = (bf16*)(ws + WS_XN); bf16* Z = (bf16*)(ws + WS_Z); bf16* XBC = (bf16*)(ws + WS_XBC); float* DT = (float*)(ws + WS_DT); \
    float* SSQ = (float*)(ws + WS_SSQ); float* SQ = (float*)(ws + WS_SQ); (void)SQ; float* SLAB = (float*)(ws + WS_SLAB); (void)SLAB; bf16* MB = (bf16*)(ws + WS_M); bf16* HB = (bf16*)(ws + WS_H); \
    bf16* KHp = (bf16*)(ws + WS_KHP); bf16* QHp = (bf16*)(ws + WS_QHP); bf16* VTp = (bf16*)(ws + WS_VTP); \
    bf16* KHs = (bf16*)(ws + WS_KHS); bf16* QHs = (bf16*)(ws + WS_QHS); bf16* VTs = (bf16*)(ws + WS_VTS); bf16* AO = (bf16*)(ws + WS_AO); \
    (void)Win_t; (void)Wout_t; (void)Wf1_t; (void)Wf2_t; (void)Wkq_t; (void)Wv_t; (void)Wo_t; (void)XN; (void)Z; (void)XBC; (void)DT; (void)SSQ; (void)MB; (void)HB; \
    (void)KHp; (void)QHp; (void)VTp; (void)KHs; (void)QHs; (void)VTs; (void)AO;
#define AIN(k) (ap_->in[k])
    LAS unsigned char* L = (LAS unsigned char*)lds;
    volatile LAS unsigned* MISC = (volatile LAS unsigned*)(L + MISC_OFF);
    if (wave_s == 0) MISC[fresh_lane()] = 0u;
    __syncthreads();
    const XcdBarrier xbar = xcd_barrier_post((unsigned*)(a.ws + WS_CTL) + 4096, MISC, wave_s);
#if PROF_K >= 0
    int n_stamp = 0;
#endif
#if PROF_K >= 0
#define STAMP() do { if (is_thread0(wave_s) && n_stamp < 24) ((volatile LAS unsigned long long*)(MISC + 8))[n_stamp] = __builtin_amdgcn_s_memrealtime(); ++n_stamp; } while (0)
#else
#define STAMP() do { } while (0)
#endif
#define GRID_BAR() do { xcd_barrier(xbar, wave_s); STAMP(); } while (0)
    STAMP();

    {
        PHASE_IDS PHASE_PTRS
        LAS float* scr = (LAS float*)(L + wave * 16384);
        constexpr float C2 = 0.125f * 1.4426950408889634f;
        constexpr int I_IN = (INPROJ_PAD / 32) * (DM / 64);
        constexpr int I_OUT = (DM / 32) * (DI / 64);
        constexpr int I_F1 = (FF2 / 32) * (DM / 64);
        constexpr int I_F2 = (DM / 32) * (FF / 64);
        constexpr int I_KQ = (2048 / 32) * (DM / 64);
        constexpr int I_V = (DM / 32) * (DM / 64);
        constexpr int NITEMS = I_IN + I_OUT + 2 * I_F1 + 2 * I_F2 + I_KQ + 2 * I_V;
        for (int it = gw; it < NITEMS; it += NGW) {
            int r = it;
            if (r < I_IN) { const int rb = r / 16, kb = r % 16, r0 = rb * 32; tr_item(ap_->in[7], INPROJ, DM, Win_t, r0, r0 < INPROJ ? r0 : -1, kb * 64, norm_w, 1.f, scr, lane); continue; } r -= I_IN;
            if (r < I_OUT) { const int rb = r / 32, kb = r % 32, r0 = rb * 32; tr_item(ap_->in[14], DM, DI, Wout_t, r0, r0, kb * 64, ap_->in[13], 1.f, scr, lane); continue; } r -= I_OUT;
            if (r < 2 * I_F1) { const int l = r / I_F1; r -= l * I_F1; const int rb = r / 16, kb = r % 16, r0 = rb * 32;
                const int c0 = ((r0 >> 7) & 1) * FF + (r0 >> 8) * 128 + (r0 & 127);
                tr_item(ap_->in[20] + (size_t)l * DM * FF2, FF2, DM, Wf1_t + (size_t)l * FF2 * DM, r0, c0, kb * 64, norm_w + (l * 4 + 2) * DM, 1.f, scr, lane); continue; } r -= 2 * I_F1;
            if (r < 2 * I_F2) { const int l = r / I_F2; r -= l * I_F2; const int rb = r / 44, kb = r % 44, r0 = rb * 32;
                tr_item(ap_->in[21] + (size_t)l * FF * DM, DM, FF, Wf2_t + (size_t)l * DM * FF, r0, r0, kb * 64, nullptr, 1.f, scr, lane); continue; } r -= 2 * I_F2;
            if (r < I_KQ) { const int rb = r / 16, kb = r % 16, r0 = rb * 32;
                if (r0 < 1024) tr_item(ap_->in[16], 2048, DM, Wkq_t, r0, r0, kb * 64, ap_->in[15], 1.f, scr, lane);
                else tr_item(ap_->in[17], DM, DM, Wkq_t, r0, r0 - 1024, kb * 64, norm_w + 4 * DM, C2, scr, lane);
                continue; } r -= I_KQ;
            if (r < I_V) { const int rb = r / 16, kb = r % 16, r0 = rb * 32; tr_item(ap_->in[16], 2048, DM, Wv_t, r0, 1024 + r0, kb * 64, ap_->in[15], 1.f, scr, lane); continue; } r -= I_V;
            { const int rb = r / 16, kb = r % 16, r0 = rb * 32; tr_item(ap_->in[19], DM, DM, Wo_t, r0, r0, kb * 64, nullptr, 1.f, scr, lane); }
        }
        for (int m = 2 * gw; m < TT; m += 2 * NGW) rms_row2_to_bf16(m < TP ? x_p + (size_t)m * DM : x_s + (size_t)(m - TP) * DM, XN + (size_t)m * DM, lane);
        for (size_t i = gtid; i < (size_t)TT * 4; i += gsz) SSQ[i] = 0.f;
    }
    __syncthreads();
    grid.sync(); STAMP();

    {
        PHASE_PTRS
        pg8::Gemm g{XN, Win_t, TT, INPROJ_PAD, DM, DM}; pg8::StaticOrder S; S.init(TT, INPROJ_PAD, G, bx);
        EpiInProj E{Z, XBC, DT, out};
        pg8::gemm_phase<EpiInProj, pg8::StaticOrder, true, true>(L, g, S, E, wave_s);
    }
    GRID_BAR();

#if PROF_K >= 0
    unsigned long long pt_last = 0ull, pt_acc0 = 0ull, pt_acc1 = 0ull, pt_acc2 = 0ull, pt_acc3 = 0ull;
#define PROF_T(k) do { const unsigned long long t_ = __builtin_amdgcn_s_memrealtime(); \
        if ((k) == 1) pt_acc0 += t_ - pt_last; else if ((k) == 2) pt_acc1 += t_ - pt_last; else if ((k) == 3) pt_acc2 += t_ - pt_last; else if ((k) == 4) pt_acc3 += t_ - pt_last; pt_last = t_; } while (0)
#define PROF_RESET() do { if (PROF_K < 70) { pt_acc0 = 0ull; pt_acc1 = 0ull; pt_acc2 = 0ull; pt_acc3 = 0ull; } } while (0)
#define PROF_TA(k) do { if (PROF_K < 70) PROF_T(k); } while (0)
#else
#define PROF_TA(k) do { } while (0)
#define PROF_T(k) do { } while (0)
#define PROF_RESET() do { } while (0)
#endif
    {
        PHASE_IDS PHASE_PTRS
        LAS bf16* XT = (LAS bf16*)(L + S_XT); LAS bf16* BT = (LAS bf16*)(L + S_BT); LAS bf16* BN = (LAS bf16*)(L + S_BN); LAS bf16* CN = (LAS bf16*)(L + S_CN);
        LAS float* CBs = (LAS float*)(L + S_CB); LAS bf16* HS = (LAS bf16*)(L + S_HS);
        LAS float* dtS = (LAS float*)(L + S_DT); LAS float* cumS = (LAS float*)(L + S_CUM); LAS float* wS = (LAS float*)(L + S_W); LAS float* cendS = (LAS float*)(L + S_CEND);
        const float* conv_w = ap_->in[8]; const float* conv_b = ap_->in[9]; const float* dt_bias = ap_->in[10]; const float* A_log = ap_->in[11]; const float* Dskip = ap_->in[12];
        const float* state_ssm = ap_->in[2]; const float* state_conv = ap_->in[3];
        const int fr = lane & 15, fq = lane >> 4, hh = wave >> 2, qd = wave & 3;
        for (int wi = bx; wi < 512; wi += G) {
            const bool smp = wi >= 256;
            const int xq = wi & 7, kq = (wi >> 3) & 31, sidx = xq * 8 + (kq >> 2), sq = sidx >> 2, grp = sidx & 3, hp = grp * 4 + (kq & 3), h0 = 2 * hp, h = h0 + hh;
            const int nchunk = smp ? 1 : 32;
            const size_t row_base = smp ? (size_t)TP + sq * 64 : (size_t)sq * 2048;
            const float Dh = Dskip[h];
            f32x4 sacc[2][4];
#pragma unroll
            for (int n2 = 0; n2 < 2; ++n2)
#pragma unroll
                for (int pt = 0; pt < 4; ++pt) {
                    const int p = 16 * pt + fr, n = 32 * qd + 16 * n2 + 4 * fq;
                    sacc[n2][pt] = smp ? *(const GAS f32x4*)(state_ssm + ((size_t)((sq * NH + h) * 64 + p)) * 128 + n) : (f32x4){0.f, 0.f, 0.f, 0.f};
                    v2u w; w.x = pk2(sacc[n2][pt][0], sacc[n2][pt][1]); w.y = pk2(sacc[n2][pt][2], sacc[n2][pt][3]);
                    *(LAS v2u*)(HS + (hh * 64 + p) * 136 + n) = w;
                }
            unsigned raw[3][11]; float dtraw = 0.f;
#define SSD_LOAD(c) do { \
              \
              \
            const __amdgpu_buffer_rsrc_t xr_ = __builtin_amdgcn_make_buffer_rsrc((void*)(XBC - 3 * CONVD), 0, (int)((size_t)(TT + 3) * CONVD * 2), 0x00020000); \
            _Pragma("unroll") for (int i = 0; i < 3; ++i) { const int it = SSD_TID + 512 * i, cp = it % 192; const int sb = __builtin_amdgcn_readfirstlane(it / 192); \
                const int col = cp < 64 ? h0 * 64 + 2 * cp : (cp < 128 ? DI + grp * 128 + 2 * (cp - 64) : DI + 512 + grp * 128 + 2 * (cp - 128)); \
                const int so0 = ((int)row_base + 64 * (c) + 8 * sb) * (CONVD * 2); \
                _Pragma("unroll") for (int r = 0; r < 11; ++r) raw[i][r] = __builtin_amdgcn_raw_buffer_load_b32(xr_, col * 2, so0 + r * (CONVD * 2), 0); } \
            if (wave < 2) dtraw = DT[(row_base + 64 * (c) + lane) * 32 + h0 + wave]; } while (0)
#define SSD_TID tid
            SSD_LOAD(0);
#undef SSD_TID
#define SSD_TID tidc
            if (!smp && tid < 192) { raw[0][0] = 0u; raw[0][1] = 0u; raw[0][2] = 0u; }
            if (smp && tid < 192) {
                const int cp = tid; const int col = cp < 64 ? h0 * 64 + 2 * cp : (cp < 128 ? DI + grp * 128 + 2 * (cp - 64) : DI + 512 + grp * 128 + 2 * (cp - 128));
#pragma unroll
                for (int r = 0; r < 3; ++r) { const float* sc = state_conv + (size_t)(sq * 3 + r) * CONVD + col; raw[0][r] = pk2(sc[0], sc[1]); } }
            for (int c = 0; c < nchunk; ++c) {
                PROF_T(0);
                int frc = fr, fqc = fq, tidc = tid; asm volatile("" : "+v"(frc), "+v"(fqc), "+v"(tidc));
                const float* cw_ = conv_w; const float* cb_ = conv_b; asm volatile("" : "+s"(cw_), "+s"(cb_));
#pragma unroll
                for (int i = 0; i < 3; ++i) { const int it = tidc + 512 * i, cp = it % 192, sb = it / 192, typ = cp >> 6, cl = 2 * (cp & 63);
                    const int col = cp < 64 ? h0 * 64 + 2 * cp : (cp < 128 ? DI + grp * 128 + 2 * (cp - 64) : DI + 512 + grp * 128 + 2 * (cp - 128));
                    float w0[4], w1[4];
#pragma unroll
                    for (int k = 0; k < 4; ++k) { w0[k] = cw_[k * CONVD + col]; w1[k] = cw_[k * CONVD + col + 1]; }
                    const float b0 = cb_[col], b1 = cb_[col + 1];
                    float o0[8], o1[8];
#pragma unroll
                    for (int s = 0; s < 8; ++s) { float a0 = b0, a1 = b1;
#pragma unroll
                        for (int k = 0; k < 4; ++k) { const unsigned uu = raw[i][s + k]; a0 += w0[k] * bflo(uu); a1 += w1[k] * bfhi(uu); }
                        o0[s] = silu_f(a0); o1[s] = silu_f(a1); }
                    if (typ == 0) { *(LAS bf16x8*)(XT + cl * 72 + 8 * sb) = pack8(o0); *(LAS bf16x8*)(XT + (cl + 1) * 72 + 8 * sb) = pack8(o1); }
                    else if (typ == 1) { *(LAS bf16x8*)(BT + cl * 72 + 8 * sb) = pack8(o0); *(LAS bf16x8*)(BT + (cl + 1) * 72 + 8 * sb) = pack8(o1);
#pragma unroll
                        for (int s = 0; s < 8; ++s) *(LAS unsigned*)(BN + (8 * sb + s) * 136 + cl) = pk2(o0[s], o1[s]); }
                    else {
#pragma unroll
                        for (int s = 0; s < 8; ++s) *(LAS unsigned*)(CN + (8 * sb + s) * 136 + cl) = pk2(o0[s], o1[s]); }
                }
                if (wave < 2) { const int hd = h0 + wave;
                    const float xx = dtraw + dt_bias[hd];
                    const float dtv = fmaxf(xx, 0.f) + __logf(1.f + __expf(-fabsf(xx)));
                    const float Ah = -__expf(A_log[hd]);
                    const float cum = wave_scan_incl(dtv * Ah);
                    const float cend = __builtin_bit_cast(float, __builtin_amdgcn_readlane(__builtin_bit_cast(int, cum), 63));
                    dtS[wave * 64 + lane] = dtv; cumS[wave * 64 + lane] = cum; wS[wave * 64 + lane] = dtv * __expf(cend - cum);
                    if (lane == 63) cendS[wave] = cend; }
                __syncthreads();
                PROF_T(1);
                if (c + 1 < nchunk) SSD_LOAD(c + 1);
                v2u zpre[4];
                { const size_t mz = row_base + 64 * c + 16 * qd + frc; const bf16* zp0 = Z + mz * DI + h * 64 + 4 * fqc;
#pragma unroll
                  for (int pt = 0; pt < 4; ++pt) zpre[pt] = *(const GAS v2u*)(zp0 + 16 * pt); }
                PROF_T(2);
                bf16x8 xt[4][2];
#pragma unroll
                for (int pt = 0; pt < 4; ++pt)
#pragma unroll
                    for (int ks = 0; ks < 2; ++ks) xt[pt][ks] = *(const LAS bf16x8*)(XT + (hh * 64 + 16 * pt + frc) * 72 + 8 * fqc + 32 * ks);
                { f32x4 yacc[4], cbacc[4];
#pragma unroll
                    for (int pt = 0; pt < 4; ++pt) { yacc[pt] = (f32x4){0.f, 0.f, 0.f, 0.f}; cbacc[pt] = (f32x4){0.f, 0.f, 0.f, 0.f}; }
                    const int q = 16 * qd + frc;
#pragma unroll
                    for (int ks = 0; ks < 4; ++ks) { const bf16x8 bfr = *(const LAS bf16x8*)(CN + q * 136 + 8 * fqc + 32 * ks);
#pragma unroll
                        for (int pt = 0; pt < 4; ++pt) { const bf16x8 af = *(const LAS bf16x8*)(HS + (hh * 64 + 16 * pt + frc) * 136 + 8 * fqc + 32 * ks); yacc[pt] = MFMA16(af, bfr, yacc[pt]); }
#pragma unroll
                        for (int st = 0; st < 4; ++st) { const bf16x8 af = *(const LAS bf16x8*)(BN + (16 * st + frc) * 136 + 8 * fqc + 32 * ks); cbacc[st] = MFMA16(af, bfr, cbacc[st]); } }
                    const float cq = cumS[hh * 64 + q]; const float eq = __expf(cq);
#pragma unroll
                    for (int pt = 0; pt < 4; ++pt) yacc[pt] = yacc[pt] * eq;
#pragma unroll
                    for (int ks = 0; ks < 2; ++ks) {
                        float mv[8];
#pragma unroll
                        for (int hf = 0; hf < 2; ++hf) { const int s0 = 16 * (2 * ks + hf) + 4 * fqc;
                            const f32x4 cs = *(const LAS f32x4*)(cumS + hh * 64 + s0), dd = *(const LAS f32x4*)(dtS + hh * 64 + s0); const f32x4 cb = cbacc[2 * ks + hf];
#pragma unroll
                            for (int e = 0; e < 4; ++e) { const int s = s0 + e; float t = cb[e] * __expf(fminf(cq - cs[e], 0.f)) * dd[e]; t = (s <= q) ? t : 0.f; if (s == q) t += Dh; mv[4 * hf + e] = t; } }
                        const bf16x8 mf = pack8(mv);
#pragma unroll
                        for (int pt = 0; pt < 4; ++pt) { const LAS bf16* xp = XT + (hh * 64 + 16 * pt + frc) * 72 + 32 * ks + 4 * fqc;
                            const v2u x0 = *(const LAS v2u*)xp, x1 = *(const LAS v2u*)(xp + 16); const v4u xa = {x0.x, x0.y, x1.x, x1.y};
                            yacc[pt] = MFMA16(__builtin_bit_cast(bf16x8, xa), mf, yacc[pt]); } }
                    const size_t m = row_base + 64 * c + q;
                    bf16* zp = Z + m * DI + h * 64 + 4 * fqc; float ss = 0.f;
#pragma unroll
                    for (int pt = 0; pt < 4; ++pt) { const v2u zz = zpre[pt];
                        const float y0 = yacc[pt][0] * silu_f(bflo(zz.x)), y1 = yacc[pt][1] * silu_f(bfhi(zz.x)), y2 = yacc[pt][2] * silu_f(bflo(zz.y)), y3 = yacc[pt][3] * silu_f(bfhi(zz.y));
                        ss += (y0 * y0 + y1 * y1) + (y2 * y2 + y3 * y3);
                        v2u o; o.x = pk2(y0, y1); o.y = pk2(y2, y3); *(GAS v2u*)(zp + 16 * pt) = o; }
                    ss += __shfl_xor(ss, 16); ss += __shfl_xor(ss, 32);
                    if (fqc == 0) atomicAdd(SSQ + m * 4 + grp, ss);
                }
                PROF_T(3);
                { const float dec = __expf(cendS[hh]);
#pragma unroll
                    for (int n2 = 0; n2 < 2; ++n2)
#pragma unroll
                        for (int pt = 0; pt < 4; ++pt) sacc[n2][pt] = sacc[n2][pt] * dec;
#pragma unroll
                    for (int ks = 0; ks < 2; ++ks) { const int s0 = 8 * fqc + 32 * ks;
                        const f32x4 w0 = *(const LAS f32x4*)(wS + hh * 64 + s0), w1 = *(const LAS f32x4*)(wS + hh * 64 + s0 + 4);
#pragma unroll
                        for (int n2 = 0; n2 < 2; ++n2) { const v4u rw = *(const LAS v4u*)(BT + (32 * qd + 16 * n2 + frc) * 72 + s0);
                            float bv[8]; bv[0] = bflo(rw.x) * w0[0]; bv[1] = bfhi(rw.x) * w0[1]; bv[2] = bflo(rw.y) * w0[2]; bv[3] = bfhi(rw.y) * w0[3];
                            bv[4] = bflo(rw.z) * w1[0]; bv[5] = bfhi(rw.z) * w1[1]; bv[6] = bflo(rw.w) * w1[2]; bv[7] = bfhi(rw.w) * w1[3];
                            const bf16x8 af = pack8(bv);
#pragma unroll
                            for (int pt = 0; pt < 4; ++pt) sacc[n2][pt] = MFMA16(af, xt[pt][ks], sacc[n2][pt]); } }
                }
                __syncthreads();
                PROF_T(4);
#pragma unroll
                for (int n2 = 0; n2 < 2; ++n2)
#pragma unroll
                    for (int pt = 0; pt < 4; ++pt) { v2u w; w.x = pk2(sacc[n2][pt][0], sacc[n2][pt][1]); w.y = pk2(sacc[n2][pt][2], sacc[n2][pt][3]);
                        *(LAS v2u*)(HS + (hh * 64 + 16 * pt + frc) * 136 + 32 * qd + 16 * n2 + 4 * fqc) = w; }
            }
#undef SSD_LOAD
#undef SSD_TID
            { float* so = out + (smp ? O_SSM_S : O_SSM_P);
#pragma unroll
                for (int n2 = 0; n2 < 2; ++n2)
#pragma unroll
                    for (int pt = 0; pt < 4; ++pt) *(GAS f32x4*)(so + ((size_t)((sq * NH + h) * 64 + 16 * pt + fr)) * 128 + 32 * qd + 16 * n2 + 4 * fq) = sacc[n2][pt]; }
        }
    }
    GRID_BAR();

#define GEMM1024_NORM(EPI, EPIARGS_P, EPIARGS_S, APTR, BTPTR, KDIM, FIRST, LAST, WPOST, SPLIT, SEAM) do { \
        { PHASE_PTRS pg8::Gemm g{(APTR), (BTPTR), TP, DM, (KDIM), (KDIM)}; pg8::StaticOrder S; S.init(TP, DM, G, bx); EPI E EPIARGS_P; \
          pg8::gemm_phase<EPI, pg8::StaticOrder, true, true>(L, g, S, E, wave_s); } \
        GRID_BAR(); \
        const int nsw = (SPLIT) ? 32 : 16;          \
        if (bx < nsw) { \
          { PHASE_PTRS \
          if (SPLIT) { pg8::Gemm g{(APTR) + (size_t)TP * (KDIM), (BTPTR), TS, DM, (KDIM) / 2, (KDIM)}; pg8::SplitOrder2 S{bx, (long)(KDIM)}; EpiSlab E{SLAB}; \
            pg8::gemm_phase<EpiSlab, pg8::SplitOrder2, true, true>(L, g, S, E, wave_s); } \
          else { pg8::Gemm g{(APTR) + (size_t)TP * (KDIM), (BTPTR), TS, DM, (KDIM), (KDIM)}; pg8::StaticOrder S; S.init(TS, DM, G, bx); EPI E EPIARGS_S; \
            pg8::gemm_phase<EPI, pg8::StaticOrder, true, true>(L, g, S, E, wave_s); } } \
            \
          { PHASE_IDS PHASE_PTRS \
            asm volatile("s_waitcnt vmcnt(0)" ::: "memory"); __syncthreads(); \
            if (tid == 0) { unsigned* cnt = (unsigned*)(ws + WS_CTL) + 8192 + 64 * (SEAM); \
              __builtin_amdgcn_fence(__ATOMIC_RELEASE, "agent"); asm volatile("s_waitcnt vmcnt(0)" ::: "memory"); \
              __hip_atomic_fetch_add(cnt, 1u, __ATOMIC_RELAXED, __HIP_MEMORY_SCOPE_AGENT); } } } \
        else { PHASE_IDS PHASE_PTRS const int gw2 = (bx - nsw) * NWAVES + wave, NGW2 = (G - nsw) * NWAVES; \
          for (int m = 2 * gw2; m < TP; m += 2 * NGW2) norm_row2(MB + (size_t)m * DM, nullptr, (FIRST) ? x_p + (size_t)m * DM : nullptr, XN + (size_t)m * DM, SQ + m, (LAST) ? out + O_Y + (size_t)m * DM : nullptr, (WPOST), lane); \
            \
          if (tid == 0) { unsigned* cnt = (unsigned*)(ws + WS_CTL) + 8192 + 64 * (SEAM); unsigned sp = 0; \
            while (__hip_atomic_load(cnt, __ATOMIC_RELAXED, __HIP_MEMORY_SCOPE_AGENT) < (unsigned)nsw) { __builtin_amdgcn_s_sleep(2); if (++sp > (1u << 22)) break; } \
            __builtin_amdgcn_fence(__ATOMIC_ACQUIRE, "agent"); asm volatile("s_waitcnt vmcnt(0)" ::: "memory"); } \
          __syncthreads(); \
          for (int m = TP + 2 * gw2; m < TT; m += 2 * NGW2) norm_row2(MB + (size_t)m * DM, (SPLIT) ? SLAB + (size_t)(m - TP) * DM : nullptr, (FIRST) ? x_s + (size_t)(m - TP) * DM : nullptr, XN + (size_t)m * DM, SQ + m, (LAST) ? out + O_Y + (size_t)m * DM : nullptr, (WPOST), lane); } \
    } while (0)
    GEMM1024_NORM(EpiOutProj, ({MB, DM, SSQ}), ({MB + (size_t)TP * DM, DM, SSQ + (size_t)TP * 4}), Z, Wout_t, DI, true, false, norm_w + 1 * DM, false, 0);
    GRID_BAR();

    { constexpr int layer = 0;
        { PHASE_PTRS pg8::Gemm g{XN, Wf1_t + (size_t)layer * FF2 * DM, TT, FF2, DM, DM}; pg8::StaticOrder S; S.init(TT, FF2, G, bx); EpiSwiGLU E{HB};
          pg8::gemm_phase<EpiSwiGLU, pg8::StaticOrder, true, true>(L, g, S, E, wave_s); }
        GRID_BAR();
        GEMM1024_NORM(EpiPlain, ({MB, DM}), ({MB + (size_t)TP * DM, DM}), HB, Wf2_t + (size_t)layer * DM * FF, FF, false, layer == 1, norm_w + (layer * 4 + 3) * DM, true, 2 + layer);
        if (layer == 0) GRID_BAR();
        }
    { constexpr int layer = 1;
        {
            { PHASE_PTRS pg8::Gemm g{XN, Wkq_t, TT, 2048, DM, DM};
              pg8::KqvtOrder S; S.G = G; S.c = bx; S.dA = (const char*)Wv_t - (const char*)XN; S.dB = (const char*)XN - (const char*)Wkq_t;
              EpiKQVT E{{KHp, QHp, KHs, QHs, out}, {VTp, VTs, out}, (float*)MB};
              pg8::gemm_phase<EpiKQVT, pg8::KqvtOrder, true, true>(L, g, S, E, wave_s); }
            GRID_BAR();
            {
                PHASE_IDS PHASE_PTRS
                LAS bf16* KsB = (LAS bf16*)L;
                LAS bf16* VsB = (LAS bf16*)(L + 18432);
                LAS float* biasL = (LAS float*)(L + 36864);
                PROF_RESET();
                const float* rel_bias = ap_->in[18];
                for (int i = tid; i < AH * 641; i += NTHREADS) { const int h = i / 641, j = i - h * 641; biasL[i] = rel_bias[h * 513 + (j > 512 ? 512 : j)] * 1.4426950408889634f; }
                __syncthreads();
                const int r32 = lane & 31, hi = lane >> 5;
                const int krow = (r32 & 0x13) | ((r32 & 4) << 1) | ((r32 & 8) >> 1);
                const int srow = tid >> 3, sch = tid & 7;
#define ATTN_DECODE(P, uu) const bool P##smp = (uu) >= 2048; const int P##idx = (uu) & 255, P##b = P##idx >> 4, P##hd = P##idx & 15, P##c0 = P##smp ? 8 : 4 * ((uu) >> 8); \
                const int P##kt_lo = P##c0 > 8 ? P##c0 - 8 : 0, P##Lk = P##smp ? SKV : 2048; \
                const bf16* P##KHb = P##smp ? KHs + (size_t)((P##b * AH + P##hd) * SKV) * 64 : KHp + (size_t)((P##b * AH + P##hd) * 2048) * 64; \
                const bf16* P##VTb = P##smp ? VTs + (size_t)((P##b * AH + P##hd) * 64) * SKV : VTp + (size_t)((P##b * AH + P##hd) * 64) * 2048; \
                const int P##pos0 = P##smp ? 32 * (wave & 1) : 64 * P##c0 + 32 * wave; \
                const bf16* P##Qb = P##smp ? QHs + (size_t)((P##b * AH + P##hd) * 64 + P##pos0) * 64 : QHp + (size_t)((P##b * AH + P##hd) * 2048 + P##pos0) * 64;
                { const float* cache_k = ap_->in[4]; const float* cache_v = ap_->in[5];
                  for (int u = bx; u < 2304; u += G) if (u >= 2048) { const int idx = u & 255, b = idx >> 4, hd = idx & 15;
                      { const int d8 = tid & 7, r0 = tid >> 3; f32x4 kv[8][2]; float vv[4][8];
#pragma unroll
                        for (int it = 0; it < 8; ++it) { const float* s = cache_k + ((size_t)((b * 512 + r0 + 64 * it) * 16 + hd)) * 64 + 8 * d8;
                            kv[it][0] = __builtin_nontemporal_load((const GAS f32x4*)s); kv[it][1] = __builtin_nontemporal_load((const GAS f32x4*)(s + 4)); }
#pragma unroll
                        for (int j = 0; j < 4; ++j)
#pragma unroll
                            for (int e = 0; e < 8; ++e) vv[j][e] = __builtin_nontemporal_load((const GAS float*)(cache_v + ((size_t)((b * 512 + 8 * (wave + 8 * j) + e) * 16 + hd)) * 64 + lane));
#pragma unroll
                        for (int it = 0; it < 8; ++it) { const f32x4 v0 = kv[it][0], v1 = kv[it][1];
                            v4u w; w.x = pk2(v0[0], v0[1]); w.y = pk2(v0[2], v0[3]); w.z = pk2(v1[0], v1[1]); w.w = pk2(v1[2], v1[3]);
                            *(GAS v4u*)(KHs + ((size_t)((b * AH + hd) * SKV + r0 + 64 * it)) * 64 + 8 * d8) = w; }
#pragma unroll
                        for (int j = 0; j < 4; ++j) { v4u w; w.x = pk2(vv[j][0], vv[j][1]); w.y = pk2(vv[j][2], vv[j][3]); w.z = pk2(vv[j][4], vv[j][5]); w.w = pk2(vv[j][6], vv[j][7]);
                            *(GAS v4u*)(VTs + ((size_t)((b * AH + hd) * 64 + lane)) * SKV + 8 * (wave + 8 * j)) = w; } }
                      { const float* sl = (const float*)MB; const int r = tid >> 3, c8 = tid & 7; float vv[4][8];
                        const float* pk = sl + (size_t)(b * 64 + r) * 3072 + hd * 64 + 8 * c8; const float* pv = sl + (size_t)(hd * 64 + r) * 3072 + 2048 + b * 64 + 8 * c8;
                        f32x4 sk[4][2], sq4[4][2], sv[4][2];
#pragma unroll
                        for (int j = 0; j < 4; ++j)
#pragma unroll
                            for (int e = 0; e < 8; ++e) vv[j][e] = __builtin_nontemporal_load((const GAS float*)(cache_v + ((size_t)((b * 512 + 8 * (wave + 8 * (j + 4)) + e) * 16 + hd)) * 64 + lane));
#pragma unroll
                        for (int s4 = 0; s4 < 4; ++s4) { const float* a = pk + s4 * KQS_SLAB; const float* c = pv + s4 * KQS_SLAB;
                            sk[s4][0] = *(const GAS f32x4*)a; sk[s4][1] = *(const GAS f32x4*)(a + 4); sq4[s4][0] = *(const GAS f32x4*)(a + 1024); sq4[s4][1] = *(const GAS f32x4*)(a + 1028);
                            sv[s4][0] = *(const GAS f32x4*)c; sv[s4][1] = *(const GAS f32x4*)(c + 4); }
#pragma unroll
                        for (int j = 0; j < 4; ++j) { v4u w; w.x = pk2(vv[j][0], vv[j][1]); w.y = pk2(vv[j][2], vv[j][3]); w.z = pk2(vv[j][4], vv[j][5]); w.w = pk2(vv[j][6], vv[j][7]);
                            *(GAS v4u*)(VTs + ((size_t)((b * AH + hd) * 64 + lane)) * SKV + 8 * (wave + 8 * (j + 4))) = w; }
                        const f32x4 k0 = (sk[0][0] + sk[1][0]) + (sk[2][0] + sk[3][0]), k1 = (sk[0][1] + sk[1][1]) + (sk[2][1] + sk[3][1]);
                        const f32x4 q0 = (sq4[0][0] + sq4[1][0]) + (sq4[2][0] + sq4[3][0]), q1 = (sq4[0][1] + sq4[1][1]) + (sq4[2][1] + sq4[3][1]);
                        const f32x4 v0 = (sv[0][0] + sv[1][0]) + (sv[2][0] + sv[3][0]), v1 = (sv[0][1] + sv[1][1]) + (sv[2][1] + sv[3][1]);
                        v4u w; w.x = pk2(k0[0], k0[1]); w.y = pk2(k0[2], k0[3]); w.z = pk2(k1[0], k1[1]); w.w = pk2(k1[2], k1[3]);
                        *(GAS v4u*)(KHs + ((size_t)((b * AH + hd) * SKV + 512 + r)) * 64 + 8 * c8) = w;
                        { float* o = out + O_CK_S + (size_t)(b * 64 + r) * 1024 + hd * 64 + 8 * c8; *(GAS f32x4*)o = k0; *(GAS f32x4*)(o + 4) = k1; }
                        w.x = pk2(q0[0], q0[1]); w.y = pk2(q0[2], q0[3]); w.z = pk2(q1[0], q1[1]); w.w = pk2(q1[2], q1[3]);
                        *(GAS v4u*)(QHs + ((size_t)((b * AH + hd) * 64 + r)) * 64 + 8 * c8) = w;
                        w.x = pk2(v0[0], v0[1]); w.y = pk2(v0[2], v0[3]); w.z = pk2(v1[0], v1[1]); w.w = pk2(v1[2], v1[3]);
                        *(GAS v4u*)(VTs + ((size_t)((b * AH + hd) * 64 + r)) * SKV + 512 + 8 * c8) = w;
                        LAS float* tt = (LAS float*)(L + 81920);
#pragma unroll
                        for (int e = 0; e < 4; ++e) { tt[(8 * c8 + e) * 65 + r] = v0[e]; tt[(8 * c8 + 4 + e) * 65 + r] = v1[e]; }
                        __syncthreads();
                        f32x4 o0, o1;
#pragma unroll
                        for (int e = 0; e < 4; ++e) { o0[e] = tt[r * 65 + 8 * c8 + e]; o1[e] = tt[r * 65 + 8 * c8 + 4 + e]; }
                        float* o = out + O_CV_S + (size_t)(b * 64 + r) * 1024 + hd * 64 + 8 * c8; *(GAS f32x4*)o = o0; *(GAS f32x4*)(o + 4) = o1; } }
                  asm volatile("s_waitcnt vmcnt(0)" ::: "memory"); __syncthreads(); }
                bf16x8 qf[4]; v4u kreg, vreg;
                { ATTN_DECODE(F, bx)
#pragma unroll
                  for (int ks = 0; ks < 4; ++ks) qf[ks] = *(const GAS bf16x8*)(FQb + r32 * 64 + 8 * hi + 16 * ks);
                  kreg = *(const GAS v4u*)(FKHb + (size_t)(64 * Fkt_lo + srow) * 64 + 8 * sch); vreg = *(const GAS v4u*)(FVTb + (size_t)srow * FLk + 64 * Fkt_lo + 8 * sch); }
                for (int u = bx; u < 2304; u += G) {
                    ATTN_DECODE(U, u)
                    const int kt_lo = Ukt_lo, kt_hi = Usmp ? 8 : Uc0 + 3, hd = Uhd;
                    const bool active = Usmp ? (wave < 2) : true; const int cw = Usmp ? 8 : Uc0 + (wave >> 1);
                    const size_t m0 = Usmp ? (size_t)TP + Ub * 64 + Upos0 : (size_t)Ub * 2048 + Upos0;
                    const int qloc = (Usmp ? 512 + Upos0 : Upos0) + r32;
                    const int kt_first = cw - 8 > kt_lo ? cw - 8 : kt_lo;
                    const bool hasN = u + G < 2304;
                    bf16x8 qn[4];
                    float m_run = 0.f; f32x16 o0, o1, lacc;
#pragma unroll
                    for (int r = 0; r < 16; ++r) { o0[r] = 0.f; o1[r] = 0.f; lacc[r] = 0.f; }
                    const bf16x8 ones8 = __builtin_bit_cast(bf16x8, (v4u){0x3f803f80u, 0x3f803f80u, 0x3f803f80u, 0x3f803f80u});
                    *(LAS v4u*)(KsB + srow * 72 + 8 * sch) = kreg;
                    *(LAS v4u*)(VsB + srow * 72 + 8 * sch) = vreg;
                    __syncthreads();
                    if (hasN) { ATTN_DECODE(M, u + G)
#pragma unroll
                        for (int ks = 0; ks < 4; ++ks) qn[ks] = *(const GAS bf16x8*)(MQb + r32 * 64 + 8 * hi + 16 * ks); }
                    for (int kt = kt_lo; kt <= kt_hi; ++kt) {
                        PROF_TA(0);
                        const int buf = (kt - kt_lo) & 1;
                        if (kt < kt_hi) { kreg = *(const GAS v4u*)(UKHb + (size_t)(64 * (kt + 1) + srow) * 64 + 8 * sch); vreg = *(const GAS v4u*)(UVTb + (size_t)srow * ULk + 64 * (kt + 1) + 8 * sch); }
                        else if (hasN) {
                            ATTN_DECODE(N, u + G)
                            kreg = *(const GAS v4u*)(NKHb + (size_t)(64 * Nkt_lo + srow) * 64 + 8 * sch); vreg = *(const GAS v4u*)(NVTb + (size_t)srow * NLk + 64 * Nkt_lo + 8 * sch); (void)NQb; }
                        if (active && kt <= cw && kt + 8 >= cw) {
                            const LAS bf16* Ks = KsB + buf * (64 * 72); const LAS bf16* Vs = VsB + buf * (64 * 72);
                            f32x16 p0, p1; const float nm = -m_run; const int jj = cw - kt;
                            const bf16x8 a00 = *(const LAS bf16x8*)(Ks + krow * 72 + 8 * hi), a10 = *(const LAS bf16x8*)(Ks + (32 + krow) * 72 + 8 * hi);
                            if (jj >= 5) { const float bc = biasL[hd * 641 + 512] + nm; f32x16 bcv;
#pragma unroll
                                for (int r = 0; r < 16; ++r) bcv[r] = bc;
                                p0 = MFMA32(a00, qf[0], bcv); p1 = MFMA32(a10, qf[0], bcv); }
                            else { const int base = qloc - 64 * kt - 8 * hi + 256;
                                const LAS float* blp = biasL + hd * 641 + base - 63;
                                const f32x2_t nm2 = {nm, nm};
#define ATT_BINIT(r) { f32x2_t t0 = {blp[63 - (16 * ((r) >> 3) + ((r) & 7))], blp[62 - (16 * ((r) >> 3) + ((r) & 7))]}, t1 = {blp[31 - (16 * ((r) >> 3) + ((r) & 7))], blp[30 - (16 * ((r) >> 3) + ((r) & 7))]}; \
                                    t0 += nm2; t1 += nm2; p0[r] = t0[0]; p0[(r) + 1] = t0[1]; p1[r] = t1[0]; p1[(r) + 1] = t1[1]; }
                                ATT_BINIT(0) ATT_BINIT(2) ATT_BINIT(4) ATT_BINIT(6) ATT_BINIT(8) ATT_BINIT(10) ATT_BINIT(12) ATT_BINIT(14)
#undef ATT_BINIT
                                p0 = MFMA32(a00, qf[0], p0); p1 = MFMA32(a10, qf[0], p1); }
#pragma unroll
                            for (int ks = 1; ks < 4; ++ks) { const bf16x8 a0 = *(const LAS bf16x8*)(Ks + krow * 72 + 8 * hi + 16 * ks), a1 = *(const LAS bf16x8*)(Ks + (32 + krow) * 72 + 8 * hi + 16 * ks);
                                p0 = MFMA32(a0, qf[ks], p0); p1 = MFMA32(a1, qf[ks], p1); }
                            asm volatile("s_nop 15\n\ts_nop 7" : "+v"(p0), "+v"(p1));
                            float mx = max3f_(p0[0], p1[0], p0[1]), mxb = max3f_(p1[1], p0[2], p1[2]);
#pragma unroll
                            for (int r = 3; r < 15; r += 2) { mx = max3f_(mx, p0[r], p1[r]); mxb = max3f_(mxb, p0[r + 1], p1[r + 1]); }
                            mx = max3f_(mx, mxb, fmaxf(p0[15], p1[15]));
                            mx = xor32_max_(mx);
                            const bool first = (kt == kt_first);
                            if (first) {
                                m_run = mx;
#pragma unroll
                                for (int r = 0; r < 16; ++r) { p0[r] -= mx; p1[r] -= mx; } }
#pragma unroll
                            for (int r = 0; r < 16; ++r) { p0[r] = __builtin_amdgcn_exp2f(p0[r]); p1[r] = __builtin_amdgcn_exp2f(p1[r]); }
                            bf16x8 pb[4];
                            { float t[8];
#pragma unroll
                              for (int j = 0; j < 8; ++j) t[j] = p0[j];
                              pb[0] = pack8(t);
#pragma unroll
                              for (int j = 0; j < 8; ++j) t[j] = p0[8 + j];
                              pb[1] = pack8(t);
#pragma unroll
                              for (int j = 0; j < 8; ++j) t[j] = p1[j];
                              pb[2] = pack8(t);
#pragma unroll
                              for (int j = 0; j < 8; ++j) t[j] = p1[8 + j];
                              pb[3] = pack8(t); }
#pragma unroll
                            for (int s4 = 0; s4 < 4; ++s4) {
                                const bf16x8 A0 = *(const LAS bf16x8*)(Vs + r32 * 72 + 16 * s4 + 8 * hi), A1 = *(const LAS bf16x8*)(Vs + (32 + r32) * 72 + 16 * s4 + 8 * hi);
                                o0 = MFMA32(A0, pb[s4], o0); o1 = MFMA32(A1, pb[s4], o1); lacc = MFMA32(ones8, pb[s4], lacc); }
                            if (!first && __any(mx > 8.f)) { const float dl = fmaxf(mx, 0.f), alpha = __builtin_amdgcn_exp2f(-dl); m_run += dl;
#pragma unroll
                                for (int r = 0; r < 16; ++r) { o0[r] *= alpha; o1[r] *= alpha; lacc[r] *= alpha; } }
                        }
                        PROF_TA(1);
                        if (kt < kt_hi) { LAS bf16* Kn = KsB + (buf ^ 1) * (64 * 72); LAS bf16* Vn = VsB + (buf ^ 1) * (64 * 72);
                            *(LAS v4u*)(Kn + srow * 72 + 8 * sch) = kreg;
                            *(LAS v4u*)(Vn + srow * 72 + 8 * sch) = vreg; }
                        PROF_TA(2);
                        __syncthreads();
                        PROF_TA(3);
                    }
                    if (active) {
                        const float inv = 1.f / lacc[0];
                        bf16* op = AO + (m0 + r32) * DM + hd * 64 + 4 * hi;
#pragma unroll
                        for (int r4 = 0; r4 < 4; ++r4) { v2u w; w.x = pk2(o0[4 * r4] * inv, o0[4 * r4 + 1] * inv); w.y = pk2(o0[4 * r4 + 2] * inv, o0[4 * r4 + 3] * inv); *(GAS v2u*)(op + 8 * r4) = w;
                            v2u w2; w2.x = pk2(o1[4 * r4] * inv, o1[4 * r4 + 1] * inv); w2.y = pk2(o1[4 * r4 + 2] * inv, o1[4 * r4 + 3] * inv); *(GAS v2u*)(op + 32 + 8 * r4) = w2; }
                    }
                    if (hasN) {
#pragma unroll
                        for (int ks = 0; ks < 4; ++ks) qf[ks] = qn[ks]; }
                }
#undef ATTN_DECODE
            }
            GRID_BAR();
            GEMM1024_NORM(EpiPlain, ({MB, DM}), ({MB + (size_t)TP * DM, DM}), AO, Wo_t, DM, false, false, norm_w + (4 + 1) * DM, false, 1);
            GRID_BAR();
        }
        { PHASE_PTRS pg8::Gemm g{XN, Wf1_t + (size_t)layer * FF2 * DM, TT, FF2, DM, DM}; pg8::StaticOrder S; S.init(TT, FF2, G, bx); EpiSwiGLU E{HB};
          pg8::gemm_phase<EpiSwiGLU, pg8::StaticOrder, true, true>(L, g, S, E, wave_s); }
        GRID_BAR();
        GEMM1024_NORM(EpiPlain, ({MB, DM}), ({MB + (size_t)TP * DM, DM}), HB, Wf2_t + (size_t)layer * DM * FF, FF, false, layer == 1, norm_w + (layer * 4 + 3) * DM, true, 2 + layer);
        if (layer == 0) GRID_BAR();
        }
#if PROF_K >= 0
    {
        PHASE_IDS PHASE_PTRS
        STAMP();
        LAS float* fs = (LAS float*)(L + MISC_OFF + 512);
        __syncthreads();
        if (tid == 0) { volatile LAS unsigned long long* ts = (volatile LAS unsigned long long*)(MISC + 8); const int k0 = PROF_K % 100;
            const unsigned long long d = (k0 == 50) ? ts[n_stamp - 1] - ts[0] : (k0 == 60 || k0 == 70) ? pt_acc0 : (k0 == 61 || k0 == 71) ? pt_acc1 : (k0 == 62 || k0 == 72) ? pt_acc2 : (k0 == 63 || k0 == 73) ? pt_acc3 : ts[k0 + 1] - ts[k0]; fs[0] = 1.f + (float)d * 0.01f * (PROF_K >= 100 ? 1e-4f : 5e-4f); }
        __syncthreads();
        const float f = fs[0];
        GRID_BAR();
        for (size_t i = gtid; i < 1048576; i += gsz) out[O_CV_S + i] *= f;
    }
#endif
}

extern "C" void kernel_launch(void* const* d_in, const int* in_sizes, int n_in, void* d_out, int out_size, void* d_ws, size_t ws_size, hipStream_t stream) {
    static int grid = 0;
    if (grid == 0) {
        int dev = 0, cus = 0, per_cu = 0;
        (void)hipGetDevice(&dev);
        (void)hipDeviceGetAttribute(&cus, hipDeviceAttributeMultiprocessorCount, dev);
        (void)hipFuncSetAttribute((const void*)mk_fwd, hipFuncAttributeMaxDynamicSharedMemorySize, LDS_BYTES);
        (void)hipOccupancyMaxActiveBlocksPerMultiprocessor(&per_cu, (const void*)mk_fwd, NTHREADS, LDS_BYTES);
        fprintf(stderr, "kernel_launch: cus %d per_cu %d ws_size %zu n_in %d out_size %d\n", cus, per_cu, ws_size, n_in, out_size);
        if (ws_size < WS_END3 || n_in != 22 || (size_t)out_size != O_TOTAL) { fprintf(stderr, "kernel_launch: unexpected sizes\n"); grid = -1; return; }
        grid = cus;
    }
    if (grid < 0) return;
    (void)hipMemsetAsync((char*)d_ws + WS_CTL, 0, 1 * MiB, stream);
    Args a{};
    for (int i = 0; i < 22; ++i) a.in[i] = (const float*)d_in[i];
    a.out = (float*)d_out; a.ws = (unsigned char*)d_ws; a.dbg = 0; a.pad = 0;
    void* args[] = {&a};
    hipError_t e = hipLaunchCooperativeKernel((const void*)mk_fwd, dim3(grid), dim3(NTHREADS), args, LDS_BYTES, stream);
    if (e != hipSuccess) fprintf(stderr, "cooperative launch failed: %s (grid %d)\n", hipGetErrorString(e), grid);
}
```

```cpp
#include <hip/hip_runtime.h>
#include <hip/hip_cooperative_groups.h>
#include <cstdio>
#include <cstdint>
namespace cg = cooperative_groups;
#define PROF_K (-1)

__device__ __forceinline__ int fresh_lane() { unsigned z = 0u; asm volatile("" : "+v"(z)); return (int)__builtin_amdgcn_mbcnt_hi(~0u, __builtin_amdgcn_mbcnt_lo(~0u, z)); }
namespace pg8 {
#define PG8_LAS __attribute__((address_space(3)))
typedef unsigned short bf16_t;
typedef short bf16x8 __attribute__((ext_vector_type(8)));
typedef float f32x4 __attribute__((ext_vector_type(4)));
typedef unsigned u32x4 __attribute__((ext_vector_type(4)));
constexpr int BM = 256, BK = 64, HALF = 128, HTB = HALF * BK * 2, STAGE_BYTES = 8 * HTB, NXCD = 8, WGM = 8;

__host__ __device__ __forceinline__ int lds_byte(int r, int c) { const int st = (r >> 4) * 2 + (c >> 5), rr = r & 15, cc = c & 31, ob = rr * 64 + cc * 2; return st * 1024 + (ob ^ (((ob >> 9) & 1) << 5)); }
__host__ __device__ __forceinline__ void stage_rc(int b, int& R, int& C) { const int st = b / 1024, sb = b % 1024, swz = sb ^ (((sb >> 9) & 1) << 5); R = (st >> 1) * 16 + swz / 64; C = (st & 1) * 32 + (swz % 64) / 2; }
__host__ __device__ __forceinline__ int perm32(int rho) { const int n = rho >> 4, i = rho & 15; return 8 * (i >> 2) + 4 * n + (i & 3); }

struct Unit { int pm, pn, w; };
struct Gemm { const bf16_t* A; const bf16_t* Bt; int M, N, K, ld; };

struct StaticOrder {
    int nM, nN, nwg, G, c;
    __host__ __device__ void init(int M, int N, int G_, int c_) { nM = M / BM; nN = N / BM; nwg = nM * nN; G = G_; c = c_; }
    __host__ __device__ bool next(int i, Unit& u) const {
        const long L = (long)i * G + c; if (L >= nwg) return false;
        int wgid = (int)L; { const int q = nwg / NXCD, r = nwg % NXCD, xcd = wgid % NXCD, off = wgid / NXCD; wgid = (xcd < r ? xcd * (q + 1) : r * (q + 1) + (xcd - r) * q) + off; }
        const int nig = WGM * nN, gid = wgid / nig, fm = gid * WGM, gsz = (nM - fm) < WGM ? (nM - fm) : WGM;
        u.pm = fm + ((wgid % nig) % gsz); u.pn = (wgid % nig) / gsz; u.w = 0; return true;
    }
    __device__ __forceinline__ void a_ready(const Unit&) const {}
    __device__ __forceinline__ void done(const Unit&) const {}
    __device__ __forceinline__ long offA(const Unit&) const { return 0; }
    __device__ __forceinline__ long offB(const Unit&) const { return 0; }
    __device__ __forceinline__ int nt(const Unit&, int d) const { return d; }
};
struct SplitOrder2 {
    int c; long koff;
    __device__ __forceinline__ bool next(int i, Unit& u) const { if (i > 0 || c >= 32) return false; const int t = c >> 1; u.pm = t >> 2; u.pn = t & 3; u.w = c & 1; return true; }
    __device__ __forceinline__ void a_ready(const Unit&) const {}
    __device__ __forceinline__ void done(const Unit&) const {}
    __device__ __forceinline__ long offA(const Unit& u) const { return u.w ? koff : 0; }
    __device__ __forceinline__ long offB(const Unit& u) const { return u.w ? koff : 0; }
    __device__ __forceinline__ int nt(const Unit&, int d) const { return d; }
};
struct DualOrder {
    int nM0, nN0, nM1, nN1, n0, n1, G, c; long dA, dB;
    __device__ __forceinline__ void init(int M0, int N0, int M1, int N1, int G_, int c_) { nM0 = M0 / BM; nN0 = N0 / BM; nM1 = M1 / BM; nN1 = N1 / BM; n0 = nM0 * nN0; n1 = nM1 * nN1; G = G_; c = c_; }
    __device__ __forceinline__ bool next(int i, Unit& u) const {
        const int Lx = i * G + c; if (Lx >= n0 + n1) return false;
        const int w = Lx >= n0 ? 1 : 0; const int nwg = w ? n1 : n0, nN = w ? nN1 : nN0, nM = w ? nM1 : nM0;
        int wgid = w ? Lx - n0 : Lx; { const int q = nwg / NXCD, r = nwg % NXCD, xcd = wgid % NXCD, off = wgid / NXCD; wgid = (xcd < r ? xcd * (q + 1) : r * (q + 1) + (xcd - r) * q) + off; }
        const int nig = WGM * nN, gid = wgid / nig, fm = gid * WGM, gsz = (nM - fm) < WGM ? (nM - fm) : WGM;
        u.pm = fm + ((wgid % nig) % gsz); u.pn = (wgid % nig) / gsz; u.w = w; return true; }
    __device__ __forceinline__ void a_ready(const Unit&) const {}
    __device__ __forceinline__ void done(const Unit&) const {}
    __device__ __forceinline__ long offA(const Unit& u) const { return u.w ? dA : 0; }
    __device__ __forceinline__ long offB(const Unit& u) const { return u.w ? dB : 0; }
    __device__ __forceinline__ int nt(const Unit&, int d) const { return d; }
};
struct KqvtOrder {
    int G, c; long dA, dB;
    __device__ __forceinline__ bool next(int i, Unit& u) const {
        const int Lx = i * G + c; if (Lx >= 1728) return false;
        if (Lx >= 1536) { const int q = Lx - 1536, kq = q & 3, tile = q >> 2;
            if (tile < 32) { u.pm = 128 + (tile >> 3); u.pn = tile & 7; u.w = 2 + 2 * kq; } else { const int t2 = tile - 32; u.pm = t2 >> 2; u.pn = 128 + (t2 & 3); u.w = 3 + 2 * kq; }
            return true; }
        const int w = Lx >= 1024 ? 1 : 0; const int nwg = w ? 512 : 1024, nN = w ? 128 : 8, nM = w ? 4 : 128;
        int wgid = w ? Lx - 1024 : Lx; { const int q = nwg / NXCD, xcd = wgid % NXCD, off = wgid / NXCD; wgid = xcd * q + off; }
        const int nig = WGM * nN, gid = wgid / nig, fm = gid * WGM, gsz = (nM - fm) < WGM ? (nM - fm) : WGM;
        u.pm = fm + ((wgid % nig) % gsz); u.pn = (wgid % nig) / gsz; u.w = w; return true; }
    __device__ __forceinline__ void a_ready(const Unit&) const {}
    __device__ __forceinline__ void done(const Unit&) const {}
    __device__ __forceinline__ long offA(const Unit& u) const { return ((u.w & 1) ? dA : 0) + (u.w >= 2 ? (long)((u.w - 2) >> 1) * 512 : 0); }
    __device__ __forceinline__ long offB(const Unit& u) const { return ((u.w & 1) ? dB : 0) + (u.w >= 2 ? (long)((u.w - 2) >> 1) * 512 : 0); }
    __device__ __forceinline__ int nt(const Unit& u, int d) const { return u.w >= 2 ? 4 : d; }
};

template <class Epi, class Sched, bool ALIGN_EPI = false, bool SP2 = false>
__device__ __forceinline__ void gemm_phase(PG8_LAS unsigned char* lds, const Gemm g, const Sched& S, const Epi& E, int wave_id) {
    int tid_ = wave_id * 64 + fresh_lane(); asm volatile("" : "+v"(tid_));
    const int tid = tid_, wid = __builtin_amdgcn_readfirstlane(tid >> 6), lane = tid & 63, wr = wid >> 2, wc = wid & 3, fr = lane & 15, fq = lane >> 4;
    const int K = g.K, nt = K / BK;
    unsigned voffA[2], voffB[2];
#pragma unroll
    for (int i = 0; i < 2; ++i) { int R, C; stage_rc(tid * 16 + i * 8192, R, C); const int Rb = Epi::PERM ? ((R & ~31) + perm32(R & 31)) : R;
        voffA[i] = (unsigned)(R * g.ld + C) * 2u; voffB[i] = (unsigned)(Rb * g.ld + C) * 2u; }
    const size_t kstep = (size_t)(BK * 2);
    const size_t hstep = (size_t)HALF * g.ld * 2;
    const size_t tstep = 2 * hstep;
    const unsigned ldsw = (unsigned)wid * 1024u;
    const int aoff = lds_byte(wr * 64 + fr, fq * 8), boff = lds_byte(wc * 32 + fr, fq * 8);
#define PG8_SA(b, h) (((b) * 2 + (h)) * HTB)
#define PG8_SB(b, h) ((4 + (b) * 2 + (h)) * HTB)
#define PG8_STAGE(bufoff, gbase, voff) do { _Pragma("unroll") for (int _i = 0; _i < 2; ++_i) \
        __builtin_amdgcn_global_load_lds((const unsigned*)((const char*)(gbase) + (voff)[_i]), (PG8_LAS unsigned*)(lds + (bufoff) + ldsw + _i * 8192), 16, 0, 0); } while (0)
#define PG8_LDA(dst, b, h) do { _Pragma("unroll") for (int m = 0; m < 4; ++m) _Pragma("unroll") for (int k = 0; k < 2; ++k) dst[m][k] = *(const PG8_LAS bf16x8*)(lds + PG8_SA(b, h) + aoff + m * 2048 + k * 1024); } while (0)
#define PG8_LDB(dst, b, h) do { _Pragma("unroll") for (int n = 0; n < 2; ++n) _Pragma("unroll") for (int k = 0; k < 2; ++k) dst[n][k] = *(const PG8_LAS bf16x8*)(lds + PG8_SB(b, h) + boff + n * 2048 + k * 1024); } while (0)
#define PG8_MMA(ai, bj, At, Bt) do { __builtin_amdgcn_s_setprio(1); _Pragma("unroll") for (int m = 0; m < 4; ++m) _Pragma("unroll") for (int n = 0; n < 2; ++n) _Pragma("unroll") for (int k = 0; k < 2; ++k) \
        acc[ai][bj][m][n] = __builtin_amdgcn_mfma_f32_16x16x32_bf16(Bt[n][k], At[m][k], acc[ai][bj][m][n], 0, 0, 0); __builtin_amdgcn_s_setprio(0); } while (0)
#define PG8_WAIT_V(n) asm volatile("s_waitcnt vmcnt(" #n ")" ::: "memory")
#define PG8_WAIT_L(n) asm volatile("s_waitcnt lgkmcnt(" #n ")" ::: "memory")
#define PG8_BAR __builtin_amdgcn_s_barrier()
#define PG8_SCHED __builtin_amdgcn_sched_barrier(0)
    Unit cur, nxt; int ui = 0;
    if (!S.next(0, cur)) return;
    f32x4 acc[2][2][4][2];
#pragma unroll
    for (int a = 0; a < 2; ++a)
#pragma unroll
        for (int b = 0; b < 2; ++b)
#pragma unroll
            for (int m = 0; m < 4; ++m)
#pragma unroll
                for (int n = 0; n < 2; ++n) acc[a][b][m][n] = (f32x4){0.f, 0.f, 0.f, 0.f};
    bf16x8 At[4][2], B0[2][2], B1[2][2];
    const char* cA = (const char*)g.A + (size_t)cur.pm * tstep + S.offA(cur); const char* cB = (const char*)g.Bt + (size_t)cur.pn * tstep + S.offB(cur);
    S.a_ready(cur);
    if constexpr (SP2) {
        PG8_STAGE(PG8_SB(0, 0), cB, voffB); PG8_STAGE(PG8_SB(0, 1), cB + hstep, voffB); PG8_STAGE(PG8_SA(0, 0), cA, voffA); PG8_STAGE(PG8_SA(0, 1), cA + hstep, voffA);
        if (wr == 1) PG8_BAR;
        PG8_WAIT_V(2); PG8_BAR;
        PG8_STAGE(PG8_SB(1, 0), cB + kstep, voffB); PG8_STAGE(PG8_SA(1, 0), cA + kstep, voffA); PG8_STAGE(PG8_SB(1, 1), cB + hstep + kstep, voffB);
        PG8_WAIT_V(6); PG8_BAR;
    } else {
        PG8_STAGE(PG8_SB(0, 0), cB, voffB); PG8_STAGE(PG8_SA(0, 0), cA, voffA); PG8_STAGE(PG8_SB(0, 1), cB + hstep, voffB); PG8_STAGE(PG8_SA(0, 1), cA + hstep, voffA);
        if (wr == 1) PG8_BAR;
        PG8_WAIT_V(4); PG8_BAR;
        PG8_STAGE(PG8_SB(1, 0), cB + kstep, voffB); PG8_STAGE(PG8_SA(1, 0), cA + kstep, voffA); PG8_STAGE(PG8_SB(1, 1), cB + hstep + kstep, voffB);
        PG8_WAIT_V(6); PG8_BAR;
    }
    for (;;) {
        const bool has_next = S.next(ui + 1, nxt);
        const char* nA = has_next ? (const char*)g.A + (size_t)nxt.pm * tstep + S.offA(nxt) : cA; const char* nB = has_next ? (const char*)g.Bt + (size_t)nxt.pn * tstep + S.offB(nxt) : cB;
        const int ntc = S.nt(cur, nt);
        for (int t = 0; t < ntc; t += 2) {
            const bool last = (t == ntc - 2);
            const char* a1 = cA + (size_t)(t + 1) * kstep;
            const char* a2 = last ? nA : cA + (size_t)(t + 2) * kstep; const char* b2 = last ? nB : cB + (size_t)(t + 2) * kstep;
            const char* a3 = a2 + kstep; const char* b3 = b2 + kstep;
            if (last && has_next) S.a_ready(nxt);
            if constexpr (Epi::KSCALE) { if (t == 0) E.unit_begin(cur, ui, lds, tid); else if ((t & 7) == 0) E.kscale(acc, ui, t >> 3, lds, wr, fr); }
            if constexpr (SP2) {
            PG8_LDB(B0, 0, 0); PG8_LDB(B1, 0, 1); PG8_SCHED; PG8_LDA(At, 0, 0); PG8_STAGE(PG8_SA(1, 1), a1 + hstep, voffA);
            PG8_WAIT_V(8); PG8_WAIT_L(0); PG8_BAR; PG8_MMA(0, 0, At, B0); PG8_MMA(0, 1, At, B1); PG8_BAR; PG8_SCHED;
            PG8_LDA(At, 0, 1); PG8_STAGE(PG8_SB(0, 0), b2, voffB); PG8_STAGE(PG8_SB(0, 1), b2 + hstep, voffB); PG8_STAGE(PG8_SA(0, 0), a2, voffA);
            PG8_WAIT_V(8); PG8_WAIT_L(0); PG8_BAR; PG8_MMA(1, 0, At, B0); PG8_MMA(1, 1, At, B1); PG8_BAR; PG8_SCHED;
            PG8_LDB(B0, 1, 0); PG8_LDB(B1, 1, 1); PG8_SCHED; PG8_LDA(At, 1, 0); PG8_STAGE(PG8_SA(0, 1), a2 + hstep, voffA);
            PG8_WAIT_V(8); PG8_WAIT_L(0); PG8_BAR; PG8_MMA(0, 0, At, B0); PG8_MMA(0, 1, At, B1); PG8_BAR; PG8_SCHED;
            PG8_LDA(At, 1, 1); PG8_STAGE(PG8_SB(1, 0), b3, voffB); PG8_STAGE(PG8_SB(1, 1), b3 + hstep, voffB); PG8_STAGE(PG8_SA(1, 0), a3, voffA);
            PG8_WAIT_V(8); PG8_WAIT_L(0); PG8_BAR; PG8_MMA(1, 0, At, B0); PG8_MMA(1, 1, At, B1); PG8_BAR; PG8_SCHED;
            } else {
            PG8_LDB(B0, 0, 0); PG8_SCHED; PG8_LDA(At, 0, 0); PG8_STAGE(PG8_SA(1, 1), a1 + hstep, voffA);
            PG8_WAIT_L(8); PG8_BAR; PG8_WAIT_L(0); PG8_MMA(0, 0, At, B0); PG8_BAR; PG8_SCHED;
            PG8_LDB(B1, 0, 1); PG8_STAGE(PG8_SB(0, 0), b2, voffB);
            PG8_BAR; PG8_WAIT_L(0); PG8_MMA(0, 1, At, B1); PG8_BAR;
            PG8_LDA(At, 0, 1); PG8_STAGE(PG8_SA(0, 0), a2, voffA);
            PG8_BAR; PG8_WAIT_L(0); PG8_MMA(1, 0, At, B0); PG8_BAR; PG8_SCHED;
            PG8_STAGE(PG8_SB(0, 1), b2 + hstep, voffB);
            PG8_WAIT_V(6); PG8_BAR; PG8_MMA(1, 1, At, B1); PG8_BAR;
            PG8_LDB(B0, 1, 0); PG8_SCHED; PG8_LDA(At, 1, 0); PG8_STAGE(PG8_SA(0, 1), a2 + hstep, voffA);
            PG8_WAIT_L(8); PG8_BAR; PG8_WAIT_L(0); PG8_MMA(0, 0, At, B0); PG8_BAR; PG8_SCHED;
            PG8_LDB(B1, 1, 1); PG8_STAGE(PG8_SB(1, 0), b3, voffB);
            PG8_BAR; PG8_WAIT_L(0); PG8_MMA(0, 1, At, B1); PG8_BAR;
            PG8_LDA(At, 1, 1); PG8_STAGE(PG8_SA(1, 0), a3, voffA);
            PG8_BAR; PG8_WAIT_L(0); PG8_MMA(1, 0, At, B0); PG8_BAR; PG8_SCHED;
            PG8_STAGE(PG8_SB(1, 1), b3 + hstep, voffB);
            PG8_WAIT_V(6); PG8_BAR; PG8_MMA(1, 1, At, B1); PG8_BAR;
            }
        }
        if constexpr (ALIGN_EPI) { if (wr == 0) PG8_BAR; }
        if constexpr (Epi::KSCALE) E.final(acc, cur, ui, lds, wr, wc, fr, fq); else E(acc, cur, wr, wc, fr, fq);
        S.done(cur);
        if (!has_next) break;
#pragma unroll
        for (int a = 0; a < 2; ++a)
#pragma unroll
            for (int b = 0; b < 2; ++b)
#pragma unroll
                for (int m = 0; m < 4; ++m)
#pragma unroll
                    for (int n = 0; n < 2; ++n) acc[a][b][m][n] = (f32x4){0.f, 0.f, 0.f, 0.f};
        cur = nxt; cA = nA; cB = nB; ++ui;
        if constexpr (ALIGN_EPI) { if (wr == 1) PG8_BAR; }
    }
    PG8_WAIT_V(0);
    if constexpr (!ALIGN_EPI) { if (wr == 0) PG8_BAR; }
    PG8_BAR;
#undef PG8_SA
#undef PG8_SB
#undef PG8_STAGE
#undef PG8_LDA
#undef PG8_LDB
#undef PG8_MMA
#undef PG8_WAIT_V
#undef PG8_WAIT_L
#undef PG8_BAR
#undef PG8_SCHED
}
}

constexpr int NTHREADS = 512, NWAVES = 8;
constexpr int LDS_BYTES = 147456;
constexpr int DM = 1024, TP = 32768, TS = 1024, TT = TP + TS;
constexpr int DI = 2048, NH = 32, HD = 64, NG = 4, NS = 128, CONVD = 3072, INPROJ = 5152, INPROJ_PAD = 5376;
constexpr int FF = 2816, FF2 = 5632;
constexpr int AH = 16;
constexpr float EPS = 1e-6f;
constexpr size_t O_Y = 0, O_SSM_P = 34603008, O_CONV_P = 38797312, O_CK_P = 38944768, O_CV_P = 47333376,
                 O_SSM_S = 55721984, O_CONV_S = 59916288, O_CK_S = 60063744, O_CV_S = 61112320, O_TOTAL = 62160896;
constexpr size_t MiB = 1u << 20;
constexpr size_t WS_CTL = 0;
constexpr size_t WS_WIN = 2 * MiB;
constexpr size_t WS_WOUT = WS_WIN + (size_t)INPROJ_PAD * DM * 2;
constexpr size_t WS_WF1 = WS_WOUT + (size_t)DM * DI * 2;
constexpr size_t WS_WF2 = WS_WF1 + 2 * (size_t)FF2 * DM * 2;
constexpr size_t WS_WKQ = WS_WF2 + 2 * (size_t)DM * FF * 2;
constexpr size_t WS_WV = WS_WKQ + (size_t)2048 * DM * 2;
constexpr size_t WS_WO = WS_WV + (size_t)DM * DM * 2;
constexpr size_t WS_WEND = WS_WO + (size_t)DM * DM * 2;
constexpr size_t WS_SSQ = 60 * MiB;
constexpr size_t WS_XN = 64 * MiB;
constexpr size_t WS_R = 130 * MiB;
constexpr size_t WS_Z = WS_R;
constexpr size_t WS_XBC = WS_R + 132 * MiB;
constexpr size_t WS_DT = WS_R + 330 * MiB;
constexpr size_t WS_END = WS_R + 336 * MiB;
constexpr size_t WS_M = WS_R + 264 * MiB;
constexpr size_t WS_H = WS_R;
constexpr size_t WS_KHP = WS_R, WS_QHP = WS_R + 64 * MiB, WS_VTP = WS_R + 128 * MiB;
constexpr size_t WS_KHS = WS_END, WS_VTS = WS_END + 18 * MiB, WS_QHS = WS_END + 36 * MiB, WS_END2 = WS_END + 38 * MiB, WS_SLAB = WS_END2, WS_END3 = WS_END2 + 8 * MiB;
constexpr size_t WS_AO = WS_R + 192 * MiB;
constexpr size_t WS_SQ = 61 * MiB;
constexpr int SKV = 576;
static_assert(WS_WEND <= WS_SSQ, "weights overflow");

#define GAS __attribute__((address_space(1)))
#define LAS __attribute__((address_space(3)))
typedef unsigned short bf16;
typedef unsigned v4u __attribute__((ext_vector_type(4)));
typedef unsigned v2u __attribute__((ext_vector_type(2)));
typedef float f32x4 __attribute__((ext_vector_type(4)));
typedef short bf16x8 __attribute__((ext_vector_type(8)));
#define LDS_WAIT() asm volatile("s_waitcnt lgkmcnt(0)" ::: "memory")

__device__ __forceinline__ unsigned f2bf(float f) { unsigned u = __builtin_bit_cast(unsigned, f); return (u + 0x7fffu + ((u >> 16) & 1u)) >> 16; }
typedef float f32x2_t __attribute__((ext_vector_type(2))); typedef __bf16 bf16x2_t __attribute__((ext_vector_type(2)));
__device__ __forceinline__ unsigned pk2(float lo, float hi) { const f32x2_t v = {lo, hi}; const bf16x2_t b = __builtin_convertvector(v, bf16x2_t); return __builtin_bit_cast(unsigned, b); }
__device__ __forceinline__ float bflo(unsigned u) { return __builtin_bit_cast(float, u << 16); }
__device__ __forceinline__ float bfhi(unsigned u) { return __builtin_bit_cast(float, u & 0xffff0000u); }
__device__ __forceinline__ float wave_sum(float v) {
#pragma unroll
    for (int o = 1; o < 64; o <<= 1) v += __shfl_xor(v, o);
    return v;
}

__device__ __forceinline__ float xor32_f(float v) { const auto rr = __builtin_amdgcn_permlane32_swap(__builtin_bit_cast(unsigned, v), __builtin_bit_cast(unsigned, v), false, false); const unsigned lo = rr[0], hi = rr[1];
    return __builtin_bit_cast(float, (fresh_lane() & 32) ? lo : hi); }
#define DPP_ADD(x, ctrl, rmask) ((x) + __builtin_bit_cast(float, __builtin_amdgcn_update_dpp(0, __builtin_bit_cast(int, (x)), (ctrl), (rmask), 0xf, false)))
__device__ __forceinline__ float wave_scan_incl(float x) {
    x = DPP_ADD(x, 0x111, 0xf); x = DPP_ADD(x, 0x112, 0xf); x = DPP_ADD(x, 0x114, 0xf); x = DPP_ADD(x, 0x118, 0xf);
    x = DPP_ADD(x, 0x142, 0xa); x = DPP_ADD(x, 0x143, 0xc); return x; }
__device__ __forceinline__ float xor32_max_(float v) { const auto rr = __builtin_amdgcn_permlane32_swap(__builtin_bit_cast(unsigned, v), __builtin_bit_cast(unsigned, v), false, false); return fmaxf(__builtin_bit_cast(float, (unsigned)rr[0]), __builtin_bit_cast(float, (unsigned)rr[1])); }
__device__ __forceinline__ float xor32_sum_(float v) { const auto rr = __builtin_amdgcn_permlane32_swap(__builtin_bit_cast(unsigned, v), __builtin_bit_cast(unsigned, v), false, false); return __builtin_bit_cast(float, (unsigned)rr[0]) + __builtin_bit_cast(float, (unsigned)rr[1]); }
__device__ __forceinline__ float max3f_(float a, float b, float c) { float r; asm("v_max3_f32 %0, %1, %2, %3" : "=v"(r) : "v"(a), "v"(b), "v"(c)); return r; }
struct Args { const float* in[22]; float* out; unsigned char* ws; int dbg; int pad; };

__device__ __forceinline__ void tr_item(const float* W, int Nsrc, int K, bf16* WT, int r0, int c0, int k0, const float* kscale, float cmul, LAS float* scr, int lane) {
    const int kq = lane >> 3, n4 = (lane & 7) * 4;
    f32x4 v[8]; float sc[8];
#pragma unroll
    for (int i = 0; i < 8; ++i) { const int kk = kq + 8 * i;
        v[i] = (c0 >= 0) ? __builtin_nontemporal_load((const GAS f32x4*)(W + (size_t)(k0 + kk) * Nsrc + c0 + n4)) : (f32x4){0.f, 0.f, 0.f, 0.f};
        sc[i] = kscale ? kscale[k0 + kk] * cmul : cmul; }
#pragma unroll
    for (int i = 0; i < 8; ++i) { const int kk = kq + 8 * i; LAS float* d = scr + kk * 33 + n4; d[0] = v[i][0] * sc[i]; d[1] = v[i][1] * sc[i]; d[2] = v[i][2] * sc[i]; d[3] = v[i][3] * sc[i]; }
    LDS_WAIT(); asm volatile("" ::: "memory");
    const int c = lane & 7;
#pragma unroll
    for (int j = 0; j < 4; ++j) { const int n = (lane >> 3) + 8 * j; const LAS float* s = scr + (8 * c) * 33 + n;
        v4u o; o.x = pk2(s[0 * 33], s[1 * 33]); o.y = pk2(s[2 * 33], s[3 * 33]); o.z = pk2(s[4 * 33], s[5 * 33]); o.w = pk2(s[6 * 33], s[7 * 33]);
        *(GAS v4u*)(WT + (size_t)(r0 + n) * K + k0 + 8 * c) = o; }
    LDS_WAIT(); asm volatile("" ::: "memory");
}
__device__ __forceinline__ void rms_row2_to_bf16(const float* xrow, bf16* orow, int lane) {
    f32x4 v[2][4]; float s[2] = {0.f, 0.f};
#pragma unroll
    for (int r = 0; r < 2; ++r)
#pragma unroll
        for (int j = 0; j < 4; ++j) { v[r][j] = __builtin_nontemporal_load((const GAS f32x4*)(xrow + r * DM + 4 * lane + 256 * j)); s[r] += (v[r][j].x * v[r][j].x + v[r][j].y * v[r][j].y) + (v[r][j].z * v[r][j].z + v[r][j].w * v[r][j].w); }
#pragma unroll
    for (int r = 0; r < 2; ++r) { const float rstd = __builtin_amdgcn_rsqf(wave_sum(s[r]) * (1.f / DM) + EPS);
#pragma unroll
        for (int j = 0; j < 4; ++j) { v2u o; o.x = pk2(v[r][j].x * rstd, v[r][j].y * rstd); o.y = pk2(v[r][j].z * rstd, v[r][j].w * rstd); *(GAS v2u*)(orow + r * DM + 4 * lane + 256 * j) = o; } }
}

struct EpiInProj {
    static constexpr bool PERM = true, KSCALE = false;
    bf16* Z; bf16* XBC; float* DT; float* out;
    __device__ __forceinline__ void operator()(const f32x4 (&acc)[2][2][4][2], const pg8::Unit& u, int wr, int wc, int fr, int fq) const {
        const int row0 = u.pm * 256 + wr * 64 + fr; const int ct = u.pn; const int cl = wc * 32 + 8 * fq;
#pragma unroll
        for (int ai = 0; ai < 2; ++ai)
#pragma unroll
            for (int m = 0; m < 4; ++m) {
                const int row = row0 + ai * 128 + m * 16;
#pragma unroll
                for (int bj = 0; bj < 2; ++bj) {
                    const f32x4 v0 = acc[ai][bj][m][0], v1 = acc[ai][bj][m][1];
                    v4u w; w.x = pk2(v0[0], v0[1]); w.y = pk2(v0[2], v0[3]); w.z = pk2(v1[0], v1[1]); w.w = pk2(v1[2], v1[3]);
                    const int c = bj * 128 + cl;
                    if (ct < 8) { *(GAS v4u*)(Z + (size_t)row * DI + ct * 256 + c) = w; }
                    else if (ct < 20) {
                        const int col = (ct - 8) * 256 + c;
                        *(GAS v4u*)(XBC + (size_t)row * CONVD + col) = w;
                        int pos, b; size_t ob; int L;
                        if (row < TP) { b = row >> 11; pos = row & 2047; L = 2048; ob = O_CONV_P; } else { b = (row - TP) >> 6; pos = (row - TP) & 63; L = 64; ob = O_CONV_S; }
                        if (pos >= L - 3) { float* o = out + ob + (size_t)(b * 3 + (pos - (L - 3))) * CONVD + col; *(GAS f32x4*)o = v0; *(GAS f32x4*)(o + 4) = v1; }
                    } else {
                        if (bj == 0 && wc == 0) { float* o = DT + (size_t)row * 32 + 8 * fq; *(GAS f32x4*)o = v0; *(GAS f32x4*)(o + 4) = v1; }
                    }
                }
            }
    }
};

struct EpiPlain {
    static constexpr bool PERM = true, KSCALE = false;
    bf16* O; int ldc;
    __device__ __forceinline__ void operator()(const f32x4 (&acc)[2][2][4][2], const pg8::Unit& u, int wr, int wc, int fr, int fq) const {
        const int row0 = u.pm * 256 + wr * 64 + fr, col0 = u.pn * 256 + wc * 32 + 8 * fq;
#pragma unroll
        for (int ai = 0; ai < 2; ++ai)
#pragma unroll
            for (int m = 0; m < 4; ++m) { bf16* rowp = O + (size_t)(row0 + ai * 128 + m * 16) * ldc + col0;
#pragma unroll
                for (int bj = 0; bj < 2; ++bj) { const f32x4 v0 = acc[ai][bj][m][0], v1 = acc[ai][bj][m][1];
                    v4u w; w.x = pk2(v0[0], v0[1]); w.y = pk2(v0[2], v0[3]); w.z = pk2(v1[0], v1[1]); w.w = pk2(v1[2], v1[3]);
                    *(GAS v4u*)(rowp + bj * 128) = w; } }
    }
};
constexpr int KS_OFF = 135168;
struct EpiOutProj {
    static constexpr bool PERM = true, KSCALE = true;
    bf16* O; int ldc; const float* ssq;
    __device__ __forceinline__ void unit_begin(const pg8::Unit& u, int ui, PG8_LAS unsigned char* lds, int tid) const {
        asm volatile("" : "+v"(tid));
        if (tid < 256) { const f32x4 v = *(const GAS f32x4*)(ssq + (size_t)(u.pm * 256 + tid) * 4);
            const float a0 = v[0] * (1.f / 512.f) + EPS, a1 = v[1] * (1.f / 512.f) + EPS, a2 = v[2] * (1.f / 512.f) + EPS, a3 = v[3] * (1.f / 512.f) + EPS;
            f32x4 r; r[0] = __builtin_amdgcn_rsqf(a0) * __builtin_amdgcn_sqrtf(a1); r[1] = __builtin_amdgcn_rsqf(a1) * __builtin_amdgcn_sqrtf(a2); r[2] = __builtin_amdgcn_rsqf(a2) * __builtin_amdgcn_sqrtf(a3); r[3] = __builtin_amdgcn_rsqf(a3);
            *(PG8_LAS f32x4*)(lds + KS_OFF + (ui & 1) * 4096 + tid * 16) = r; }
    }
    __device__ __forceinline__ void kscale(f32x4 (&acc)[2][2][4][2], int ui, int g, PG8_LAS unsigned char* lds, int wr, int fr) const {
        asm volatile("" : "+v"(fr));
        const PG8_LAS float* rt = (const PG8_LAS float*)(lds + KS_OFF + (ui & 1) * 4096) + (wr * 64 + fr) * 4 + (g - 1);
#pragma unroll
        for (int ai = 0; ai < 2; ++ai)
#pragma unroll
            for (int m = 0; m < 4; ++m) { const float ratio = rt[(ai * 128 + m * 16) * 4];
#pragma unroll
                for (int bj = 0; bj < 2; ++bj)
#pragma unroll
                    for (int n = 0; n < 2; ++n) acc[ai][bj][m][n] = acc[ai][bj][m][n] * ratio; }
    }
    __device__ __forceinline__ void final(const f32x4 (&acc)[2][2][4][2], const pg8::Unit& u, int ui, PG8_LAS unsigned char* lds, int wr, int wc, int fr, int fq) const {
        asm volatile("" : "+v"(fr), "+v"(fq));
        const int row0 = u.pm * 256 + wr * 64 + fr, col0 = u.pn * 256 + wc * 32 + 8 * fq;
        const PG8_LAS float* rt = (const PG8_LAS float*)(lds + KS_OFF + (ui & 1) * 4096) + (wr * 64 + fr) * 4 + 3;
#pragma unroll
        for (int ai = 0; ai < 2; ++ai)
#pragma unroll
            for (int m = 0; m < 4; ++m) { const int row = row0 + ai * 128 + m * 16; bf16* rowp = O + (size_t)row * ldc + col0;
                const float s3 = rt[(ai * 128 + m * 16) * 4];
#pragma unroll
                for (int bj = 0; bj < 2; ++bj) { const f32x4 v0 = acc[ai][bj][m][0] * s3, v1 = acc[ai][bj][m][1] * s3;
                    v4u w; w.x = pk2(v0[0], v0[1]); w.y = pk2(v0[2], v0[3]); w.z = pk2(v1[0], v1[1]); w.w = pk2(v1[2], v1[3]);
                    *(GAS v4u*)(rowp + bj * 128) = w; } }
    }
    __device__ __forceinline__ void operator()(const f32x4 (&acc)[2][2][4][2], const pg8::Unit& u, int wr, int wc, int fr, int fq) const {}
};
__device__ __forceinline__ float silu_f(float v) { return v * __builtin_amdgcn_rcpf(1.f + __expf(-v)); }
struct EpiSwiGLU {
    static constexpr bool PERM = true, KSCALE = false;
    bf16* H;
    __device__ __forceinline__ void operator()(const f32x4 (&acc)[2][2][4][2], const pg8::Unit& u, int wr, int wc, int fr, int fq) const {
        const int row0 = u.pm * 256 + wr * 64 + fr, col0 = u.pn * 128 + wc * 32 + 8 * fq;
#pragma unroll
        for (int ai = 0; ai < 2; ++ai)
#pragma unroll
            for (int m = 0; m < 4; ++m) {
                const f32x4 g0 = acc[ai][0][m][0], g1 = acc[ai][0][m][1], u0 = acc[ai][1][m][0], u1 = acc[ai][1][m][1];
                v4u w; w.x = pk2(silu_f(g0[0]) * u0[0], silu_f(g0[1]) * u0[1]); w.y = pk2(silu_f(g0[2]) * u0[2], silu_f(g0[3]) * u0[3]);
                w.z = pk2(silu_f(g1[0]) * u1[0], silu_f(g1[1]) * u1[1]); w.w = pk2(silu_f(g1[2]) * u1[2], silu_f(g1[3]) * u1[3]);
                *(GAS v4u*)(H + (size_t)(row0 + ai * 128 + m * 16) * FF + col0) = w; }
    }
};
struct EpiKQ {
    static constexpr bool PERM = true, KSCALE = false;
    bf16 *KHp, *QHp, *KHs, *QHs; float* out;
    __device__ __forceinline__ void operator()(const f32x4 (&acc)[2][2][4][2], const pg8::Unit& u, int wr, int wc, int fr, int fq) const {
        const int row_t = u.pm * 256, b = row_t >> 11, pos_t = row_t & 2047; const bool isK = u.pn < 4, cache = isK && pos_t >= 1536;
        const int hd0 = (u.pn & 3) * 4 + (wc >> 1), d = (wc & 1) * 32 + 8 * fq, ro = wr * 64 + fr;
        bf16* dstb = (isK ? KHp : QHp) + ((size_t)((b * AH + hd0) * 2048 + pos_t + ro)) * 64 + d;
        float* ob = out + O_CK_P + (size_t)(b * 512 + pos_t - 1536 + ro) * 1024 + u.pn * 256 + wc * 32 + 8 * fq;
#pragma unroll
        for (int ai = 0; ai < 2; ++ai)
#pragma unroll
            for (int m = 0; m < 4; ++m)
#pragma unroll
                for (int bj = 0; bj < 2; ++bj) {
                    const f32x4 v0 = acc[ai][bj][m][0], v1 = acc[ai][bj][m][1];
                    v4u w; w.x = pk2(v0[0], v0[1]); w.y = pk2(v0[2], v0[3]); w.z = pk2(v1[0], v1[1]); w.w = pk2(v1[2], v1[3]);
                    *(GAS v4u*)(dstb + (size_t)(bj * 2 * 2048 + ai * 128 + m * 16) * 64) = w;
                    if (cache) { float* o = ob + (size_t)(ai * 128 + m * 16) * 1024 + bj * 128; *(GAS f32x4*)o = v0; *(GAS f32x4*)(o + 4) = v1; }
                }
    }
};
struct EpiVT {
    static constexpr bool PERM = true, KSCALE = false;
    bf16 *VTp, *VTs; float* out;
    __device__ __forceinline__ void operator()(const f32x4 (&acc)[2][2][4][2], const pg8::Unit& u, int wr, int wc, int fr, int fq) const {
        const int b = u.pn >> 3, pos_t = (u.pn & 7) * 256; const bool cache = pos_t >= 1536;
        const int hd0 = u.pm * 4 + wr, po = wc * 32 + 8 * fq;
        bf16* dstb = VTp + ((size_t)((b * AH + hd0) * 64 + fr)) * 2048 + pos_t + po;
        float* ob = out + O_CV_P + (size_t)(b * 512 + pos_t - 1536 + po) * 1024 + u.pm * 256 + wr * 64 + fr;
#pragma unroll
        for (int ai = 0; ai < 2; ++ai)
#pragma unroll
            for (int m = 0; m < 4; ++m)
#pragma unroll
                for (int bj = 0; bj < 2; ++bj) {
                    const f32x4 v0 = acc[ai][bj][m][0], v1 = acc[ai][bj][m][1];
                    v4u w; w.x = pk2(v0[0], v0[1]); w.y = pk2(v0[2], v0[3]); w.z = pk2(v1[0], v1[1]); w.w = pk2(v1[2], v1[3]);
                    *(GAS v4u*)(dstb + (size_t)((ai * 2 * 64 + m * 16) * 2048 + bj * 128)) = w;
                    if (cache) { float* o = ob + (size_t)(bj * 128) * 1024 + ai * 128 + m * 16;
#pragma unroll
                        for (int e = 0; e < 4; ++e) { o[(size_t)e * 1024] = v0[e]; o[(size_t)(e + 4) * 1024] = v1[e]; } }
                }
    }
};

struct EpiSlab {
    static constexpr bool PERM = true, KSCALE = false;
    float* slab;
    __device__ __forceinline__ void operator()(const f32x4 (&acc)[2][2][4][2], const pg8::Unit& u, int wr, int wc, int fr, int fq) const {
        const int row0 = u.pm * 256 + wr * 64 + fr, col0 = u.pn * 256 + wc * 32 + 8 * fq; float* base = slab + (size_t)u.w * (TS * DM);
#pragma unroll
        for (int ai = 0; ai < 2; ++ai)
#pragma unroll
            for (int m = 0; m < 4; ++m) { float* rowp = base + (size_t)(row0 + ai * 128 + m * 16) * DM + col0;
#pragma unroll
                for (int bj = 0; bj < 2; ++bj) { *(GAS f32x4*)(rowp + bj * 128) = acc[ai][bj][m][0]; *(GAS f32x4*)(rowp + bj * 128 + 4) = acc[ai][bj][m][1]; } }
    }
};
constexpr size_t KQS_SLAB = (size_t)TS * 3072;
struct EpiKQVT {
    static constexpr bool PERM = true, KSCALE = false;
    EpiKQ kq; EpiVT vt; float* slab;
    __device__ __forceinline__ void operator()(const f32x4 (&acc)[2][2][4][2], const pg8::Unit& u, int wr, int wc, int fr, int fq) const {
        if (u.w == 0) kq(acc, u, wr, wc, fr, fq); else if (u.w == 1) vt(acc, u, wr, wc, fr, fq);
        else { const bool isv = u.w & 1; const int row0 = (isv ? u.pm : u.pm - 128) * 256 + wr * 64 + fr, col0 = (isv ? 2048 + (u.pn - 128) * 256 : u.pn * 256) + wc * 32 + 8 * fq;
            float* base = slab + (size_t)((u.w - 2) >> 1) * KQS_SLAB;
#pragma unroll
            for (int ai = 0; ai < 2; ++ai)
#pragma unroll
                for (int m = 0; m < 4; ++m) { float* rowp = base + (size_t)(row0 + ai * 128 + m * 16) * 3072 + col0;
#pragma unroll
                    for (int bj = 0; bj < 2; ++bj) { *(GAS f32x4*)(rowp + bj * 128) = acc[ai][bj][m][0]; *(GAS f32x4*)(rowp + bj * 128 + 4) = acc[ai][bj][m][1]; } } }
    }
};
__device__ __forceinline__ void norm_row2(const bf16* Mrow, const float* mf, const float* xf, bf16* xn, float* sq, float* yout, const float* wpost, int lane) {
    f32x4 mv[2][4], xv[2][4], wv[4]; float s[2] = {0.f, 0.f};
#pragma unroll
    for (int j = 0; j < 4; ++j) wv[j] = *(const GAS f32x4*)(wpost + 4 * lane + 256 * j);
#pragma unroll
    for (int r = 0; r < 2; ++r) {
        const float sqr = xf ? 1.f : sq[r];
#pragma unroll
        for (int j = 0; j < 4; ++j) {
            if (mf) mv[r][j] = *(const GAS f32x4*)(mf + r * DM + 4 * lane + 256 * j) + *(const GAS f32x4*)(mf + (size_t)TS * DM + r * DM + 4 * lane + 256 * j);
            else { const v2u mm = __builtin_nontemporal_load((const GAS v2u*)(Mrow + r * DM + 4 * lane + 256 * j)); mv[r][j] = (f32x4){bflo(mm.x), bfhi(mm.x), bflo(mm.y), bfhi(mm.y)}; }
            if (xf) xv[r][j] = __builtin_nontemporal_load((const GAS f32x4*)(xf + r * DM + 4 * lane + 256 * j));
            else { const v2u xx = *(const GAS v2u*)(xn + r * DM + 4 * lane + 256 * j); xv[r][j] = (f32x4){bflo(xx.x) * sqr, bfhi(xx.x) * sqr, bflo(xx.y) * sqr, bfhi(xx.y) * sqr}; }
            s[r] += (mv[r][j].x * mv[r][j].x + mv[r][j].y * mv[r][j].y) + (mv[r][j].z * mv[r][j].z + mv[r][j].w * mv[r][j].w); } }
    float s2[2] = {0.f, 0.f};
#pragma unroll
    for (int r = 0; r < 2; ++r) { const float r1 = __builtin_amdgcn_rsqf(wave_sum(s[r]) * (1.f / DM) + EPS);
#pragma unroll
        for (int j = 0; j < 4; ++j) { xv[r][j] = xv[r][j] + mv[r][j] * r1 * wv[j];
            if (yout) *(GAS f32x4*)(yout + r * DM + 4 * lane + 256 * j) = xv[r][j];
            s2[r] += (xv[r][j].x * xv[r][j].x + xv[r][j].y * xv[r][j].y) + (xv[r][j].z * xv[r][j].z + xv[r][j].w * xv[r][j].w); } }
    if (!yout) {
#pragma unroll
        for (int r = 0; r < 2; ++r) { const float ms = wave_sum(s2[r]) * (1.f / DM) + EPS; const float r2 = __builtin_amdgcn_rsqf(ms);
            if (lane == 0) sq[r] = ms * r2;
#pragma unroll
            for (int j = 0; j < 4; ++j) { v2u o; o.x = pk2(xv[r][j].x * r2, xv[r][j].y * r2); o.y = pk2(xv[r][j].z * r2, xv[r][j].w * r2); *(GAS v2u*)(xn + r * DM + 4 * lane + 256 * j) = o; } } }
}

typedef float f32x16 __attribute__((ext_vector_type(16)));
__device__ __forceinline__ bf16x8 pack8(const float* v) { v4u w; w.x = pk2(v[0], v[1]); w.y = pk2(v[2], v[3]); w.z = pk2(v[4], v[5]); w.w = pk2(v[6], v[7]); return __builtin_bit_cast(bf16x8, w); }
#define MFMA16(a, b, c) __builtin_amdgcn_mfma_f32_16x16x32_bf16((a), (b), (c), 0, 0, 0)
#define MFMA32(a, b, c) __builtin_amdgcn_mfma_f32_32x32x16_bf16((a), (b), (c), 0, 0, 0)
constexpr int S_XT = 0, S_BT = 18432, S_BN = 36864, S_CN = 54272, S_CB = 71680, S_HS = 89088, S_DT = 123904, S_CUM = 124416, S_W = 124928, S_CEND = 125440;


#define XB_TMO      128
#define XB_XCNT(j)  (256  + 64 * (j))
#define XB_XSUB(j)  (1280 + 64 * (j))
#define XB_XGEN(j)  (2304 + 64 * (j))
#define XB_TOP      3328
#define XB_TOPGEN   3392
#define XCD_BAR_WORDS 3456
#define XB_SPIN_CAP (1u << 22)
__device__ __forceinline__ unsigned xb_ld(unsigned* p)              { return __hip_atomic_load(p, __ATOMIC_RELAXED, __HIP_MEMORY_SCOPE_AGENT); }
__device__ __forceinline__ unsigned xb_add(unsigned* p, unsigned v) { return __hip_atomic_fetch_add(p, v, __ATOMIC_RELAXED, __HIP_MEMORY_SCOPE_AGENT); }
__device__ __forceinline__ unsigned xb_xcc_id() { return (unsigned)__builtin_amdgcn_s_getreg((3 << 11) | 20) & 0xFu; }
#define XB_SPIN(cond, bar) do { unsigned _sp = 0; while (cond) { __builtin_amdgcn_s_sleep(1); \
    if ((++_sp & 255u) == 0u) { if (xb_ld(&(bar)[XB_TMO])) break; if (_sp > XB_SPIN_CAP) { atomicAdd(&(bar)[XB_TMO], 1u); break; } } } } while (0)
struct XcdBarrier { unsigned* bar; unsigned x; volatile LAS unsigned* st; };
__device__ __forceinline__ bool is_thread0(int wave_id) { return wave_id == 0 && fresh_lane() == 0; }
__device__ __forceinline__ XcdBarrier xcd_barrier_post(unsigned* bar, volatile LAS unsigned* st, int wave_id) {
    XcdBarrier b; b.bar = bar; b.x = xb_xcc_id(); b.st = st;
    if (is_thread0(wave_id)) (void)xb_add(&bar[XB_XCNT(b.x)], 1u);
    return b;
}
__device__ __forceinline__ void xcd_barrier_complete(unsigned* bar, unsigned x, unsigned& nloc, unsigned& nx) {
    const unsigned G = gridDim.x * gridDim.y * gridDim.z;
    unsigned sum, cnt, mine, sp = 0u;
    for (;;) {
        sum = 0u; cnt = 0u; mine = 0u;
#pragma unroll
        for (unsigned j = 0; j < 16; ++j) { const unsigned c = xb_ld(&bar[XB_XCNT(j)]); sum += c; cnt += (c > 0u) ? 1u : 0u; mine = (j == x) ? c : mine; }
        if (sum == G) break;
        __builtin_amdgcn_s_sleep(1);
        if ((++sp & 255u) == 0u) { if (xb_ld(&bar[XB_TMO])) break; if (sp > XB_SPIN_CAP) { atomicAdd(&bar[XB_TMO], 1u); break; } }
    }
    nloc = mine > 0u ? mine : 1u; nx = cnt > 0u ? cnt : 1u;
}
__device__ __forceinline__ void xcd_barrier(const XcdBarrier& b, int wave_id) {
    asm volatile("s_waitcnt vmcnt(0)" ::: "memory");
    __syncthreads();
    if (is_thread0(wave_id)) {
        unsigned* bar = b.bar;
        __builtin_amdgcn_s_waitcnt(0);
        unsigned nloc = b.st[0], nx = b.st[1];
        if (nloc == 0u) { xcd_barrier_complete(bar, b.x, nloc, nx); b.st[0] = nloc; b.st[1] = nx; }
        const unsigned old = xb_add(&bar[XB_XSUB(b.x)], 1u);
        const unsigned gen = old / nloc;
        if (old + 1u == (gen + 1u) * nloc) {
            __builtin_amdgcn_fence(__ATOMIC_RELEASE, "agent");
            asm volatile("s_waitcnt vmcnt(0)" ::: "memory");
            const unsigned og = xb_add(&bar[XB_TOP], 1u);
            const unsigned tg = og / nx;
            if (og + 1u == (tg + 1u) * nx) xb_add(&bar[XB_TOPGEN], 1u);
            else XB_SPIN(xb_ld(&bar[XB_TOPGEN]) == tg, bar);
            __builtin_amdgcn_fence(__ATOMIC_ACQUIRE, "agent");
            xb_add(&bar[XB_XGEN(b.x)], 1u);
            asm volatile("s_waitcnt vmcnt(0)" ::: "memory");
        } else {
            XB_SPIN(xb_ld(&bar[XB_XGEN(b.x)]) == gen, bar);
            __builtin_amdgcn_fence(__ATOMIC_ACQUIRE, "agent");
            asm volatile("s_waitcnt vmcnt(0)" ::: "memory");
        }
    }
    __syncthreads();
}
constexpr int MISC_OFF = 146432;

__global__ void __launch_bounds__(NTHREADS, 2) mk_fwd(Args a) {
    extern __shared__ __attribute__((aligned(16))) unsigned char lds[];
    cg::grid_group grid = cg::this_grid();
    const int wave_s = __builtin_amdgcn_readfirstlane((int)threadIdx.x >> 6);
    const int G = gridDim.x, bx = blockIdx.x, NGW = G * NWAVES;
    const size_t gsz = (size_t)G * NTHREADS;
#define PHASE_IDS int tid = wave_s * 64 + fresh_lane(); asm volatile("" : "+v"(tid)); const int lane = tid & 63, wave = __builtin_amdgcn_readfirstlane(tid >> 6), gw = bx * NWAVES + wave; const size_t gtid = (size_t)bx * NTHREADS + tid; (void)lane; (void)gw; (void)gtid;
#define PHASE_PTRS const Args __attribute__((address_space(4)))* ap_ = (const Args __attribute__((address_space(4)))*)__builtin_amdgcn_kernarg_segment_ptr(); asm volatile("" : "+s"(ap_)); \
    unsigned char* ws = ap_->ws; float* out = ap_->out; (void)out; const float* x_p = ap_->in[0]; const float* x_s = ap_->in[1]; const float* norm_w = ap_->in[6]; (void)x_p; (void)x_s; (void)norm_w; \
    bf16* Win_t = (bf16*)(ws + WS_WIN); bf16* Wout_t = (bf16*)(ws + WS_WOUT); bf16* Wf1_t = (bf16*)(ws + WS_WF1); bf16* Wf2_t = (bf16*)(ws + WS_WF2); \
    bf16* Wkq_t = (bf16*)(ws + WS_WKQ); bf16* Wv_t = (bf16*)(ws + WS_WV); bf16* Wo_t = (bf16*)(ws + WS_WO); \
    bf16* XN = (bf16*)(ws + WS_XN); bf16* Z = (bf16*)(ws + WS_Z); bf16* XBC = (bf16*)(ws + WS_XBC); float* DT = (float*)(ws + WS_DT); \
    float* SSQ = (float*)(ws + WS_SSQ); float* SQ = (float*)(ws + WS_SQ); (void)SQ; float* SLAB = (float*)(ws + WS_SLAB); (void)SLAB; bf16* MB = (bf16*)(ws + WS_M); bf16* HB = (bf16*)(ws + WS_H); \
    bf16* KHp = (bf16*)(ws + WS_KHP); bf16* QHp = (bf16*)(ws + WS_QHP); bf16* VTp = (bf16*)(ws + WS_VTP); \
    bf16* KHs = (bf16*)(ws + WS_KHS); bf16* QHs = (bf16*)(ws + WS_QHS); bf16* VTs = (bf16*)(ws + WS_VTS); bf16* AO = (bf16*)(ws + WS_AO); \
    (void)Win_t; (void)Wout_t; (void)Wf1_t; (void)Wf2_t; (void)Wkq_t; (void)Wv_t; (void)Wo_t; (void)XN; (void)Z; (void)XBC; (void)DT; (void)SSQ; (void)MB; (void)HB; \
    (void)KHp; (void)QHp; (void)VTp; (void)KHs; (void)QHs; (void)VTs; (void)AO;
#define AIN(k) (ap_->in[k])
    LAS unsigned char* L = (LAS unsigned char*)lds;
    volatile LAS unsigned* MISC = (volatile LAS unsigned*)(L + MISC_OFF);
    if (wave_s == 0) MISC[fresh_lane()] = 0u;
    __syncthreads();
    const XcdBarrier xbar = xcd_barrier_post((unsigned*)(a.ws + WS_CTL) + 4096, MISC, wave_s);
#if PROF_K >= 0
    int n_stamp = 0;
#endif
#if PROF_K >= 0
#define STAMP() do { if (is_thread0(wave_s) && n_stamp < 24) ((volatile LAS unsigned long long*)(MISC + 8))[n_stamp] = __builtin_amdgcn_s_memrealtime(); ++n_stamp; } while (0)
#else
#define STAMP() do { } while (0)
#endif
#define GRID_BAR() do { xcd_barrier(xbar, wave_s); STAMP(); } while (0)
    STAMP();

    {
        PHASE_IDS PHASE_PTRS
        LAS float* scr = (LAS float*)(L + wave * 16384);
        constexpr float C2 = 0.125f * 1.4426950408889634f;
        constexpr int I_IN = (INPROJ_PAD / 32) * (DM / 64);
        constexpr int I_OUT = (DM / 32) * (DI / 64);
        constexpr int I_F1 = (FF2 / 32) * (DM / 64);
        constexpr int I_F2 = (DM / 32) * (FF / 64);
        constexpr int I_KQ = (2048 / 32) * (DM / 64);
        constexpr int I_V = (DM / 32) * (DM / 64);
        constexpr int NITEMS = I_IN + I_OUT + 2 * I_F1 + 2 * I_F2 + I_KQ + 2 * I_V;
        for (int it = gw; it < NITEMS; it += NGW) {
            int r = it;
            if (r < I_IN) { const int rb = r / 16, kb = r % 16, r0 = rb * 32; tr_item(ap_->in[7], INPROJ, DM, Win_t, r0, r0 < INPROJ ? r0 : -1, kb * 64, norm_w, 1.f, scr, lane); continue; } r -= I_IN;
            if (r < I_OUT) { const int rb = r / 32, kb = r % 32, r0 = rb * 32; tr_item(ap_->in[14], DM, DI, Wout_t, r0, r0, kb * 64, ap_->in[13], 1.f, scr, lane); continue; } r -= I_OUT;
            if (r < 2 * I_F1) { const int l = r / I_F1; r -= l * I_F1; const int rb = r / 16, kb = r % 16, r0 = rb * 32;
                const int c0 = ((r0 >> 7) & 1) * FF + (r0 >> 8) * 128 + (r0 & 127);
                tr_item(ap_->in[20] + (size_t)l * DM * FF2, FF2, DM, Wf1_t + (size_t)l * FF2 * DM, r0, c0, kb * 64, norm_w + (l * 4 + 2) * DM, 1.f, scr, lane); continue; } r -= 2 * I_F1;
            if (r < 2 * I_F2) { const int l = r / I_F2; r -= l * I_F2; const int rb = r / 44, kb = r % 44, r0 = rb * 32;
                tr_item(ap_->in[21] + (size_t)l * FF * DM, DM, FF, Wf2_t + (size_t)l * DM * FF, r0, r0, kb * 64, nullptr, 1.f, scr, lane); continue; } r -= 2 * I_F2;
            if (r < I_KQ) { const int rb = r / 16, kb = r % 16, r0 = rb * 32;
                if (r0 < 1024) tr_item(ap_->in[16], 2048, DM, Wkq_t, r0, r0, kb * 64, ap_->in[15], 1.f, scr, lane);
                else tr_item(ap_->in[17], DM, DM, Wkq_t, r0, r0 - 1024, kb * 64, norm_w + 4 * DM, C2, scr, lane);
                continue; } r -= I_KQ;
            if (r < I_V) { const int rb = r / 16, kb = r % 16, r0 = rb * 32; tr_item(ap_->in[16], 2048, DM, Wv_t, r0, 1024 + r0, kb * 64, ap_->in[15], 1.f, scr, lane); continue; } r -= I_V;
            { const int rb = r / 16, kb = r % 16, r0 = rb * 32; tr_item(ap_->in[19], DM, DM, Wo_t, r0, r0, kb * 64, nullptr, 1.f, scr, lane); }
        }
        for (int m = 2 * gw; m < TT; m += 2 * NGW) rms_row2_to_bf16(m < TP ? x_p + (size_t)m * DM : x_s + (size_t)(m - TP) * DM, XN + (size_t)m * DM, lane);
        for (size_t i = gtid; i < (size_t)TT * 4; i += gsz) SSQ[i] = 0.f;
    }
    __syncthreads();
    grid.sync(); STAMP();

    {
        PHASE_PTRS
        pg8::Gemm g{XN, Win_t, TT, INPROJ_PAD, DM, DM}; pg8::StaticOrder S; S.init(TT, INPROJ_PAD, G, bx);
        EpiInProj E{Z, XBC, DT, out};
        pg8::gemm_phase<EpiInProj, pg8::StaticOrder, true, true>(L, g, S, E, wave_s);
    }
    GRID_BAR();

#if PROF_K >= 0
    unsigned long long pt_last = 0ull, pt_acc0 = 0ull, pt_acc1 = 0ull, pt_acc2 = 0ull, pt_acc3 = 0ull;
#define PROF_T(k) do { const unsigned long long t_ = __builtin_amdgcn_s_memrealtime(); \
        if ((k) == 1) pt_acc0 += t_ - pt_last; else if ((k) == 2) pt_acc1 += t_ - pt_last; else if ((k) == 3) pt_acc2 += t_ - pt_last; else if ((k) == 4) pt_acc3 += t_ - pt_last; pt_last = t_; } while (0)
#define PROF_RESET() do { if (PROF_K < 70) { pt_acc0 = 0ull; pt_acc1 = 0ull; pt_acc2 = 0ull; pt_acc3 = 0ull; } } while (0)
#define PROF_TA(k) do { if (PROF_K < 70) PROF_T(k); } while (0)
#else
#define PROF_TA(k) do { } while (0)
#define PROF_T(k) do { } while (0)
#define PROF_RESET() do { } while (0)
#endif
    {
        PHASE_IDS PHASE_PTRS
        LAS bf16* XT = (LAS bf16*)(L + S_XT); LAS bf16* BT = (LAS bf16*)(L + S_BT); LAS bf16* BN = (LAS bf16*)(L + S_BN); LAS bf16* CN = (LAS bf16*)(L + S_CN);
        LAS float* CBs = (LAS float*)(L + S_CB); LAS bf16* HS = (LAS bf16*)(L + S_HS);
        LAS float* dtS = (LAS float*)(L + S_DT); LAS float* cumS = (LAS float*)(L + S_CUM); LAS float* wS = (LAS float*)(L + S_W); LAS float* cendS = (LAS float*)(L + S_CEND);
        const float* conv_w = ap_->in[8]; const float* conv_b = ap_->in[9]; const float* dt_bias = ap_->in[10]; const float* A_log = ap_->in[11]; const float* Dskip = ap_->in[12];
        const float* state_ssm = ap_->in[2]; const float* state_conv = ap_->in[3];
        const int fr = lane & 15, fq = lane >> 4, hh = wave >> 2, qd = wave & 3;
        for (int wi = bx; wi < 512; wi += G) {
            const bool smp = wi >= 256;
            const int xq = wi & 7, kq = (wi >> 3) & 31, sidx = xq * 8 + (kq >> 2), sq = sidx >> 2, grp = sidx & 3, hp = grp * 4 + (kq & 3), h0 = 2 * hp, h = h0 + hh;
            const int nchunk = smp ? 1 : 32;
            const size_t row_base = smp ? (size_t)TP + sq * 64 : (size_t)sq * 2048;
            const float Dh = Dskip[h];
            f32x4 sacc[2][4];
#pragma unroll
            for (int n2 = 0; n2 < 2; ++n2)
#pragma unroll
                for (int pt = 0; pt < 4; ++pt) {
                    const int p = 16 * pt + fr, n = 32 * qd + 16 * n2 + 4 * fq;
                    sacc[n2][pt] = smp ? *(const GAS f32x4*)(state_ssm + ((size_t)((sq * NH + h) * 64 + p)) * 128 + n) : (f32x4){0.f, 0.f, 0.f, 0.f};
                    v2u w; w.x = pk2(sacc[n2][pt][0], sacc[n2][pt][1]); w.y = pk2(sacc[n2][pt][2], sacc[n2][pt][3]);
                    *(LAS v2u*)(HS + (hh * 64 + p) * 136 + n) = w;
                }
            unsigned raw[3][11]; float dtraw = 0.f;
#define SSD_LOAD(c) do { \
              \
              \
            const __amdgpu_buffer_rsrc_t xr_ = __builtin_amdgcn_make_buffer_rsrc((void*)(XBC - 3 * CONVD), 0, (int)((size_t)(TT + 3) * CONVD * 2), 0x00020000); \
            _Pragma("unroll") for (int i = 0; i < 3; ++i) { const int it = SSD_TID + 512 * i, cp = it % 192; const int sb = __builtin_amdgcn_readfirstlane(it / 192); \
                const int col = cp < 64 ? h0 * 64 + 2 * cp : (cp < 128 ? DI + grp * 128 + 2 * (cp - 64) : DI + 512 + grp * 128 + 2 * (cp - 128)); \
                const int so0 = ((int)row_base + 64 * (c) + 8 * sb) * (CONVD * 2); \
                _Pragma("unroll") for (int r = 0; r < 11; ++r) raw[i][r] = __builtin_amdgcn_raw_buffer_load_b32(xr_, col * 2, so0 + r * (CONVD * 2), 0); } \
            if (wave < 2) dtraw = DT[(row_base + 64 * (c) + lane) * 32 + h0 + wave]; } while (0)
#define SSD_TID tid
            SSD_LOAD(0);
#undef SSD_TID
#define SSD_TID tidc
            if (!smp && tid < 192) { raw[0][0] = 0u; raw[0][1] = 0u; raw[0][2] = 0u; }
            if (smp && tid < 192) {
                const int cp = tid; const int col = cp < 64 ? h0 * 64 + 2 * cp : (cp < 128 ? DI + grp * 128 + 2 * (cp - 64) : DI + 512 + grp * 128 + 2 * (cp - 128));
#pragma unroll
                for (int r = 0; r < 3; ++r) { const float* sc = state_conv + (size_t)(sq * 3 + r) * CONVD + col; raw[0][r] = pk2(sc[0], sc[1]); } }
            for (int c = 0; c < nchunk; ++c) {
                PROF_T(0);
                int frc = fr, fqc = fq, tidc = tid; asm volatile("" : "+v"(frc), "+v"(fqc), "+v"(tidc));
                const float* cw_ = conv_w; const float* cb_ = conv_b; asm volatile("" : "+s"(cw_), "+s"(cb_));
#pragma unroll
                for (int i = 0; i < 3; ++i) { const int it = tidc + 512 * i, cp = it % 192, sb = it / 192, typ = cp >> 6, cl = 2 * (cp & 63);
                    const int col = cp < 64 ? h0 * 64 + 2 * cp : (cp < 128 ? DI + grp * 128 + 2 * (cp - 64) : DI + 512 + grp * 128 + 2 * (cp - 128));
                    float w0[4], w1[4];
#pragma unroll
                    for (int k = 0; k < 4; ++k) { w0[k] = cw_[k * CONVD + col]; w1[k] = cw_[k * CONVD + col + 1]; }
                    const float b0 = cb_[col], b1 = cb_[col + 1];
                    float o0[8], o1[8];
#pragma unroll
                    for (int s = 0; s < 8; ++s) { float a0 = b0, a1 = b1;
#pragma unroll
                        for (int k = 0; k < 4; ++k) { const unsigned uu = raw[i][s + k]; a0 += w0[k] * bflo(uu); a1 += w1[k] * bfhi(uu); }
                        o0[s] = silu_f(a0); o1[s] = silu_f(a1); }
                    if (typ == 0) { *(LAS bf16x8*)(XT + cl * 72 + 8 * sb) = pack8(o0); *(LAS bf16x8*)(XT + (cl + 1) * 72 + 8 * sb) = pack8(o1); }
                    else if (typ == 1) { *(LAS bf16x8*)(BT + cl * 72 + 8 * sb) = pack8(o0); *(LAS bf16x8*)(BT + (cl + 1) * 72 + 8 * sb) = pack8(o1);
#pragma unroll
                        for (int s = 0; s < 8; ++s) *(LAS unsigned*)(BN + (8 * sb + s) * 136 + cl) = pk2(o0[s], o1[s]); }
                    else {
#pragma unroll
                        for (int s = 0; s < 8; ++s) *(LAS unsigned*)(CN + (8 * sb + s) * 136 + cl) = pk2(o0[s], o1[s]); }
                }
                if (wave < 2) { const int hd = h0 + wave;
                    const float xx = dtraw + dt_bias[hd];
                    const float dtv = fmaxf(xx, 0.f) + __logf(1.f + __expf(-fabsf(xx)));
                    const float Ah = -__expf(A_log[hd]);
                    const float cum = wave_scan_incl(dtv * Ah);
                    const float cend = __builtin_bit_cast(float, __builtin_amdgcn_readlane(__builtin_bit_cast(int, cum), 63));
                    dtS[wave * 64 + lane] = dtv; cumS[wave * 64 + lane] = cum; wS[wave * 64 + lane] = dtv * __expf(cend - cum);
                    if (lane == 63) cendS[wave] = cend; }
                __syncthreads();
                PROF_T(1);
                if (c + 1 < nchunk) SSD_LOAD(c + 1);
                v2u zpre[4];
                { const size_t mz = row_base + 64 * c + 16 * qd + frc; const bf16* zp0 = Z + mz * DI + h * 64 + 4 * fqc;
#pragma unroll
                  for (int pt = 0; pt < 4; ++pt) zpre[pt] = *(const GAS v2u*)(zp0 + 16 * pt); }
                PROF_T(2);
                bf16x8 xt[4][2];
#pragma unroll
                for (int pt = 0; pt < 4; ++pt)
#pragma unroll
                    for (int ks = 0; ks < 2; ++ks) xt[pt][ks] = *(const LAS bf16x8*)(XT + (hh * 64 + 16 * pt + frc) * 72 + 8 * fqc + 32 * ks);
                { f32x4 yacc[4], cbacc[4];
#pragma unroll
                    for (int pt = 0; pt < 4; ++pt) { yacc[pt] = (f32x4){0.f, 0.f, 0.f, 0.f}; cbacc[pt] = (f32x4){0.f, 0.f, 0.f, 0.f}; }
                    const int q = 16 * qd + frc;
#pragma unroll
                    for (int ks = 0; ks < 4; ++ks) { const bf16x8 bfr = *(const LAS bf16x8*)(CN + q * 136 + 8 * fqc + 32 * ks);
#pragma unroll
                        for (int pt = 0; pt < 4; ++pt) { const bf16x8 af = *(const LAS bf16x8*)(HS + (hh * 64 + 16 * pt + frc) * 136 + 8 * fqc + 32 * ks); yacc[pt] = MFMA16(af, bfr, yacc[pt]); }
#pragma unroll
                        for (int st = 0; st < 4; ++st) { const bf16x8 af = *(const LAS bf16x8*)(BN + (16 * st + frc) * 136 + 8 * fqc + 32 * ks); cbacc[st] = MFMA16(af, bfr, cbacc[st]); } }
                    const float cq = cumS[hh * 64 + q]; const float eq = __expf(cq);
#pragma unroll
                    for (int pt = 0; pt < 4; ++pt) yacc[pt] = yacc[pt] * eq;
#pragma unroll
                    for (int ks = 0; ks < 2; ++ks) {
                        float mv[8];
#pragma unroll
                        for (int hf = 0; hf < 2; ++hf) { const int s0 = 16 * (2 * ks + hf) + 4 * fqc;
                            const f32x4 cs = *(const LAS f32x4*)(cumS + hh * 64 + s0), dd = *(const LAS f32x4*)(dtS + hh * 64 + s0); const f32x4 cb = cbacc[2 * ks + hf];
#pragma unroll
                            for (int e = 0; e < 4; ++e) { const int s = s0 + e; float t = cb[e] * __expf(fminf(cq - cs[e], 0.f)) * dd[e]; t = (s <= q) ? t : 0.f; if (s == q) t += Dh; mv[4 * hf + e] = t; } }
                        const bf16x8 mf = pack8(mv);
#pragma unroll
                        for (int pt = 0; pt < 4; ++pt) { const LAS bf16* xp = XT + (hh * 64 + 16 * pt + frc) * 72 + 32 * ks + 4 * fqc;
                            const v2u x0 = *(const LAS v2u*)xp, x1 = *(const LAS v2u*)(xp + 16); const v4u xa = {x0.x, x0.y, x1.x, x1.y};
                            yacc[pt] = MFMA16(__builtin_bit_cast(bf16x8, xa), mf, yacc[pt]); } }
                    const size_t m = row_base + 64 * c + q;
                    bf16* zp = Z + m * DI + h * 64 + 4 * fqc; float ss = 0.f;
#pragma unroll
                    for (int pt = 0; pt < 4; ++pt) { const v2u zz = zpre[pt];
                        const float y0 = yacc[pt][0] * silu_f(bflo(zz.x)), y1 = yacc[pt][1] * silu_f(bfhi(zz.x)), y2 = yacc[pt][2] * silu_f(bflo(zz.y)), y3 = yacc[pt][3] * silu_f(bfhi(zz.y));
                        ss += (y0 * y0 + y1 * y1) + (y2 * y2 + y3 * y3);
                        v2u o; o.x = pk2(y0, y1); o.y = pk2(y2, y3); *(GAS v2u*)(zp + 16 * pt) = o; }
                    ss += __shfl_xor(ss, 16); ss += __shfl_xor(ss, 32);
                    if (fqc == 0) atomicAdd(SSQ + m * 4 + grp, ss);
                }
                PROF_T(3);
                { const float dec = __expf(cendS[hh]);
#pragma unroll
                    for (int n2 = 0; n2 < 2; ++n2)
#pragma unroll
                        for (int pt = 0; pt < 4; ++pt) sacc[n2][pt] = sacc[n2][pt] * dec;
#pragma unroll
                    for (int ks = 0; ks < 2; ++ks) { const int s0 = 8 * fqc + 32 * ks;
                        const f32x4 w0 = *(const LAS f32x4*)(wS + hh * 64 + s0), w1 = *(const LAS f32x4*)(wS + hh * 64 + s0 + 4);
#pragma unroll
                        for (int n2 = 0; n2 < 2; ++n2) { const v4u rw = *(const LAS v4u*)(BT + (32 * qd + 16 * n2 + frc) * 72 + s0);
                            float bv[8]; bv[0] = bflo(rw.x) * w0[0]; bv[1] = bfhi(rw.x) * w0[1]; bv[2] = bflo(rw.y) * w0[2]; bv[3] = bfhi(rw.y) * w0[3];
                            bv[4] = bflo(rw.z) * w1[0]; bv[5] = bfhi(rw.z) * w1[1]; bv[6] = bflo(rw.w) * w1[2]; bv[7] = bfhi(rw.w) * w1[3];
                            const bf16x8 af = pack8(bv);
#pragma unroll
                            for (int pt = 0; pt < 4; ++pt) sacc[n2][pt] = MFMA16(af, xt[pt][ks], sacc[n2][pt]); } }
                }
                __syncthreads();
                PROF_T(4);
#pragma unroll
                for (int n2 = 0; n2 < 2; ++n2)
#pragma unroll
                    for (int pt = 0; pt < 4; ++pt) { v2u w; w.x = pk2(sacc[n2][pt][0], sacc[n2][pt][1]); w.y = pk2(sacc[n2][pt][2], sacc[n2][pt][3]);
                        *(LAS v2u*)(HS + (hh * 64 + 16 * pt + frc) * 136 + 32 * qd + 16 * n2 + 4 * fqc) = w; }
            }
#undef SSD_LOAD
#undef SSD_TID
            { float* so = out + (smp ? O_SSM_S : O_SSM_P);
#pragma unroll
                for (int n2 = 0; n2 < 2; ++n2)
#pragma unroll
                    for (int pt = 0; pt < 4; ++pt) *(GAS f32x4*)(so + ((size_t)((sq * NH + h) * 64 + 16 * pt + fr)) * 128 + 32 * qd + 16 * n2 + 4 * fq) = sacc[n2][pt]; }
        }
    }
    GRID_BAR();

#define GEMM1024_NORM(EPI, EPIARGS_P, EPIARGS_S, APTR, BTPTR, KDIM, FIRST, LAST, WPOST, SPLIT, SEAM) do { \
        { PHASE_PTRS pg8::Gemm g{(APTR), (BTPTR), TP, DM, (KDIM), (KDIM)}; pg8::StaticOrder S; S.init(TP, DM, G, bx); EPI E EPIARGS_P; \
          pg8::gemm_phase<EPI, pg8::StaticOrder, true, true>(L, g, S, E, wave_s); } \
        GRID_BAR(); \
        const int nsw = (SPLIT) ? 32 : 16;          \
        if (bx < nsw) { \
          { PHASE_PTRS \
          if (SPLIT) { pg8::Gemm g{(APTR) + (size_t)TP * (KDIM), (BTPTR), TS, DM, (KDIM) / 2, (KDIM)}; pg8::SplitOrder2 S{bx, (long)(KDIM)}; EpiSlab E{SLAB}; \
            pg8::gemm_phase<EpiSlab, pg8::SplitOrder2, true, true>(L, g, S, E, wave_s); } \
          else { pg8::Gemm g{(APTR) + (size_t)TP * (KDIM), (BTPTR), TS, DM, (KDIM), (KDIM)}; pg8::StaticOrder S; S.init(TS, DM, G, bx); EPI E EPIARGS_S; \
            pg8::gemm_phase<EPI, pg8::StaticOrder, true, true>(L, g, S, E, wave_s); } } \
            \
          { PHASE_IDS PHASE_PTRS \
            asm volatile("s_waitcnt vmcnt(0)" ::: "memory"); __syncthreads(); \
            if (tid == 0) { unsigned* cnt = (unsigned*)(ws + WS_CTL) + 8192 + 64 * (SEAM); \
              __builtin_amdgcn_fence(__ATOMIC_RELEASE, "agent"); asm volatile("s_waitcnt vmcnt(0)" ::: "memory"); \
              __hip_atomic_fetch_add(cnt, 1u, __ATOMIC_RELAXED, __HIP_MEMORY_SCOPE_AGENT); } } } \
        else { PHASE_IDS PHASE_PTRS const int gw2 = (bx - nsw) * NWAVES + wave, NGW2 = (G - nsw) * NWAVES; \
          for (int m = 2 * gw2; m < TP; m += 2 * NGW2) norm_row2(MB + (size_t)m * DM, nullptr, (FIRST) ? x_p + (size_t)m * DM : nullptr, XN + (size_t)m * DM, SQ + m, (LAST) ? out + O_Y + (size_t)m * DM : nullptr, (WPOST), lane); \
            \
          if (tid == 0) { unsigned* cnt = (unsigned*)(ws + WS_CTL) + 8192 + 64 * (SEAM); unsigned sp = 0; \
            while (__hip_atomic_load(cnt, __ATOMIC_RELAXED, __HIP_MEMORY_SCOPE_AGENT) < (unsigned)nsw) { __builtin_amdgcn_s_sleep(2); if (++sp > (1u << 22)) break; } \
            __builtin_amdgcn_fence(__ATOMIC_ACQUIRE, "agent"); asm volatile("s_waitcnt vmcnt(0)" ::: "memory"); } \
          __syncthreads(); \
          for (int m = TP + 2 * gw2; m < TT; m += 2 * NGW2) norm_row2(MB + (size_t)m * DM, (SPLIT) ? SLAB + (size_t)(m - TP) * DM : nullptr, (FIRST) ? x_s + (size_t)(m - TP) * DM : nullptr, XN + (size_t)m * DM, SQ + m, (LAST) ? out + O_Y + (size_t)m * DM : nullptr, (WPOST), lane); } \
    } while (0)
    GEMM1024_NORM(EpiOutProj, ({MB, DM, SSQ}), ({MB + (size_t)TP * DM, DM, SSQ + (size_t)TP * 4}), Z, Wout_t, DI, true, false, norm_w + 1 * DM, false, 0);
    GRID_BAR();

    { constexpr int layer = 0;
        { PHASE_PTRS pg8::Gemm g{XN, Wf1_t + (size_t)layer * FF2 * DM, TT, FF2, DM, DM}; pg8::StaticOrder S; S.init(TT, FF2, G, bx); EpiSwiGLU E{HB};
          pg8::gemm_phase<EpiSwiGLU, pg8::StaticOrder, true, true>(L, g, S, E, wave_s); }
        GRID_BAR();
        GEMM1024_NORM(EpiPlain, ({MB, DM}), ({MB + (size_t)TP * DM, DM}), HB, Wf2_t + (size_t)layer * DM * FF, FF, false, layer == 1, norm_w + (layer * 4 + 3) * DM, true, 2 + layer);
        if (layer == 0) GRID_BAR();
        }
    { constexpr int layer = 1;
        {
            { PHASE_PTRS pg8::Gemm g{XN, Wkq_t, TT, 2048, DM, DM};
              pg8::KqvtOrder S; S.G = G; S.c = bx; S.dA = (const char*)Wv_t - (const char*)XN; S.dB = (const char*)XN - (const char*)Wkq_t;
              EpiKQVT E{{KHp, QHp, KHs, QHs, out}, {VTp, VTs, out}, (float*)MB};
              pg8::gemm_phase<EpiKQVT, pg8::KqvtOrder, true, true>(L, g, S, E, wave_s); }
            GRID_BAR();
            {
                PHASE_IDS PHASE_PTRS
                LAS bf16* KsB = (LAS bf16*)L;
                LAS bf16* VsB = (LAS bf16*)(L + 18432);
                LAS float* biasL = (LAS float*)(L + 36864);
                PROF_RESET();
                const float* rel_bias = ap_->in[18];
                for (int i = tid; i < AH * 641; i += NTHREADS) { const int h = i / 641, j = i - h * 641; biasL[i] = rel_bias[h * 513 + (j > 512 ? 512 : j)] * 1.4426950408889634f; }
                __syncthreads();
                const int r32 = lane & 31, hi = lane >> 5;
                const int krow = (r32 & 0x13) | ((r32 & 4) << 1) | ((r32 & 8) >> 1);
                const int srow = tid >> 3, sch = tid & 7;
#define ATTN_DECODE(P, uu) const bool P##smp = (uu) >= 2048; const int P##idx = (uu) & 255, P##b = P##idx >> 4, P##hd = P##idx & 15, P##c0 = P##smp ? 8 : 4 * ((uu) >> 8); \
                const int P##kt_lo = P##c0 > 8 ? P##c0 - 8 : 0, P##Lk = P##smp ? SKV : 2048; \
                const bf16* P##KHb = P##smp ? KHs + (size_t)((P##b * AH + P##hd) * SKV) * 64 : KHp + (size_t)((P##b * AH + P##hd) * 2048) * 64; \
                const bf16* P##VTb = P##smp ? VTs + (size_t)((P##b * AH + P##hd) * 64) * SKV : VTp + (size_t)((P##b * AH + P##hd) * 64) * 2048; \
                const int P##pos0 = P##smp ? 32 * (wave & 1) : 64 * P##c0 + 32 * wave; \
                const bf16* P##Qb = P##smp ? QHs + (size_t)((P##b * AH + P##hd) * 64 + P##pos0) * 64 : QHp + (size_t)((P##b * AH + P##hd) * 2048 + P##pos0) * 64;
                { const float* cache_k = ap_->in[4]; const float* cache_v = ap_->in[5];
                  for (int u = bx; u < 2304; u += G) if (u >= 2048) { const int idx = u & 255, b = idx >> 4, hd = idx & 15;
                      { const int d8 = tid & 7, r0 = tid >> 3; f32x4 kv[8][2]; float vv[4][8];
#pragma unroll
                        for (int it = 0; it < 8; ++it) { const float* s = cache_k + ((size_t)((b * 512 + r0 + 64 * it) * 16 + hd)) * 64 + 8 * d8;
                            kv[it][0] = __builtin_nontemporal_load((const GAS f32x4*)s); kv[it][1] = __builtin_nontemporal_load((const GAS f32x4*)(s + 4)); }
#pragma unroll
                        for (int j = 0; j < 4; ++j)
#pragma unroll
                            for (int e = 0; e < 8; ++e) vv[j][e] = __builtin_nontemporal_load((const GAS float*)(cache_v + ((size_t)((b * 512 + 8 * (wave + 8 * j) + e) * 16 + hd)) * 64 + lane));
#pragma unroll
                        for (int it = 0; it < 8; ++it) { const f32x4 v0 = kv[it][0], v1 = kv[it][1];
                            v4u w; w.x = pk2(v0[0], v0[1]); w.y = pk2(v0[2], v0[3]); w.z = pk2(v1[0], v1[1]); w.w = pk2(v1[2], v1[3]);
                            *(GAS v4u*)(KHs + ((size_t)((b * AH + hd) * SKV + r0 + 64 * it)) * 64 + 8 * d8) = w; }
#pragma unroll
                        for (int j = 0; j < 4; ++j) { v4u w; w.x = pk2(vv[j][0], vv[j][1]); w.y = pk2(vv[j][2], vv[j][3]); w.z = pk2(vv[j][4], vv[j][5]); w.w = pk2(vv[j][6], vv[j][7]);
                            *(GAS v4u*)(VTs + ((size_t)((b * AH + hd) * 64 + lane)) * SKV + 8 * (wave + 8 * j)) = w; } }
                      { const float* sl = (const float*)MB; const int r = tid >> 3, c8 = tid & 7; float vv[4][8];
                        const float* pk = sl + (size_t)(b * 64 + r) * 3072 + hd * 64 + 8 * c8; const float* pv = sl + (size_t)(hd * 64 + r) * 3072 + 2048 + b * 64 + 8 * c8;
                        f32x4 sk[4][2], sq4[4][2], sv[4][2];
#pragma unroll
                        for (int j = 0; j < 4; ++j)
#pragma unroll
                            for (int e = 0; e < 8; ++e) vv[j][e] = __builtin_nontemporal_load((const GAS float*)(cache_v + ((size_t)((b * 512 + 8 * (wave + 8 * (j + 4)) + e) * 16 + hd)) * 64 + lane));
#pragma unroll
                        for (int s4 = 0; s4 < 4; ++s4) { const float* a = pk + s4 * KQS_SLAB; const float* c = pv + s4 * KQS_SLAB;
                            sk[s4][0] = *(const GAS f32x4*)a; sk[s4][1] = *(const GAS f32x4*)(a + 4); sq4[s4][0] = *(const GAS f32x4*)(a + 1024); sq4[s4][1] = *(const GAS f32x4*)(a + 1028);
                            sv[s4][0] = *(const GAS f32x4*)c; sv[s4][1] = *(const GAS f32x4*)(c + 4); }
#pragma unroll
                        for (int j = 0; j < 4; ++j) { v4u w; w.x = pk2(vv[j][0], vv[j][1]); w.y = pk2(vv[j][2], vv[j][3]); w.z = pk2(vv[j][4], vv[j][5]); w.w = pk2(vv[j][6], vv[j][7]);
                            *(GAS v4u*)(VTs + ((size_t)((b * AH + hd) * 64 + lane)) * SKV + 8 * (wave + 8 * (j + 4))) = w; }
                        const f32x4 k0 = (sk[0][0] + sk[1][0]) + (sk[2][0] + sk[3][0]), k1 = (sk[0][1] + sk[1][1]) + (sk[2][1] + sk[3][1]);
                        const f32x4 q0 = (sq4[0][0] + sq4[1][0]) + (sq4[2][0] + sq4[3][0]), q1 = (sq4[0][1] + sq4[1][1]) + (sq4[2][1] + sq4[3][1]);
                        const f32x4 v0 = (sv[0][0] + sv[1][0]) + (sv[2][0] + sv[3][0]), v1 = (sv[0][1] + sv[1][1]) + (sv[2][1] + sv[3][1]);
                        v4u w; w.x = pk2(k0[0], k0[1]); w.y = pk2(k0[2], k0[3]); w.z = pk2(k1[0], k1[1]); w.w = pk2(k1[2], k1[3]);
                        *(GAS v4u*)(KHs + ((size_t)((b * AH + hd) * SKV + 512 + r)) * 64 + 8 * c8) = w;
                        { float* o = out + O_CK_S + (size_t)(b * 64 + r) * 1024 + hd * 64 + 8 * c8; *(GAS f32x4*)o = k0; *(GAS f32x4*)(o + 4) = k1; }
                        w.x = pk2(q0[0], q0[1]); w.y = pk2(q0[2], q0[3]); w.z = pk2(q1[0], q1[1]); w.w = pk2(q1[2], q1[3]);
                        *(GAS v4u*)(QHs + ((size_t)((b * AH + hd) * 64 + r)) * 64 + 8 * c8) = w;
                        w.x = pk2(v0[0], v0[1]); w.y = pk2(v0[2], v0[3]); w.z = pk2(v1[0], v1[1]); w.w = pk2(v1[2], v1[3]);
                        *(GAS v4u*)(VTs + ((size_t)((b * AH + hd) * 64 + r)) * SKV + 512 + 8 * c8) = w;
                        LAS float* tt = (LAS float*)(L + 81920);
#pragma unroll
                        for (int e = 0; e < 4; ++e) { tt[(8 * c8 + e) * 65 + r] = v0[e]; tt[(8 * c8 + 4 + e) * 65 + r] = v1[e]; }
                        __syncthreads();
                        f32x4 o0, o1;
#pragma unroll
                        for (int e = 0; e < 4; ++e) { o0[e] = tt[r * 65 + 8 * c8 + e]; o1[e] = tt[r * 65 + 8 * c8 + 4 + e]; }
                        float* o = out + O_CV_S + (size_t)(b * 64 + r) * 1024 + hd * 64 + 8 * c8; *(GAS f32x4*)o = o0; *(GAS f32x4*)(o + 4) = o1; } }
                  asm volatile("s_waitcnt vmcnt(0)" ::: "memory"); __syncthreads(); }
                bf16x8 qf[4]; v4u kreg, vreg;
                { ATTN_DECODE(F, bx)
#pragma unroll
                  for (int ks = 0; ks < 4; ++ks) qf[ks] = *(const GAS bf16x8*)(FQb + r32 * 64 + 8 * hi + 16 * ks);
                  kreg = *(const GAS v4u*)(FKHb + (size_t)(64 * Fkt_lo + srow) * 64 + 8 * sch); vreg = *(const GAS v4u*)(FVTb + (size_t)srow * FLk + 64 * Fkt_lo + 8 * sch); }
                for (int u = bx; u < 2304; u += G) {
                    ATTN_DECODE(U, u)
                    const int kt_lo = Ukt_lo, kt_hi = Usmp ? 8 : Uc0 + 3, hd = Uhd;
                    const bool active = Usmp ? (wave < 2) : true; const int cw = Usmp ? 8 : Uc0 + (wave >> 1);
                    const size_t m0 = Usmp ? (size_t)TP + Ub * 64 + Upos0 : (size_t)Ub * 2048 + Upos0;
                    const int qloc = (Usmp ? 512 + Upos0 : Upos0) + r32;
                    const int kt_first = cw - 8 > kt_lo ? cw - 8 : kt_lo;
                    const bool hasN = u + G < 2304;
                    bf16x8 qn[4];
                    float m_run = 0.f, l_run = 0.f; f32x16 o0, o1;
#pragma unroll
                    for (int r = 0; r < 16; ++r) { o0[r] = 0.f; o1[r] = 0.f; }
                    *(LAS v4u*)(KsB + srow * 72 + 8 * sch) = kreg;
                    *(LAS v4u*)(VsB + srow * 72 + 8 * sch) = vreg;
                    __syncthreads();
                    if (hasN) { ATTN_DECODE(M, u + G)
#pragma unroll
                        for (int ks = 0; ks < 4; ++ks) qn[ks] = *(const GAS bf16x8*)(MQb + r32 * 64 + 8 * hi + 16 * ks); }
                    for (int kt = kt_lo; kt <= kt_hi; ++kt) {
                        PROF_TA(0);
                        const int buf = (kt - kt_lo) & 1;
                        if (kt < kt_hi) { kreg = *(const GAS v4u*)(UKHb + (size_t)(64 * (kt + 1) + srow) * 64 + 8 * sch); vreg = *(const GAS v4u*)(UVTb + (size_t)srow * ULk + 64 * (kt + 1) + 8 * sch); }
                        else if (hasN) {
                            ATTN_DECODE(N, u + G)
                            kreg = *(const GAS v4u*)(NKHb + (size_t)(64 * Nkt_lo + srow) * 64 + 8 * sch); vreg = *(const GAS v4u*)(NVTb + (size_t)srow * NLk + 64 * Nkt_lo + 8 * sch); (void)NQb; }
                        if (active && kt <= cw && kt + 8 >= cw) {
                            const LAS bf16* Ks = KsB + buf * (64 * 72); const LAS bf16* Vs = VsB + buf * (64 * 72);
                            f32x16 p0, p1; const float nm = -m_run; const int jj = cw - kt;
                            const bf16x8 a00 = *(const LAS bf16x8*)(Ks + krow * 72 + 8 * hi), a10 = *(const LAS bf16x8*)(Ks + (32 + krow) * 72 + 8 * hi);
                            if (jj >= 5) { const float bc = biasL[hd * 641 + 512] + nm; f32x16 bcv;
#pragma unroll
                                for (int r = 0; r < 16; ++r) bcv[r] = bc;
                                p0 = MFMA32(a00, qf[0], bcv); p1 = MFMA32(a10, qf[0], bcv); }
                            else { const int base = qloc - 64 * kt - 8 * hi + 256;
                                const LAS float* blp = biasL + hd * 641 + base - 63;
                                const f32x2_t nm2 = {nm, nm};
#define ATT_BINIT(r) { f32x2_t t0 = {blp[63 - (16 * ((r) >> 3) + ((r) & 7))], blp[62 - (16 * ((r) >> 3) + ((r) & 7))]}, t1 = {blp[31 - (16 * ((r) >> 3) + ((r) & 7))], blp[30 - (16 * ((r) >> 3) + ((r) & 7))]}; \
                                    t0 += nm2; t1 += nm2; p0[r] = t0[0]; p0[(r) + 1] = t0[1]; p1[r] = t1[0]; p1[(r) + 1] = t1[1]; }
                                ATT_BINIT(0) ATT_BINIT(2) ATT_BINIT(4) ATT_BINIT(6) ATT_BINIT(8) ATT_BINIT(10) ATT_BINIT(12) ATT_BINIT(14)
#undef ATT_BINIT
                                p0 = MFMA32(a00, qf[0], p0); p1 = MFMA32(a10, qf[0], p1); }
#pragma unroll
                            for (int ks = 1; ks < 4; ++ks) { const bf16x8 a0 = *(const LAS bf16x8*)(Ks + krow * 72 + 8 * hi + 16 * ks), a1 = *(const LAS bf16x8*)(Ks + (32 + krow) * 72 + 8 * hi + 16 * ks);
                                p0 = MFMA32(a0, qf[ks], p0); p1 = MFMA32(a1, qf[ks], p1); }
                            asm volatile("s_nop 15\n\ts_nop 7" : "+v"(p0), "+v"(p1));
                            float mx = max3f_(p0[0], p1[0], p0[1]), mxb = max3f_(p1[1], p0[2], p1[2]);
#pragma unroll
                            for (int r = 3; r < 15; r += 2) { mx = max3f_(mx, p0[r], p1[r]); mxb = max3f_(mxb, p0[r + 1], p1[r + 1]); }
                            mx = max3f_(mx, mxb, p0[15]); mx = max3f_(mx, p1[15], p1[15]);
                            { const auto rr = __builtin_amdgcn_permlane32_swap(__builtin_bit_cast(unsigned, mx), __builtin_bit_cast(unsigned, mx), false, false);
                              const float ma = __builtin_bit_cast(float, (unsigned)rr[0]), mb = __builtin_bit_cast(float, (unsigned)rr[1]); mx = max3f_(ma, mb, mb); }
                            const bool first = (kt == kt_first);
                            if (first) {
                                m_run = mx;
#pragma unroll
                                for (int r = 0; r < 16; ++r) { p0[r] -= mx; p1[r] -= mx; } }
#pragma unroll
                            for (int r = 0; r < 16; ++r) { p0[r] = __builtin_amdgcn_exp2f(p0[r]); p1[r] = __builtin_amdgcn_exp2f(p1[r]); }
                            f32x2_t ls2 = __builtin_shufflevector(p0, p0, 0, 1) + __builtin_shufflevector(p1, p1, 0, 1);
#define ATT_PKSUM(r) ls2 += __builtin_shufflevector(p0, p0, r, r + 1); ls2 += __builtin_shufflevector(p1, p1, r, r + 1);
                            ATT_PKSUM(2) ATT_PKSUM(4) ATT_PKSUM(6) ATT_PKSUM(8) ATT_PKSUM(10) ATT_PKSUM(12) ATT_PKSUM(14)
#undef ATT_PKSUM
                            l_run += ls2[0] + ls2[1];
                            bf16x8 pb[4];
                            { float t[8];
#pragma unroll
                              for (int j = 0; j < 8; ++j) t[j] = p0[j];
                              pb[0] = pack8(t);
#pragma unroll
                              for (int j = 0; j < 8; ++j) t[j] = p0[8 + j];
                              pb[1] = pack8(t);
#pragma unroll
                              for (int j = 0; j < 8; ++j) t[j] = p1[j];
                              pb[2] = pack8(t);
#pragma unroll
                              for (int j = 0; j < 8; ++j) t[j] = p1[8 + j];
                              pb[3] = pack8(t); }
#pragma unroll
                            for (int s4 = 0; s4 < 4; ++s4) {
                                const bf16x8 A0 = *(const LAS bf16x8*)(Vs + r32 * 72 + 16 * s4 + 8 * hi), A1 = *(const LAS bf16x8*)(Vs + (32 + r32) * 72 + 16 * s4 + 8 * hi);
                                o0 = MFMA32(A0, pb[s4], o0); o1 = MFMA32(A1, pb[s4], o1); }
                            if (!first && __any(mx > 8.f)) { const float dl = fmaxf(mx, 0.f), alpha = __builtin_amdgcn_exp2f(-dl); m_run += dl; l_run *= alpha;
#pragma unroll
                                for (int r = 0; r < 16; ++r) { o0[r] *= alpha; o1[r] *= alpha; } }
                        }
                        PROF_TA(1);
                        if (kt < kt_hi) { LAS bf16* Kn = KsB + (buf ^ 1) * (64 * 72); LAS bf16* Vn = VsB + (buf ^ 1) * (64 * 72);
                            *(LAS v4u*)(Kn + srow * 72 + 8 * sch) = kreg;
                            *(LAS v4u*)(Vn + srow * 72 + 8 * sch) = vreg; }
                        PROF_TA(2);
                        __syncthreads();
                        PROF_TA(3);
                    }
                    if (active) {
                        const float inv = 1.f / xor32_sum_(l_run);
                        bf16* op = AO + (m0 + r32) * DM + hd * 64 + 4 * hi;
#pragma unroll
                        for (int r4 = 0; r4 < 4; ++r4) { v2u w; w.x = pk2(o0[4 * r4] * inv, o0[4 * r4 + 1] * inv); w.y = pk2(o0[4 * r4 + 2] * inv, o0[4 * r4 + 3] * inv); *(GAS v2u*)(op + 8 * r4) = w;
                            v2u w2; w2.x = pk2(o1[4 * r4] * inv, o1[4 * r4 + 1] * inv); w2.y = pk2(o1[4 * r4 + 2] * inv, o1[4 * r4 + 3] * inv); *(GAS v2u*)(op + 32 + 8 * r4) = w2; }
                    }
                    if (hasN) {
#pragma unroll
                        for (int ks = 0; ks < 4; ++ks) qf[ks] = qn[ks]; }
                }
#undef ATTN_DECODE
            }
            GRID_BAR();
            GEMM1024_NORM(EpiPlain, ({MB, DM}), ({MB + (size_t)TP * DM, DM}), AO, Wo_t, DM, false, false, norm_w + (4 + 1) * DM, false, 1);
            GRID_BAR();
        }
        { PHASE_PTRS pg8::Gemm g{XN, Wf1_t + (size_t)layer * FF2 * DM, TT, FF2, DM, DM}; pg8::StaticOrder S; S.init(TT, FF2, G, bx); EpiSwiGLU E{HB};
          pg8::gemm_phase<EpiSwiGLU, pg8::StaticOrder, true, true>(L, g, S, E, wave_s); }
        GRID_BAR();
        GEMM1024_NORM(EpiPlain, ({MB, DM}), ({MB + (size_t)TP * DM, DM}), HB, Wf2_t + (size_t)layer * DM * FF, FF, false, layer == 1, norm_w + (layer * 4 + 3) * DM, true, 2 + layer);
        if (layer == 0) GRID_BAR();
        }
#if PROF_K >= 0
    {
        PHASE_IDS PHASE_PTRS
        STAMP();
        LAS float* fs = (LAS float*)(L + MISC_OFF + 512);
        __syncthreads();
        if (tid == 0) { volatile LAS unsigned long long* ts = (volatile LAS unsigned long long*)(MISC + 8); const int k0 = PROF_K % 100;
            const unsigned long long d = (k0 == 50) ? ts[n_stamp - 1] - ts[0] : (k0 == 60 || k0 == 70) ? pt_acc0 : (k0 == 61 || k0 == 71) ? pt_acc1 : (k0 == 62 || k0 == 72) ? pt_acc2 : (k0 == 63 || k0 == 73) ? pt_acc3 : ts[k0 + 1] - ts[k0]; fs[0] = 1.f + (float)d * 0.01f * (PROF_K >= 100 ? 1e-4f : 5e-4f); }
        __syncthreads();
        const float f = fs[0];
        GRID_BAR();
        for (size_t i = gtid; i < 1048576; i += gsz) out[O_CV_S + i] *= f;
    }
#endif
}

extern "C" void kernel_launch(void* const* d_in, const int* in_sizes, int n_in, void* d_out, int out_size, void* d_ws, size_t ws_size, hipStream_t stream) {
    static int grid = 0;
    if (grid == 0) {
        int dev = 0, cus = 0, per_cu = 0;
        (void)hipGetDevice(&dev);
        (void)hipDeviceGetAttribute(&cus, hipDeviceAttributeMultiprocessorCount, dev);
        (void)hipFuncSetAttribute((const void*)mk_fwd, hipFuncAttributeMaxDynamicSharedMemorySize, LDS_BYTES);
        (void)hipOccupancyMaxActiveBlocksPerMultiprocessor(&per_cu, (const void*)mk_fwd, NTHREADS, LDS_BYTES);
        fprintf(stderr, "kernel_launch: cus %d per_cu %d ws_size %zu n_in %d out_size %d\n", cus, per_cu, ws_size, n_in, out_size);
        if (ws_size < WS_END3 || n_in != 22 || (size_t)out_size != O_TOTAL) { fprintf(stderr, "kernel_launch: unexpected sizes\n"); grid = -1; return; }
        grid = cus;
    }
    if (grid < 0) return;
    (void)hipMemsetAsync((char*)d_ws + WS_CTL, 0, 1 * MiB, stream);
    Args a{};
    for (int i = 0; i < 22; ++i) a.in[i] = (const float*)d_in[i];
    a.out = (float*)d_out; a.ws = (unsigned char*)d_ws; a.dbg = 0; a.pad = 0;
    void* args[] = {&a};
    hipError_t e = hipLaunchCooperativeKernel((const void*)mk_fwd, dim3(grid), dim3(NTHREADS), args, LDS_BYTES, stream);
    if (e != hipSuccess) fprintf(stderr, "cooperative launch failed: %s (grid %d)\n", hipGetErrorString(e), grid);
}
```

```cpp
#include <hip/hip_runtime.h>
#include <hip/hip_cooperative_groups.h>
#include <cstdio>
#include <cstdint>
namespace cg = cooperative_groups;
#define PROF_K (-1)

__device__ __forceinline__ int fresh_lane() { unsigned z = 0u; asm volatile("" : "+v"(z)); return (int)__builtin_amdgcn_mbcnt_hi(~0u, __builtin_amdgcn_mbcnt_lo(~0u, z)); }
namespace pg8 {
#define PG8_LAS __attribute__((address_space(3)))
typedef unsigned short bf16_t;
typedef short bf16x8 __attribute__((ext_vector_type(8)));
typedef float f32x4 __attribute__((ext_vector_type(4)));
typedef unsigned u32x4 __attribute__((ext_vector_type(4)));
constexpr int BM = 256, BK = 64, HALF = 128, HTB = HALF * BK * 2, STAGE_BYTES = 8 * HTB, NXCD = 8, WGM = 8;

__host__ __device__ __forceinline__ int lds_byte(int r, int c) { const int st = (r >> 4) * 2 + (c >> 5), rr = r & 15, cc = c & 31, ob = rr * 64 + cc * 2; return st * 1024 + (ob ^ (((ob >> 9) & 1) << 5)); }
__host__ __device__ __forceinline__ void stage_rc(int b, int& R, int& C) { const int st = b / 1024, sb = b % 1024, swz = sb ^ (((sb >> 9) & 1) << 5); R = (st >> 1) * 16 + swz / 64; C = (st & 1) * 32 + (swz % 64) / 2; }
__host__ __device__ __forceinline__ int perm32(int rho) { const int n = rho >> 4, i = rho & 15; return 8 * (i >> 2) + 4 * n + (i & 3); }

struct Unit { int pm, pn, w; };
struct Gemm { const bf16_t* A; const bf16_t* Bt; int M, N, K, ld; };

struct StaticOrder {
    int nM, nN, nwg, G, c;
    __host__ __device__ void init(int M, int N, int G_, int c_) { nM = M / BM; nN = N / BM; nwg = nM * nN; G = G_; c = c_; }
    __host__ __device__ bool next(int i, Unit& u) const {
        const long L = (long)i * G + c; if (L >= nwg) return false;
        int wgid = (int)L; { const int q = nwg / NXCD, r = nwg % NXCD, xcd = wgid % NXCD, off = wgid / NXCD; wgid = (xcd < r ? xcd * (q + 1) : r * (q + 1) + (xcd - r) * q) + off; }
        const int nig = WGM * nN, gid = wgid / nig, fm = gid * WGM, gsz = (nM - fm) < WGM ? (nM - fm) : WGM;
        u.pm = fm + ((wgid % nig) % gsz); u.pn = (wgid % nig) / gsz; u.w = 0; return true;
    }
    __device__ __forceinline__ void a_ready(const Unit&) const {}
    __device__ __forceinline__ void done(const Unit&) const {}
    __device__ __forceinline__ long offA(const Unit&) const { return 0; }
    __device__ __forceinline__ long offB(const Unit&) const { return 0; }
    __device__ __forceinline__ int nt(const Unit&, int d) const { return d; }
};
struct SplitOrder2 {
    int c; long koff;
    __device__ __forceinline__ bool next(int i, Unit& u) const { if (i > 0 || c >= 32) return false; const int t = c >> 1; u.pm = t >> 2; u.pn = t & 3; u.w = c & 1; return true; }
    __device__ __forceinline__ void a_ready(const Unit&) const {}
    __device__ __forceinline__ void done(const Unit&) const {}
    __device__ __forceinline__ long offA(const Unit& u) const { return u.w ? koff : 0; }
    __device__ __forceinline__ long offB(const Unit& u) const { return u.w ? koff : 0; }
    __device__ __forceinline__ int nt(const Unit&, int d) const { return d; }
};
struct DualOrder {
    int nM0, nN0, nM1, nN1, n0, n1, G, c; long dA, dB;
    __device__ __forceinline__ void init(int M0, int N0, int M1, int N1, int G_, int c_) { nM0 = M0 / BM; nN0 = N0 / BM; nM1 = M1 / BM; nN1 = N1 / BM; n0 = nM0 * nN0; n1 = nM1 * nN1; G = G_; c = c_; }
    __device__ __forceinline__ bool next(int i, Unit& u) const {
        const int Lx = i * G + c; if (Lx >= n0 + n1) return false;
        const int w = Lx >= n0 ? 1 : 0; const int nwg = w ? n1 : n0, nN = w ? nN1 : nN0, nM = w ? nM1 : nM0;
        int wgid = w ? Lx - n0 : Lx; { const int q = nwg / NXCD, r = nwg % NXCD, xcd = wgid % NXCD, off = wgid / NXCD; wgid = (xcd < r ? xcd * (q + 1) : r * (q + 1) + (xcd - r) * q) + off; }
        const int nig = WGM * nN, gid = wgid / nig, fm = gid * WGM, gsz = (nM - fm) < WGM ? (nM - fm) : WGM;
        u.pm = fm + ((wgid % nig) % gsz); u.pn = (wgid % nig) / gsz; u.w = w; return true; }
    __device__ __forceinline__ void a_ready(const Unit&) const {}
    __device__ __forceinline__ void done(const Unit&) const {}
    __device__ __forceinline__ long offA(const Unit& u) const { return u.w ? dA : 0; }
    __device__ __forceinline__ long offB(const Unit& u) const { return u.w ? dB : 0; }
    __device__ __forceinline__ int nt(const Unit&, int d) const { return d; }
};
struct KqvtOrder {
    int G, c; long dA, dB;
    __device__ __forceinline__ bool next(int i, Unit& u) const {
        const int Lx = i * G + c; if (Lx >= 1728) return false;
        if (Lx >= 1536) { const int q = Lx - 1536, kq = q & 3, tile = q >> 2;
            if (tile < 32) { u.pm = 128 + (tile >> 3); u.pn = tile & 7; u.w = 2 + 2 * kq; } else { const int t2 = tile - 32; u.pm = t2 >> 2; u.pn = 128 + (t2 & 3); u.w = 3 + 2 * kq; }
            return true; }
        const int w = Lx >= 1024 ? 1 : 0; const int nwg = w ? 512 : 1024, nN = w ? 128 : 8, nM = w ? 4 : 128;
        int wgid = w ? Lx - 1024 : Lx; { const int q = nwg / NXCD, xcd = wgid % NXCD, off = wgid / NXCD; wgid = xcd * q + off; }
        const int nig = WGM * nN, gid = wgid / nig, fm = gid * WGM, gsz = (nM - fm) < WGM ? (nM - fm) : WGM;
        u.pm = fm + ((wgid % nig) % gsz); u.pn = (wgid % nig) / gsz; u.w = w; return true; }
    __device__ __forceinline__ void a_ready(const Unit&) const {}
    __device__ __forceinline__ void done(const Unit&) const {}
    __device__ __forceinline__ long offA(const Unit& u) const { return ((u.w & 1) ? dA : 0) + (u.w >= 2 ? (long)((u.w - 2) >> 1) * 512 : 0); }
    __device__ __forceinline__ long offB(const Unit& u) const { return ((u.w & 1) ? dB : 0) + (u.w >= 2 ? (long)((u.w - 2) >> 1) * 512 : 0); }
    __device__ __forceinline__ int nt(const Unit& u, int d) const { return u.w >= 2 ? 4 : d; }
};

template <class Epi, class Sched, bool ALIGN_EPI = false, bool SP2 = false>
__device__ __forceinline__ void gemm_phase(PG8_LAS unsigned char* lds, const Gemm g, const Sched& S, const Epi& E, int wave_id) {
    int tid_ = wave_id * 64 + fresh_lane(); asm volatile("" : "+v"(tid_));
    const int tid = tid_, wid = __builtin_amdgcn_readfirstlane(tid >> 6), lane = tid & 63, wr = wid >> 2, wc = wid & 3, fr = lane & 15, fq = lane >> 4;
    const int K = g.K, nt = K / BK;
    unsigned voffA[2], voffB[2];
#pragma unroll
    for (int i = 0; i < 2; ++i) { int R, C; stage_rc(tid * 16 + i * 8192, R, C); const int Rb = Epi::PERM ? ((R & ~31) + perm32(R & 31)) : R;
        voffA[i] = (unsigned)(R * g.ld + C) * 2u; voffB[i] = (unsigned)(Rb * g.ld + C) * 2u; }
    const size_t kstep = (size_t)(BK * 2);
    const size_t hstep = (size_t)HALF * g.ld * 2;
    const size_t tstep = 2 * hstep;
    const unsigned ldsw = (unsigned)wid * 1024u;
    const int aoff = lds_byte(wr * 64 + fr, fq * 8), boff = lds_byte(wc * 32 + fr, fq * 8);
#define PG8_SA(b, h) (((b) * 2 + (h)) * HTB)
#define PG8_SB(b, h) ((4 + (b) * 2 + (h)) * HTB)
#define PG8_STAGE(bufoff, gbase, voff) do { _Pragma("unroll") for (int _i = 0; _i < 2; ++_i) \
        __builtin_amdgcn_global_load_lds((const unsigned*)((const char*)(gbase) + (voff)[_i]), (PG8_LAS unsigned*)(lds + (bufoff) + ldsw + _i * 8192), 16, 0, 0); } while (0)
#define PG8_LDA(dst, b, h) do { _Pragma("unroll") for (int m = 0; m < 4; ++m) _Pragma("unroll") for (int k = 0; k < 2; ++k) dst[m][k] = *(const PG8_LAS bf16x8*)(lds + PG8_SA(b, h) + aoff + m * 2048 + k * 1024); } while (0)
#define PG8_LDB(dst, b, h) do { _Pragma("unroll") for (int n = 0; n < 2; ++n) _Pragma("unroll") for (int k = 0; k < 2; ++k) dst[n][k] = *(const PG8_LAS bf16x8*)(lds + PG8_SB(b, h) + boff + n * 2048 + k * 1024); } while (0)
#define PG8_MMA(ai, bj, At, Bt) do { __builtin_amdgcn_s_setprio(1); _Pragma("unroll") for (int m = 0; m < 4; ++m) _Pragma("unroll") for (int n = 0; n < 2; ++n) _Pragma("unroll") for (int k = 0; k < 2; ++k) \
        acc[ai][bj][m][n] = __builtin_amdgcn_mfma_f32_16x16x32_bf16(Bt[n][k], At[m][k], acc[ai][bj][m][n], 0, 0, 0); __builtin_amdgcn_s_setprio(0); } while (0)
#define PG8_WAIT_V(n) asm volatile("s_waitcnt vmcnt(" #n ")" ::: "memory")
#define PG8_WAIT_L(n) asm volatile("s_waitcnt lgkmcnt(" #n ")" ::: "memory")
#define PG8_BAR __builtin_amdgcn_s_barrier()
#define PG8_SCHED __builtin_amdgcn_sched_barrier(0)
    Unit cur, nxt; int ui = 0;
    if (!S.next(0, cur)) return;
    f32x4 acc[2][2][4][2];
#pragma unroll
    for (int a = 0; a < 2; ++a)
#pragma unroll
        for (int b = 0; b < 2; ++b)
#pragma unroll
            for (int m = 0; m < 4; ++m)
#pragma unroll
                for (int n = 0; n < 2; ++n) acc[a][b][m][n] = (f32x4){0.f, 0.f, 0.f, 0.f};
    bf16x8 At[4][2], B0[2][2], B1[2][2];
    const char* cA = (const char*)g.A + (size_t)cur.pm * tstep + S.offA(cur); const char* cB = (const char*)g.Bt + (size_t)cur.pn * tstep + S.offB(cur);
    S.a_ready(cur);
    if constexpr (SP2) {
        PG8_STAGE(PG8_SB(0, 0), cB, voffB); PG8_STAGE(PG8_SB(0, 1), cB + hstep, voffB); PG8_STAGE(PG8_SA(0, 0), cA, voffA); PG8_STAGE(PG8_SA(0, 1), cA + hstep, voffA);
        if (wr == 1) PG8_BAR;
        PG8_WAIT_V(2); PG8_BAR;
        PG8_STAGE(PG8_SB(1, 0), cB + kstep, voffB); PG8_STAGE(PG8_SA(1, 0), cA + kstep, voffA); PG8_STAGE(PG8_SB(1, 1), cB + hstep + kstep, voffB);
        PG8_WAIT_V(6); PG8_BAR;
    } else {
        PG8_STAGE(PG8_SB(0, 0), cB, voffB); PG8_STAGE(PG8_SA(0, 0), cA, voffA); PG8_STAGE(PG8_SB(0, 1), cB + hstep, voffB); PG8_STAGE(PG8_SA(0, 1), cA + hstep, voffA);
        if (wr == 1) PG8_BAR;
        PG8_WAIT_V(4); PG8_BAR;
        PG8_STAGE(PG8_SB(1, 0), cB + kstep, voffB); PG8_STAGE(PG8_SA(1, 0), cA + kstep, voffA); PG8_STAGE(PG8_SB(1, 1), cB + hstep + kstep, voffB);
        PG8_WAIT_V(6); PG8_BAR;
    }
    for (;;) {
        const bool has_next = S.next(ui + 1, nxt);
        const char* nA = has_next ? (const char*)g.A + (size_t)nxt.pm * tstep + S.offA(nxt) : cA; const char* nB = has_next ? (const char*)g.Bt + (size_t)nxt.pn * tstep + S.offB(nxt) : cB;
        const int ntc = S.nt(cur, nt);
        for (int t = 0; t < ntc; t += 2) {
            const bool last = (t == ntc - 2);
            const char* a1 = cA + (size_t)(t + 1) * kstep;
            const char* a2 = last ? nA : cA + (size_t)(t + 2) * kstep; const char* b2 = last ? nB : cB + (size_t)(t + 2) * kstep;
            const char* a3 = a2 + kstep; const char* b3 = b2 + kstep;
            if (last && has_next) S.a_ready(nxt);
            if constexpr (Epi::KSCALE) { if (t == 0) E.unit_begin(cur, ui, lds, tid); else if ((t & 7) == 0) E.kscale(acc, ui, t >> 3, lds, wr, fr); }
            if constexpr (SP2) {
            PG8_LDB(B0, 0, 0); PG8_LDB(B1, 0, 1); PG8_SCHED; PG8_LDA(At, 0, 0); PG8_STAGE(PG8_SA(1, 1), a1 + hstep, voffA);
            PG8_WAIT_V(8); PG8_WAIT_L(0); PG8_BAR; PG8_MMA(0, 0, At, B0); PG8_MMA(0, 1, At, B1); PG8_BAR; PG8_SCHED;
            PG8_LDA(At, 0, 1); PG8_STAGE(PG8_SB(0, 0), b2, voffB); PG8_STAGE(PG8_SB(0, 1), b2 + hstep, voffB); PG8_STAGE(PG8_SA(0, 0), a2, voffA);
            PG8_WAIT_V(8); PG8_WAIT_L(0); PG8_BAR; PG8_MMA(1, 0, At, B0); PG8_MMA(1, 1, At, B1); PG8_BAR; PG8_SCHED;
            PG8_LDB(B0, 1, 0); PG8_LDB(B1, 1, 1); PG8_SCHED; PG8_LDA(At, 1, 0); PG8_STAGE(PG8_SA(0, 1), a2 + hstep, voffA);
            PG8_WAIT_V(8); PG8_WAIT_L(0); PG8_BAR; PG8_MMA(0, 0, At, B0); PG8_MMA(0, 1, At, B1); PG8_BAR; PG8_SCHED;
            PG8_LDA(At, 1, 1); PG8_STAGE(PG8_SB(1, 0), b3, voffB); PG8_STAGE(PG8_SB(1, 1), b3 + hstep, voffB); PG8_STAGE(PG8_SA(1, 0), a3, voffA);
            PG8_WAIT_V(8); PG8_WAIT_L(0); PG8_BAR; PG8_MMA(1, 0, At, B0); PG8_MMA(1, 1, At, B1); PG8_BAR; PG8_SCHED;
            } else {
            PG8_LDB(B0, 0, 0); PG8_SCHED; PG8_LDA(At, 0, 0); PG8_STAGE(PG8_SA(1, 1), a1 + hstep, voffA);
            PG8_WAIT_L(8); PG8_BAR; PG8_WAIT_L(0); PG8_MMA(0, 0, At, B0); PG8_BAR; PG8_SCHED;
            PG8_LDB(B1, 0, 1); PG8_STAGE(PG8_SB(0, 0), b2, voffB);
            PG8_BAR; PG8_WAIT_L(0); PG8_MMA(0, 1, At, B1); PG8_BAR;
            PG8_LDA(At, 0, 1); PG8_STAGE(PG8_SA(0, 0), a2, voffA);
            PG8_BAR; PG8_WAIT_L(0); PG8_MMA(1, 0, At, B0); PG8_BAR; PG8_SCHED;
            PG8_STAGE(PG8_SB(0, 1), b2 + hstep, voffB);
            PG8_WAIT_V(6); PG8_BAR; PG8_MMA(1, 1, At, B1); PG8_BAR;
            PG8_LDB(B0, 1, 0); PG8_SCHED; PG8_LDA(At, 1, 0); PG8_STAGE(PG8_SA(0, 1), a2 + hstep, voffA);
            PG8_WAIT_L(8); PG8_BAR; PG8_WAIT_L(0); PG8_MMA(0, 0, At, B0); PG8_BAR; PG8_SCHED;
            PG8_LDB(B1, 1, 1); PG8_STAGE(PG8_SB(1, 0), b3, voffB);
            PG8_BAR; PG8_WAIT_L(0); PG8_MMA(0, 1, At, B1); PG8_BAR;
            PG8_LDA(At, 1, 1); PG8_STAGE(PG8_SA(1, 0), a3, voffA);
            PG8_BAR; PG8_WAIT_L(0); PG8_MMA(1, 0, At, B0); PG8_BAR; PG8_SCHED;
            PG8_STAGE(PG8_SB(1, 1), b3 + hstep, voffB);
            PG8_WAIT_V(6); PG8_BAR; PG8_MMA(1, 1, At, B1); PG8_BAR;
            }
        }
        if constexpr (ALIGN_EPI) { if (wr == 0) PG8_BAR; }
        if constexpr (Epi::KSCALE) E.final(acc, cur, ui, lds, wr, wc, fr, fq); else E(acc, cur, wr, wc, fr, fq);
        S.done(cur);
        if (!has_next) break;
#pragma unroll
        for (int a = 0; a < 2; ++a)
#pragma unroll
            for (int b = 0; b < 2; ++b)
#pragma unroll
                for (int m = 0; m < 4; ++m)
#pragma unroll
                    for (int n = 0; n < 2; ++n) acc[a][b][m][n] = (f32x4){0.f, 0.f, 0.f, 0.f};
        cur = nxt; cA = nA; cB = nB; ++ui;
        if constexpr (ALIGN_EPI) { if (wr == 1) PG8_BAR; }
    }
    PG8_WAIT_V(0);
    if constexpr (!ALIGN_EPI) { if (wr == 0) PG8_BAR; }
    PG8_BAR;
#undef PG8_SA
#undef PG8_SB
#undef PG8_STAGE
#undef PG8_LDA
#undef PG8_LDB
#undef PG8_MMA
#undef PG8_WAIT_V
#undef PG8_WAIT_L
#undef PG8_BAR
#undef PG8_SCHED
}
}

constexpr int NTHREADS = 512, NWAVES = 8;
constexpr int LDS_BYTES = 147456;
constexpr int DM = 1024, TP = 32768, TS = 1024, TT = TP + TS;
constexpr int DI = 2048, NH = 32, HD = 64, NG = 4, NS = 128, CONVD = 3072, INPROJ = 5152, INPROJ_PAD = 5376;
constexpr int FF = 2816, FF2 = 5632;
constexpr int AH = 16;
constexpr float EPS = 1e-6f;
constexpr size_t O_Y = 0, O_SSM_P = 34603008, O_CONV_P = 38797312, O_CK_P = 38944768, O_CV_P = 47333376,
                 O_SSM_S = 55721984, O_CONV_S = 59916288, O_CK_S = 60063744, O_CV_S = 61112320, O_TOTAL = 62160896;
constexpr size_t MiB = 1u << 20;
constexpr size_t WS_CTL = 0;
constexpr size_t WS_WIN = 2 * MiB;
constexpr size_t WS_WOUT = WS_WIN + (size_t)INPROJ_PAD * DM * 2;
constexpr size_t WS_WF1 = WS_WOUT + (size_t)DM * DI * 2;
constexpr size_t WS_WF2 = WS_WF1 + 2 * (size_t)FF2 * DM * 2;
constexpr size_t WS_WKQ = WS_WF2 + 2 * (size_t)DM * FF * 2;
constexpr size_t WS_WV = WS_WKQ + (size_t)2048 * DM * 2;
constexpr size_t WS_WO = WS_WV + (size_t)DM * DM * 2;
constexpr size_t WS_WEND = WS_WO + (size_t)DM * DM * 2;
constexpr size_t WS_SSQ = 60 * MiB;
constexpr size_t WS_XN = 64 * MiB;
constexpr size_t WS_R = 130 * MiB;
constexpr size_t WS_Z = WS_R;
constexpr size_t WS_XBC = WS_R + 132 * MiB;
constexpr size_t WS_DT = WS_R + 330 * MiB;
constexpr size_t WS_END = WS_R + 336 * MiB;
constexpr size_t WS_M = WS_R + 264 * MiB;
constexpr size_t WS_H = WS_R;
constexpr size_t WS_KHP = WS_R, WS_QHP = WS_R + 64 * MiB, WS_VTP = WS_R + 128 * MiB;
constexpr size_t WS_KHS = WS_END, WS_VTS = WS_END + 18 * MiB, WS_QHS = WS_END + 36 * MiB, WS_END2 = WS_END + 38 * MiB, WS_SLAB = WS_END2, WS_END3 = WS_END2 + 8 * MiB;
constexpr size_t WS_AO = WS_R + 192 * MiB;
constexpr size_t WS_SQ = 61 * MiB;
constexpr int SKV = 576;
static_assert(WS_WEND <= WS_SSQ, "weights overflow");

#define GAS __attribute__((address_space(1)))
#define LAS __attribute__((address_space(3)))
typedef unsigned short bf16;
typedef unsigned v4u __attribute__((ext_vector_type(4)));
typedef unsigned v2u __attribute__((ext_vector_type(2)));
typedef float f32x4 __attribute__((ext_vector_type(4)));
typedef short bf16x8 __attribute__((ext_vector_type(8)));
#define LDS_WAIT() asm volatile("s_waitcnt lgkmcnt(0)" ::: "memory")

__device__ __forceinline__ unsigned f2bf(float f) { unsigned u = __builtin_bit_cast(unsigned, f); return (u + 0x7fffu + ((u >> 16) & 1u)) >> 16; }
typedef float f32x2_t __attribute__((ext_vector_type(2))); typedef __bf16 bf16x2_t __attribute__((ext_vector_type(2)));
__device__ __forceinline__ unsigned pk2(float lo, float hi) { const f32x2_t v = {lo, hi}; const bf16x2_t b = __builtin_convertvector(v, bf16x2_t); return __builtin_bit_cast(unsigned, b); }
__device__ __forceinline__ float bflo(unsigned u) { return __builtin_bit_cast(float, u << 16); }
__device__ __forceinline__ float bfhi(unsigned u) { return __builtin_bit_cast(float, u & 0xffff0000u); }
__device__ __forceinline__ float wave_sum(float v) {
#pragma unroll
    for (int o = 1; o < 64; o <<= 1) v += __shfl_xor(v, o);
    return v;
}

__device__ __forceinline__ float xor32_f(float v) { const auto rr = __builtin_amdgcn_permlane32_swap(__builtin_bit_cast(unsigned, v), __builtin_bit_cast(unsigned, v), false, false); const unsigned lo = rr[0], hi = rr[1];
    return __builtin_bit_cast(float, (fresh_lane() & 32) ? lo : hi); }
#define DPP_ADD(x, ctrl, rmask) ((x) + __builtin_bit_cast(float, __builtin_amdgcn_update_dpp(0, __builtin_bit_cast(int, (x)), (ctrl), (rmask), 0xf, false)))
__device__ __forceinline__ float wave_scan_incl(float x) {
    x = DPP_ADD(x, 0x111, 0xf); x = DPP_ADD(x, 0x112, 0xf); x = DPP_ADD(x, 0x114, 0xf); x = DPP_ADD(x, 0x118, 0xf);
    x = DPP_ADD(x, 0x142, 0xa); x = DPP_ADD(x, 0x143, 0xc); return x; }
__device__ __forceinline__ float xor32_max_(float v) { const auto rr = __builtin_amdgcn_permlane32_swap(__builtin_bit_cast(unsigned, v), __builtin_bit_cast(unsigned, v), false, false); return fmaxf(__builtin_bit_cast(float, (unsigned)rr[0]), __builtin_bit_cast(float, (unsigned)rr[1])); }
__device__ __forceinline__ float xor32_sum_(float v) { const auto rr = __builtin_amdgcn_permlane32_swap(__builtin_bit_cast(unsigned, v), __builtin_bit_cast(unsigned, v), false, false); return __builtin_bit_cast(float, (unsigned)rr[0]) + __builtin_bit_cast(float, (unsigned)rr[1]); }
__device__ __forceinline__ float max3f_(float a, float b, float c) { float r; asm("v_max3_f32 %0, %1, %2, %3" : "=v"(r) : "v"(a), "v"(b), "v"(c)); return r; }
struct Args { const float* in[22]; float* out; unsigned char* ws; int dbg; int pad; };

__device__ __forceinline__ void tr_item(const float* W, int Nsrc, int K, bf16* WT, int r0, int c0, int k0, const float* kscale, float cmul, LAS float* scr, int lane) {
    const int kq = lane >> 3, n4 = (lane & 7) * 4;
    f32x4 v[8]; float sc[8];
#pragma unroll
    for (int i = 0; i < 8; ++i) { const int kk = kq + 8 * i;
        v[i] = (c0 >= 0) ? __builtin_nontemporal_load((const GAS f32x4*)(W + (size_t)(k0 + kk) * Nsrc + c0 + n4)) : (f32x4){0.f, 0.f, 0.f, 0.f};
        sc[i] = kscale ? kscale[k0 + kk] * cmul : cmul; }
#pragma unroll
    for (int i = 0; i < 8; ++i) { const int kk = kq + 8 * i; LAS float* d = scr + kk * 33 + n4; d[0] = v[i][0] * sc[i]; d[1] = v[i][1] * sc[i]; d[2] = v[i][2] * sc[i]; d[3] = v[i][3] * sc[i]; }
    LDS_WAIT(); asm volatile("" ::: "memory");
    const int c = lane & 7;
#pragma unroll
    for (int j = 0; j < 4; ++j) { const int n = (lane >> 3) + 8 * j; const LAS float* s = scr + (8 * c) * 33 + n;
        v4u o; o.x = pk2(s[0 * 33], s[1 * 33]); o.y = pk2(s[2 * 33], s[3 * 33]); o.z = pk2(s[4 * 33], s[5 * 33]); o.w = pk2(s[6 * 33], s[7 * 33]);
        *(GAS v4u*)(WT + (size_t)(r0 + n) * K + k0 + 8 * c) = o; }
    LDS_WAIT(); asm volatile("" ::: "memory");
}
__device__ __forceinline__ void rms_row2_to_bf16(const float* xrow, bf16* orow, int lane) {
    f32x4 v[2][4]; float s[2] = {0.f, 0.f};
#pragma unroll
    for (int r = 0; r < 2; ++r)
#pragma unroll
        for (int j = 0; j < 4; ++j) { v[r][j] = __builtin_nontemporal_load((const GAS f32x4*)(xrow + r * DM + 4 * lane + 256 * j)); s[r] += (v[r][j].x * v[r][j].x + v[r][j].y * v[r][j].y) + (v[r][j].z * v[r][j].z + v[r][j].w * v[r][j].w); }
#pragma unroll
    for (int r = 0; r < 2; ++r) { const float rstd = __builtin_amdgcn_rsqf(wave_sum(s[r]) * (1.f / DM) + EPS);
#pragma unroll
        for (int j = 0; j < 4; ++j) { v2u o; o.x = pk2(v[r][j].x * rstd, v[r][j].y * rstd); o.y = pk2(v[r][j].z * rstd, v[r][j].w * rstd); *(GAS v2u*)(orow + r * DM + 4 * lane + 256 * j) = o; } }
}

struct EpiInProj {
    static constexpr bool PERM = true, KSCALE = false;
    bf16* Z; bf16* XBC; float* DT; float* out;
    __device__ __forceinline__ void operator()(const f32x4 (&acc)[2][2][4][2], const pg8::Unit& u, int wr, int wc, int fr, int fq) const {
        const int row0 = u.pm * 256 + wr * 64 + fr; const int ct = u.pn; const int cl = wc * 32 + 8 * fq;
#pragma unroll
        for (int ai = 0; ai < 2; ++ai)
#pragma unroll
            for (int m = 0; m < 4; ++m) {
                const int row = row0 + ai * 128 + m * 16;
#pragma unroll
                for (int bj = 0; bj < 2; ++bj) {
                    const f32x4 v0 = acc[ai][bj][m][0], v1 = acc[ai][bj][m][1];
                    v4u w; w.x = pk2(v0[0], v0[1]); w.y = pk2(v0[2], v0[3]); w.z = pk2(v1[0], v1[1]); w.w = pk2(v1[2], v1[3]);
                    const int c = bj * 128 + cl;
                    if (ct < 8) { *(GAS v4u*)(Z + (size_t)row * DI + ct * 256 + c) = w; }
                    else if (ct < 20) {
                        const int col = (ct - 8) * 256 + c;
                        *(GAS v4u*)(XBC + (size_t)row * CONVD + col) = w;
                        int pos, b; size_t ob; int L;
                        if (row < TP) { b = row >> 11; pos = row & 2047; L = 2048; ob = O_CONV_P; } else { b = (row - TP) >> 6; pos = (row - TP) & 63; L = 64; ob = O_CONV_S; }
                        if (pos >= L - 3) { float* o = out + ob + (size_t)(b * 3 + (pos - (L - 3))) * CONVD + col; *(GAS f32x4*)o = v0; *(GAS f32x4*)(o + 4) = v1; }
                    } else {
                        if (bj == 0 && wc == 0) { float* o = DT + (size_t)row * 32 + 8 * fq; *(GAS f32x4*)o = v0; *(GAS f32x4*)(o + 4) = v1; }
                    }
                }
            }
    }
};

struct EpiPlain {
    static constexpr bool PERM = true, KSCALE = false;
    bf16* O; int ldc;
    __device__ __forceinline__ void operator()(const f32x4 (&acc)[2][2][4][2], const pg8::Unit& u, int wr, int wc, int fr, int fq) const {
        const int row0 = u.pm * 256 + wr * 64 + fr, col0 = u.pn * 256 + wc * 32 + 8 * fq;
#pragma unroll
        for (int ai = 0; ai < 2; ++ai)
#pragma unroll
            for (int m = 0; m < 4; ++m) { bf16* rowp = O + (size_t)(row0 + ai * 128 + m * 16) * ldc + col0;
#pragma unroll
                for (int bj = 0; bj < 2; ++bj) { const f32x4 v0 = acc[ai][bj][m][0], v1 = acc[ai][bj][m][1];
                    v4u w; w.x = pk2(v0[0], v0[1]); w.y = pk2(v0[2], v0[3]); w.z = pk2(v1[0], v1[1]); w.w = pk2(v1[2], v1[3]);
                    *(GAS v4u*)(rowp + bj * 128) = w; } }
    }
};
constexpr int KS_OFF = 135168;
struct EpiOutProj {
    static constexpr bool PERM = true, KSCALE = true;
    bf16* O; int ldc; const float* ssq;
    __device__ __forceinline__ void unit_begin(const pg8::Unit& u, int ui, PG8_LAS unsigned char* lds, int tid) const {
        asm volatile("" : "+v"(tid));
        if (tid < 256) { const f32x4 v = *(const GAS f32x4*)(ssq + (size_t)(u.pm * 256 + tid) * 4);
            const float a0 = v[0] * (1.f / 512.f) + EPS, a1 = v[1] * (1.f / 512.f) + EPS, a2 = v[2] * (1.f / 512.f) + EPS, a3 = v[3] * (1.f / 512.f) + EPS;
            f32x4 r; r[0] = __builtin_amdgcn_rsqf(a0) * __builtin_amdgcn_sqrtf(a1); r[1] = __builtin_amdgcn_rsqf(a1) * __builtin_amdgcn_sqrtf(a2); r[2] = __builtin_amdgcn_rsqf(a2) * __builtin_amdgcn_sqrtf(a3); r[3] = __builtin_amdgcn_rsqf(a3);
            *(PG8_LAS f32x4*)(lds + KS_OFF + (ui & 1) * 4096 + tid * 16) = r; }
    }
    __device__ __forceinline__ void kscale(f32x4 (&acc)[2][2][4][2], int ui, int g, PG8_LAS unsigned char* lds, int wr, int fr) const {
        asm volatile("" : "+v"(fr));
        const PG8_LAS float* rt = (const PG8_LAS float*)(lds + KS_OFF + (ui & 1) * 4096) + (wr * 64 + fr) * 4 + (g - 1);
#pragma unroll
        for (int ai = 0; ai < 2; ++ai)
#pragma unroll
            for (int m = 0; m < 4; ++m) { const float ratio = rt[(ai * 128 + m * 16) * 4];
#pragma unroll
                for (int bj = 0; bj < 2; ++bj)
#pragma unroll
                    for (int n = 0; n < 2; ++n) acc[ai][bj][m][n] = acc[ai][bj][m][n] * ratio; }
    }
    __device__ __forceinline__ void final(const f32x4 (&acc)[2][2][4][2], const pg8::Unit& u, int ui, PG8_LAS unsigned char* lds, int wr, int wc, int fr, int fq) const {
        asm volatile("" : "+v"(fr), "+v"(fq));
        const int row0 = u.pm * 256 + wr * 64 + fr, col0 = u.pn * 256 + wc * 32 + 8 * fq;
        const PG8_LAS float* rt = (const PG8_LAS float*)(lds + KS_OFF + (ui & 1) * 4096) + (wr * 64 + fr) * 4 + 3;
#pragma unroll
        for (int ai = 0; ai < 2; ++ai)
#pragma unroll
            for (int m = 0; m < 4; ++m) { const int row = row0 + ai * 128 + m * 16; bf16* rowp = O + (size_t)row * ldc + col0;
                const float s3 = rt[(ai * 128 + m * 16) * 4];
#pragma unroll
                for (int bj = 0; bj < 2; ++bj) { const f32x4 v0 = acc[ai][bj][m][0] * s3, v1 = acc[ai][bj][m][1] * s3;
                    v4u w; w.x = pk2(v0[0], v0[1]); w.y = pk2(v0[2], v0[3]); w.z = pk2(v1[0], v1[1]); w.w = pk2(v1[2], v1[3]);
                    *(GAS v4u*)(rowp + bj * 128) = w; } }
    }
    __device__ __forceinline__ void operator()(const f32x4 (&acc)[2][2][4][2], const pg8::Unit& u, int wr, int wc, int fr, int fq) const {}
};
__device__ __forceinline__ float silu_f(float v) { return v * __builtin_amdgcn_rcpf(1.f + __expf(-v)); }
struct EpiSwiGLU {
    static constexpr bool PERM = true, KSCALE = false;
    bf16* H;
    __device__ __forceinline__ void operator()(const f32x4 (&acc)[2][2][4][2], const pg8::Unit& u, int wr, int wc, int fr, int fq) const {
        const int row0 = u.pm * 256 + wr * 64 + fr, col0 = u.pn * 128 + wc * 32 + 8 * fq;
#pragma unroll
        for (int ai = 0; ai < 2; ++ai)
#pragma unroll
            for (int m = 0; m < 4; ++m) {
                const f32x4 g0 = acc[ai][0][m][0], g1 = acc[ai][0][m][1], u0 = acc[ai][1][m][0], u1 = acc[ai][1][m][1];
                v4u w; w.x = pk2(silu_f(g0[0]) * u0[0], silu_f(g0[1]) * u0[1]); w.y = pk2(silu_f(g0[2]) * u0[2], silu_f(g0[3]) * u0[3]);
                w.z = pk2(silu_f(g1[0]) * u1[0], silu_f(g1[1]) * u1[1]); w.w = pk2(silu_f(g1[2]) * u1[2], silu_f(g1[3]) * u1[3]);
                *(GAS v4u*)(H + (size_t)(row0 + ai * 128 + m * 16) * FF + col0) = w; }
    }
};
struct EpiKQ {
    static constexpr bool PERM = true, KSCALE = false;
    bf16 *KHp, *QHp, *KHs, *QHs; float* out;
    __device__ __forceinline__ void operator()(const f32x4 (&acc)[2][2][4][2], const pg8::Unit& u, int wr, int wc, int fr, int fq) const {
        const int row_t = u.pm * 256, b = row_t >> 11, pos_t = row_t & 2047; const bool isK = u.pn < 4, cache = isK && pos_t >= 1536;
        const int hd0 = (u.pn & 3) * 4 + (wc >> 1), d = (wc & 1) * 32 + 8 * fq, ro = wr * 64 + fr;
        bf16* dstb = (isK ? KHp : QHp) + ((size_t)((b * AH + hd0) * 2048 + pos_t + ro)) * 64 + d;
        float* ob = out + O_CK_P + (size_t)(b * 512 + pos_t - 1536 + ro) * 1024 + u.pn * 256 + wc * 32 + 8 * fq;
#pragma unroll
        for (int ai = 0; ai < 2; ++ai)
#pragma unroll
            for (int m = 0; m < 4; ++m)
#pragma unroll
                for (int bj = 0; bj < 2; ++bj) {
                    const f32x4 v0 = acc[ai][bj][m][0], v1 = acc[ai][bj][m][1];
                    v4u w; w.x = pk2(v0[0], v0[1]); w.y = pk2(v0[2], v0[3]); w.z = pk2(v1[0], v1[1]); w.w = pk2(v1[2], v1[3]);
                    *(GAS v4u*)(dstb + (size_t)(bj * 2 * 2048 + ai * 128 + m * 16) * 64) = w;
                    if (cache) { float* o = ob + (size_t)(ai * 128 + m * 16) * 1024 + bj * 128; *(GAS f32x4*)o = v0; *(GAS f32x4*)(o + 4) = v1; }
                }
    }
};
struct EpiVT {
    static constexpr bool PERM = true, KSCALE = false;
    bf16 *VTp, *VTs; float* out;
    __device__ __forceinline__ void operator()(const f32x4 (&acc)[2][2][4][2], const pg8::Unit& u, int wr, int wc, int fr, int fq) const {
        const int b = u.pn >> 3, pos_t = (u.pn & 7) * 256; const bool cache = pos_t >= 1536;
        const int hd0 = u.pm * 4 + wr, po = wc * 32 + 8 * fq;
        bf16* dstb = VTp + ((size_t)((b * AH + hd0) * 64 + fr)) * 2048 + pos_t + po;
        float* ob = out + O_CV_P + (size_t)(b * 512 + pos_t - 1536 + po) * 1024 + u.pm * 256 + wr * 64 + fr;
#pragma unroll
        for (int ai = 0; ai < 2; ++ai)
#pragma unroll
            for (int m = 0; m < 4; ++m)
#pragma unroll
                for (int bj = 0; bj < 2; ++bj) {
                    const f32x4 v0 = acc[ai][bj][m][0], v1 = acc[ai][bj][m][1];
                    v4u w; w.x = pk2(v0[0], v0[1]); w.y = pk2(v0[2], v0[3]); w.z = pk2(v1[0], v1[1]); w.w = pk2(v1[2], v1[3]);
                    *(GAS v4u*)(dstb + (size_t)((ai * 2 * 64 + m * 16) * 2048 + bj * 128)) = w;
                    if (cache) { float* o = ob + (size_t)(bj * 128) * 1024 + ai * 128 + m * 16;
#pragma unroll
                        for (int e = 0; e < 4; ++e) { o[(size_t)e * 1024] = v0[e]; o[(size_t)(e + 4) * 1024] = v1[e]; } }
                }
    }
};

struct EpiSlab {
    static constexpr bool PERM = true, KSCALE = false;
    float* slab;
    __device__ __forceinline__ void operator()(const f32x4 (&acc)[2][2][4][2], const pg8::Unit& u, int wr, int wc, int fr, int fq) const {
        const int row0 = u.pm * 256 + wr * 64 + fr, col0 = u.pn * 256 + wc * 32 + 8 * fq; float* base = slab + (size_t)u.w * (TS * DM);
#pragma unroll
        for (int ai = 0; ai < 2; ++ai)
#pragma unroll
            for (int m = 0; m < 4; ++m) { float* rowp = base + (size_t)(row0 + ai * 128 + m * 16) * DM + col0;
#pragma unroll
                for (int bj = 0; bj < 2; ++bj) { *(GAS f32x4*)(rowp + bj * 128) = acc[ai][bj][m][0]; *(GAS f32x4*)(rowp + bj * 128 + 4) = acc[ai][bj][m][1]; } }
    }
};
constexpr size_t KQS_SLAB = (size_t)TS * 3072;
struct EpiKQVT {
    static constexpr bool PERM = true, KSCALE = false;
    EpiKQ kq; EpiVT vt; float* slab;
    __device__ __forceinline__ void operator()(const f32x4 (&acc)[2][2][4][2], const pg8::Unit& u, int wr, int wc, int fr, int fq) const {
        if (u.w == 0) kq(acc, u, wr, wc, fr, fq); else if (u.w == 1) vt(acc, u, wr, wc, fr, fq);
        else { const bool isv = u.w & 1; const int row0 = (isv ? u.pm : u.pm - 128) * 256 + wr * 64 + fr, col0 = (isv ? 2048 + (u.pn - 128) * 256 : u.pn * 256) + wc * 32 + 8 * fq;
            float* base = slab + (size_t)((u.w - 2) >> 1) * KQS_SLAB;
#pragma unroll
            for (int ai = 0; ai < 2; ++ai)
#pragma unroll
                for (int m = 0; m < 4; ++m) { float* rowp = base + (size_t)(row0 + ai * 128 + m * 16) * 3072 + col0;
#pragma unroll
                    for (int bj = 0; bj < 2; ++bj) { *(GAS f32x4*)(rowp + bj * 128) = acc[ai][bj][m][0]; *(GAS f32x4*)(rowp + bj * 128 + 4) = acc[ai][bj][m][1]; } } }
    }
};
__device__ __forceinline__ void norm_row2(const bf16* Mrow, const float* mf, const float* xf, bf16* xn, float* sq, float* yout, const float* wpost, int lane) {
    f32x4 mv[2][4], xv[2][4], wv[4]; float s[2] = {0.f, 0.f};
#pragma unroll
    for (int j = 0; j < 4; ++j) wv[j] = *(const GAS f32x4*)(wpost + 4 * lane + 256 * j);
#pragma unroll
    for (int r = 0; r < 2; ++r) {
        const float sqr = xf ? 1.f : sq[r];
#pragma unroll
        for (int j = 0; j < 4; ++j) {
            if (mf) mv[r][j] = *(const GAS f32x4*)(mf + r * DM + 4 * lane + 256 * j) + *(const GAS f32x4*)(mf + (size_t)TS * DM + r * DM + 4 * lane + 256 * j);
            else { const v2u mm = __builtin_nontemporal_load((const GAS v2u*)(Mrow + r * DM + 4 * lane + 256 * j)); mv[r][j] = (f32x4){bflo(mm.x), bfhi(mm.x), bflo(mm.y), bfhi(mm.y)}; }
            if (xf) xv[r][j] = __builtin_nontemporal_load((const GAS f32x4*)(xf + r * DM + 4 * lane + 256 * j));
            else { const v2u xx = *(const GAS v2u*)(xn + r * DM + 4 * lane + 256 * j); xv[r][j] = (f32x4){bflo(xx.x) * sqr, bfhi(xx.x) * sqr, bflo(xx.y) * sqr, bfhi(xx.y) * sqr}; }
            s[r] += (mv[r][j].x * mv[r][j].x + mv[r][j].y * mv[r][j].y) + (mv[r][j].z * mv[r][j].z + mv[r][j].w * mv[r][j].w); } }
    float s2[2] = {0.f, 0.f};
#pragma unroll
    for (int r = 0; r < 2; ++r) { const float r1 = __builtin_amdgcn_rsqf(wave_sum(s[r]) * (1.f / DM) + EPS);
#pragma unroll
        for (int j = 0; j < 4; ++j) { xv[r][j] = xv[r][j] + mv[r][j] * r1 * wv[j];
            if (yout) *(GAS f32x4*)(yout + r * DM + 4 * lane + 256 * j) = xv[r][j];
            s2[r] += (xv[r][j].x * xv[r][j].x + xv[r][j].y * xv[r][j].y) + (xv[r][j].z * xv[r][j].z + xv[r][j].w * xv[r][j].w); } }
    if (!yout) {
#pragma unroll
        for (int r = 0; r < 2; ++r) { const float ms = wave_sum(s2[r]) * (1.f / DM) + EPS; const float r2 = __builtin_amdgcn_rsqf(ms);
            if (lane == 0) sq[r] = ms * r2;
#pragma unroll
            for (int j = 0; j < 4; ++j) { v2u o; o.x = pk2(xv[r][j].x * r2, xv[r][j].y * r2); o.y = pk2(xv[r][j].z * r2, xv[r][j].w * r2); *(GAS v2u*)(xn + r * DM + 4 * lane + 256 * j) = o; } } }
}

typedef float f32x16 __attribute__((ext_vector_type(16)));
__device__ __forceinline__ bf16x8 pack8(const float* v) { v4u w; w.x = pk2(v[0], v[1]); w.y = pk2(v[2], v[3]); w.z = pk2(v[4], v[5]); w.w = pk2(v[6], v[7]); return __builtin_bit_cast(bf16x8, w); }
#define MFMA16(a, b, c) __builtin_amdgcn_mfma_f32_16x16x32_bf16((a), (b), (c), 0, 0, 0)
#define MFMA32(a, b, c) __builtin_amdgcn_mfma_f32_32x32x16_bf16((a), (b), (c), 0, 0, 0)
constexpr int S_XT = 0, S_BT = 18432, S_BN = 36864, S_CN = 54272, S_CB = 71680, S_HS = 89088, S_DT = 123904, S_CUM = 124416, S_W = 124928, S_CEND = 125440;


#define XB_TMO      128
#define XB_XCNT(j)  (256  + 64 * (j))
#define XB_XSUB(j)  (1280 + 64 * (j))
#define XB_XGEN(j)  (2304 + 64 * (j))
#define XB_TOP      3328
#define XB_TOPGEN   3392
#define XCD_BAR_WORDS 3456
#define XB_SPIN_CAP (1u << 22)
__device__ __forceinline__ unsigned xb_ld(unsigned* p)              { return __hip_atomic_load(p, __ATOMIC_RELAXED, __HIP_MEMORY_SCOPE_AGENT); }
__device__ __forceinline__ unsigned xb_add(unsigned* p, unsigned v) { return __hip_atomic_fetch_add(p, v, __ATOMIC_RELAXED, __HIP_MEMORY_SCOPE_AGENT); }
__device__ __forceinline__ unsigned xb_xcc_id() { return (unsigned)__builtin_amdgcn_s_getreg((3 << 11) | 20) & 0xFu; }
#define XB_SPIN(cond, bar) do { unsigned _sp = 0; while (cond) { __builtin_amdgcn_s_sleep(1); \
    if ((++_sp & 255u) == 0u) { if (xb_ld(&(bar)[XB_TMO])) break; if (_sp > XB_SPIN_CAP) { atomicAdd(&(bar)[XB_TMO], 1u); break; } } } } while (0)
struct XcdBarrier { unsigned* bar; unsigned x; volatile LAS unsigned* st; };
__device__ __forceinline__ bool is_thread0(int wave_id) { return wave_id == 0 && fresh_lane() == 0; }
__device__ __forceinline__ XcdBarrier xcd_barrier_post(unsigned* bar, volatile LAS unsigned* st, int wave_id) {
    XcdBarrier b; b.bar = bar; b.x = xb_xcc_id(); b.st = st;
    if (is_thread0(wave_id)) (void)xb_add(&bar[XB_XCNT(b.x)], 1u);
    return b;
}
__device__ __forceinline__ void xcd_barrier_complete(unsigned* bar, unsigned x, unsigned& nloc, unsigned& nx) {
    const unsigned G = gridDim.x * gridDim.y * gridDim.z;
    unsigned sum, cnt, mine, sp = 0u;
    for (;;) {
        sum = 0u; cnt = 0u; mine = 0u;
#pragma unroll
        for (unsigned j = 0; j < 16; ++j) { const unsigned c = xb_ld(&bar[XB_XCNT(j)]); sum += c; cnt += (c > 0u) ? 1u : 0u; mine = (j == x) ? c : mine; }
        if (sum == G) break;
        __builtin_amdgcn_s_sleep(1);
        if ((++sp & 255u) == 0u) { if (xb_ld(&bar[XB_TMO])) break; if (sp > XB_SPIN_CAP) { atomicAdd(&bar[XB_TMO], 1u); break; } }
    }
    nloc = mine > 0u ? mine : 1u; nx = cnt > 0u ? cnt : 1u;
}
__device__ __forceinline__ void xcd_barrier(const XcdBarrier& b, int wave_id) {
    asm volatile("s_waitcnt vmcnt(0)" ::: "memory");
    __syncthreads();
    if (is_thread0(wave_id)) {
        unsigned* bar = b.bar;
        __builtin_amdgcn_s_waitcnt(0);
        unsigned nloc = b.st[0], nx = b.st[1];
        if (nloc == 0u) { xcd_barrier_complete(bar, b.x, nloc, nx); b.st[0] = nloc; b.st[1] = nx; }
        const unsigned old = xb_add(&bar[XB_XSUB(b.x)], 1u);
        const unsigned gen = old / nloc;
        if (old + 1u == (gen + 1u) * nloc) {
            __builtin_amdgcn_fence(__ATOMIC_RELEASE, "agent");
            asm volatile("s_waitcnt vmcnt(0)" ::: "memory");
            const unsigned og = xb_add(&bar[XB_TOP], 1u);
            const unsigned tg = og / nx;
            if (og + 1u == (tg + 1u) * nx) xb_add(&bar[XB_TOPGEN], 1u);
            else XB_SPIN(xb_ld(&bar[XB_TOPGEN]) == tg, bar);
            __builtin_amdgcn_fence(__ATOMIC_ACQUIRE, "agent");
            xb_add(&bar[XB_XGEN(b.x)], 1u);
            asm volatile("s_waitcnt vmcnt(0)" ::: "memory");
        } else {
            XB_SPIN(xb_ld(&bar[XB_XGEN(b.x)]) == gen, bar);
            __builtin_amdgcn_fence(__ATOMIC_ACQUIRE, "agent");
            asm volatile("s_waitcnt vmcnt(0)" ::: "memory");
        }
    }
    __syncthreads();
}
constexpr int MISC_OFF = 146432;

__global__ void __launch_bounds__(NTHREADS, 2) mk_fwd(Args a) {
    extern __shared__ __attribute__((aligned(16))) unsigned char lds[];
    cg::grid_group grid = cg::this_grid();
    const int wave_s = __builtin_amdgcn_readfirstlane((int)threadIdx.x >> 6);
    const int G = gridDim.x, bx = blockIdx.x, NGW = G * NWAVES;
    const size_t gsz = (size_t)G * NTHREADS;
#define PHASE_IDS int tid = wave_s * 64 + fresh_lane(); asm volatile("" : "+v"(tid)); const int lane = tid & 63, wave = __builtin_amdgcn_readfirstlane(tid >> 6), gw = bx * NWAVES + wave; const size_t gtid = (size_t)bx * NTHREADS + tid; (void)lane; (void)gw; (void)gtid;
#define PHASE_PTRS const Args __attribute__((address_space(4)))* ap_ = (const Args __attribute__((address_space(4)))*)__builtin_amdgcn_kernarg_segment_ptr(); asm volatile("" : "+s"(ap_)); \
    unsigned char* ws = ap_->ws; float* out = ap_->out; (void)out; const float* x_p = ap_->in[0]; const float* x_s = ap_->in[1]; const float* norm_w = ap_->in[6]; (void)x_p; (void)x_s; (void)norm_w; \
    bf16* Win_t = (bf16*)(ws + WS_WIN); bf16* Wout_t = (bf16*)(ws + WS_WOUT); bf16* Wf1_t = (bf16*)(ws + WS_WF1); bf16* Wf2_t = (bf16*)(ws + WS_WF2); \
    bf16* Wkq_t = (bf16*)(ws + WS_WKQ); bf16* Wv_t = (bf16*)(ws + WS_WV); bf16* Wo_t = (bf16*)(ws + WS_WO); \
    bf16* XN = (bf16*)(ws + WS_XN); bf16* Z = (bf16*)(ws + WS_Z); bf16* XBC = (bf16*)(ws + WS_XBC); float* DT = (float*)(ws + WS_DT); \
    float* SSQ = (float*)(ws + WS_SSQ); float* SQ = (float*)(ws + WS_SQ); (void)SQ; float* SLAB = (float*)(ws + WS_SLAB); (void)SLAB; bf16* MB = (bf16*)(ws + WS_M); bf16* HB = (bf16*)(ws + WS_H); \
    bf16* KHp = (bf16*)(ws + WS_KHP); bf16* QHp = (bf16*)(ws + WS_QHP); bf16* VTp = (bf16*)(ws + WS_VTP); \
    bf16* KHs = (bf16*)(ws + WS_KHS); bf16* QHs = (bf16*)(ws + WS_QHS); bf16* VTs = (bf16*)(ws + WS_VTS); bf16* AO = (bf16*)(ws + WS_AO); \
    (void)Win_t; (void)Wout_t; (void)Wf1_t; (void)Wf2_t; (void)Wkq_t; (void)Wv_t; (void)Wo_t; (void)XN; (void)Z; (void)XBC; (void)DT; (void)SSQ; (void)MB; (void)HB; \
    (void)KHp; (void)QHp; (void)VTp; (void)KHs; (void)QHs; (void)VTs; (void)AO;
#define AIN(k) (ap_->in[k])
    LAS unsigned char* L = (LAS unsigned char*)lds;
    volatile LAS unsigned* MISC = (volatile LAS unsigned*)(L + MISC_OFF);
    if (wave_s == 0) MISC[fresh_lane()] = 0u;
    __syncthreads();
    const XcdBarrier xbar = xcd_barrier_post((unsigned*)(a.ws + WS_CTL) + 4096, MISC, wave_s);
#if PROF_K >= 0
    int n_stamp = 0;
#endif
#if PROF_K >= 0
#define STAMP() do { if (is_thread0(wave_s) && n_stamp < 24) ((volatile LAS unsigned long long*)(MISC + 8))[n_stamp] = __builtin_amdgcn_s_memrealtime(); ++n_stamp; } while (0)
#else
#define STAMP() do { } while (0)
#endif
#define GRID_BAR() do { xcd_barrier(xbar, wave_s); STAMP(); } while (0)
    STAMP();

    {
        PHASE_IDS PHASE_PTRS
        LAS float* scr = (LAS float*)(L + wave * 16384);
        constexpr float C2 = 0.125f * 1.4426950408889634f;
        constexpr int I_IN = (INPROJ_PAD / 32) * (DM / 64);
        constexpr int I_OUT = (DM / 32) * (DI / 64);
        constexpr int I_F1 = (FF2 / 32) * (DM / 64);
        constexpr int I_F2 = (DM / 32) * (FF / 64);
        constexpr int I_KQ = (2048 / 32) * (DM / 64);
        constexpr int I_V = (DM / 32) * (DM / 64);
        constexpr int NITEMS = I_IN + I_OUT + 2 * I_F1 + 2 * I_F2 + I_KQ + 2 * I_V;
        for (int it = gw; it < NITEMS; it += NGW) {
            int r = it;
            if (r < I_IN) { const int rb = r / 16, kb = r % 16, r0 = rb * 32; tr_item(ap_->in[7], INPROJ, DM, Win_t, r0, r0 < INPROJ ? r0 : -1, kb * 64, norm_w, 1.f, scr, lane); continue; } r -= I_IN;
            if (r < I_OUT) { const int rb = r / 32, kb = r % 32, r0 = rb * 32; tr_item(ap_->in[14], DM, DI, Wout_t, r0, r0, kb * 64, ap_->in[13], 1.f, scr, lane); continue; } r -= I_OUT;
            if (r < 2 * I_F1) { const int l = r / I_F1; r -= l * I_F1; const int rb = r / 16, kb = r % 16, r0 = rb * 32;
                const int c0 = ((r0 >> 7) & 1) * FF + (r0 >> 8) * 128 + (r0 & 127);
                tr_item(ap_->in[20] + (size_t)l * DM * FF2, FF2, DM, Wf1_t + (size_t)l * FF2 * DM, r0, c0, kb * 64, norm_w + (l * 4 + 2) * DM, 1.f, scr, lane); continue; } r -= 2 * I_F1;
            if (r < 2 * I_F2) { const int l = r / I_F2; r -= l * I_F2; const int rb = r / 44, kb = r % 44, r0 = rb * 32;
                tr_item(ap_->in[21] + (size_t)l * FF * DM, DM, FF, Wf2_t + (size_t)l * DM * FF, r0, r0, kb * 64, nullptr, 1.f, scr, lane); continue; } r -= 2 * I_F2;
            if (r < I_KQ) { const int rb = r / 16, kb = r % 16, r0 = rb * 32;
                if (r0 < 1024) tr_item(ap_->in[16], 2048, DM, Wkq_t, r0, r0, kb * 64, ap_->in[15], 1.f, scr, lane);
                else tr_item(ap_->in[17], DM, DM, Wkq_t, r0, r0 - 1024, kb * 64, norm_w + 4 * DM, C2, scr, lane);
                continue; } r -= I_KQ;
            if (r < I_V) { const int rb = r / 16, kb = r % 16, r0 = rb * 32; tr_item(ap_->in[16], 2048, DM, Wv_t, r0, 1024 + r0, kb * 64, ap_->in[15], 1.f, scr, lane); continue; } r -= I_V;
            { const int rb = r / 16, kb = r % 16, r0 = rb * 32; tr_item(ap_->in[19], DM, DM, Wo_t, r0, r0, kb * 64, nullptr, 1.f, scr, lane); }
        }
        for (int m = 2 * gw; m < TT; m += 2 * NGW) rms_row2_to_bf16(m < TP ? x_p + (size_t)m * DM : x_s + (size_t)(m - TP) * DM, XN + (size_t)m * DM, lane);
        for (size_t i = gtid; i < (size_t)TT * 4; i += gsz) SSQ[i] = 0.f;
    }
    __syncthreads();
    grid.sync(); STAMP();

    {
        PHASE_PTRS
        pg8::Gemm g{XN, Win_t, TT, INPROJ_PAD, DM, DM}; pg8::StaticOrder S; S.init(TT, INPROJ_PAD, G, bx);
        EpiInProj E{Z, XBC, DT, out};
        pg8::gemm_phase<EpiInProj, pg8::StaticOrder, true, true>(L, g, S, E, wave_s);
    }
    GRID_BAR();

#if PROF_K >= 0
    unsigned long long pt_last = 0ull, pt_acc0 = 0ull, pt_acc1 = 0ull, pt_acc2 = 0ull, pt_acc3 = 0ull;
#define PROF_T(k) do { const unsigned long long t_ = __builtin_amdgcn_s_memrealtime(); \
        if ((k) == 1) pt_acc0 += t_ - pt_last; else if ((k) == 2) pt_acc1 += t_ - pt_last; else if ((k) == 3) pt_acc2 += t_ - pt_last; else if ((k) == 4) pt_acc3 += t_ - pt_last; pt_last = t_; } while (0)
#define PROF_RESET() do { if (PROF_K < 70) { pt_acc0 = 0ull; pt_acc1 = 0ull; pt_acc2 = 0ull; pt_acc3 = 0ull; } } while (0)
#define PROF_TA(k) do { if (PROF_K < 70) PROF_T(k); } while (0)
#else
#define PROF_TA(k) do { } while (0)
#define PROF_T(k) do { } while (0)
#define PROF_RESET() do { } while (0)
#endif
    {
        PHASE_IDS PHASE_PTRS
        LAS bf16* XT = (LAS bf16*)(L + S_XT); LAS bf16* BT = (LAS bf16*)(L + S_BT); LAS bf16* BN = (LAS bf16*)(L + S_BN); LAS bf16* CN = (LAS bf16*)(L + S_CN);
        LAS float* CBs = (LAS float*)(L + S_CB); LAS bf16* HS = (LAS bf16*)(L + S_HS);
        LAS float* dtS = (LAS float*)(L + S_DT); LAS float* cumS = (LAS float*)(L + S_CUM); LAS float* wS = (LAS float*)(L + S_W); LAS float* cendS = (LAS float*)(L + S_CEND);
        const float* conv_w = ap_->in[8]; const float* conv_b = ap_->in[9]; const float* dt_bias = ap_->in[10]; const float* A_log = ap_->in[11]; const float* Dskip = ap_->in[12];
        const float* state_ssm = ap_->in[2]; const float* state_conv = ap_->in[3];
        const int fr = lane & 15, fq = lane >> 4, hh = wave >> 2, qd = wave & 3;
        for (int wi = bx; wi < 512; wi += G) {
            const bool smp = wi >= 256;
            const int xq = wi & 7, kq = (wi >> 3) & 31, sidx = xq * 8 + (kq >> 2), sq = sidx >> 2, grp = sidx & 3, hp = grp * 4 + (kq & 3), h0 = 2 * hp, h = h0 + hh;
            const int nchunk = smp ? 1 : 32;
            const size_t row_base = smp ? (size_t)TP + sq * 64 : (size_t)sq * 2048;
            const float Dh = Dskip[h];
            f32x4 sacc[2][4];
#pragma unroll
            for (int n2 = 0; n2 < 2; ++n2)
#pragma unroll
                for (int pt = 0; pt < 4; ++pt) {
                    const int p = 16 * pt + fr, n = 32 * qd + 16 * n2 + 4 * fq;
                    sacc[n2][pt] = smp ? *(const GAS f32x4*)(state_ssm + ((size_t)((sq * NH + h) * 64 + p)) * 128 + n) : (f32x4){0.f, 0.f, 0.f, 0.f};
                    v2u w; w.x = pk2(sacc[n2][pt][0], sacc[n2][pt][1]); w.y = pk2(sacc[n2][pt][2], sacc[n2][pt][3]);
                    *(LAS v2u*)(HS + (hh * 64 + p) * 136 + n) = w;
                }
            unsigned raw[3][11]; float dtraw = 0.f;
#define SSD_LOAD(c) do { \
              \
              \
            const __amdgpu_buffer_rsrc_t xr_ = __builtin_amdgcn_make_buffer_rsrc((void*)(XBC - 3 * CONVD), 0, (int)((size_t)(TT + 3) * CONVD * 2), 0x00020000); \
            _Pragma("unroll") for (int i = 0; i < 3; ++i) { const int it = SSD_TID + 512 * i, cp = it % 192; const int sb = __builtin_amdgcn_readfirstlane(it / 192); \
                const int col = cp < 64 ? h0 * 64 + 2 * cp : (cp < 128 ? DI + grp * 128 + 2 * (cp - 64) : DI + 512 + grp * 128 + 2 * (cp - 128)); \
                const int so0 = ((int)row_base + 64 * (c) + 8 * sb) * (CONVD * 2); \
                _Pragma("unroll") for (int r = 0; r < 11; ++r) raw[i][r] = __builtin_amdgcn_raw_buffer_load_b32(xr_, col * 2, so0 + r * (CONVD * 2), 0); } \
            if (wave < 2) dtraw = DT[(row_base + 64 * (c) + lane) * 32 + h0 + wave]; } while (0)
#define SSD_TID tid
            SSD_LOAD(0);
#undef SSD_TID
#define SSD_TID tidc
            if (!smp && tid < 192) { raw[0][0] = 0u; raw[0][1] = 0u; raw[0][2] = 0u; }
            if (smp && tid < 192) {
                const int cp = tid; const int col = cp < 64 ? h0 * 64 + 2 * cp : (cp < 128 ? DI + grp * 128 + 2 * (cp - 64) : DI + 512 + grp * 128 + 2 * (cp - 128));
#pragma unroll
                for (int r = 0; r < 3; ++r) { const float* sc = state_conv + (size_t)(sq * 3 + r) * CONVD + col; raw[0][r] = pk2(sc[0], sc[1]); } }
            for (int c = 0; c < nchunk; ++c) {
                PROF_T(0);
                int frc = fr, fqc = fq, tidc = tid; asm volatile("" : "+v"(frc), "+v"(fqc), "+v"(tidc));
                const float* cw_ = conv_w; const float* cb_ = conv_b; asm volatile("" : "+s"(cw_), "+s"(cb_));
#pragma unroll
                for (int i = 0; i < 3; ++i) { const int it = tidc + 512 * i, cp = it % 192, sb = it / 192, typ = cp >> 6, cl = 2 * (cp & 63);
                    const int col = cp < 64 ? h0 * 64 + 2 * cp : (cp < 128 ? DI + grp * 128 + 2 * (cp - 64) : DI + 512 + grp * 128 + 2 * (cp - 128));
                    float w0[4], w1[4];
#pragma unroll
                    for (int k = 0; k < 4; ++k) { w0[k] = cw_[k * CONVD + col]; w1[k] = cw_[k * CONVD + col + 1]; }
                    const float b0 = cb_[col], b1 = cb_[col + 1];
                    float o0[8], o1[8];
#pragma unroll
                    for (int s = 0; s < 8; ++s) { float a0 = b0, a1 = b1;
#pragma unroll
                        for (int k = 0; k < 4; ++k) { const unsigned uu = raw[i][s + k]; a0 += w0[k] * bflo(uu); a1 += w1[k] * bfhi(uu); }
                        o0[s] = silu_f(a0); o1[s] = silu_f(a1); }
                    if (typ == 0) { *(LAS bf16x8*)(XT + cl * 72 + 8 * sb) = pack8(o0); *(LAS bf16x8*)(XT + (cl + 1) * 72 + 8 * sb) = pack8(o1); }
                    else if (typ == 1) { *(LAS bf16x8*)(BT + cl * 72 + 8 * sb) = pack8(o0); *(LAS bf16x8*)(BT + (cl + 1) * 72 + 8 * sb) = pack8(o1);
#pragma unroll
                        for (int s = 0; s < 8; ++s) *(LAS unsigned*)(BN + (8 * sb + s) * 136 + cl) = pk2(o0[s], o1[s]); }
                    else {
#pragma unroll
                        for (int s = 0; s < 8; ++s) *(LAS unsigned*)(CN + (8 * sb + s) * 136 + cl) = pk2(o0[s], o1[s]); }
                }
                if (wave < 2) { const int hd = h0 + wave;
                    const float xx = dtraw + dt_bias[hd];
                    const float dtv = fmaxf(xx, 0.f) + __logf(1.f + __expf(-fabsf(xx)));
                    const float Ah = -__expf(A_log[hd]);
                    const float cum = wave_scan_incl(dtv * Ah);
                    const float cend = __builtin_bit_cast(float, __builtin_amdgcn_readlane(__builtin_bit_cast(int, cum), 63));
                    dtS[wave * 64 + lane] = dtv; cumS[wave * 64 + lane] = cum; wS[wave * 64 + lane] = dtv * __expf(cend - cum);
                    if (lane == 63) cendS[wave] = cend; }
                __syncthreads();
                PROF_T(1);
                if (c + 1 < nchunk) SSD_LOAD(c + 1);
                v2u zpre[4];
                { const size_t mz = row_base + 64 * c + 16 * qd + frc; const bf16* zp0 = Z + mz * DI + h * 64 + 4 * fqc;
#pragma unroll
                  for (int pt = 0; pt < 4; ++pt) zpre[pt] = *(const GAS v2u*)(zp0 + 16 * pt); }
                PROF_T(2);
                bf16x8 xt[4][2];
#pragma unroll
                for (int pt = 0; pt < 4; ++pt)
#pragma unroll
                    for (int ks = 0; ks < 2; ++ks) xt[pt][ks] = *(const LAS bf16x8*)(XT + (hh * 64 + 16 * pt + frc) * 72 + 8 * fqc + 32 * ks);
                { f32x4 yacc[4], cbacc[4];
#pragma unroll
                    for (int pt = 0; pt < 4; ++pt) { yacc[pt] = (f32x4){0.f, 0.f, 0.f, 0.f}; cbacc[pt] = (f32x4){0.f, 0.f, 0.f, 0.f}; }
                    const int q = 16 * qd + frc;
#pragma unroll
                    for (int ks = 0; ks < 4; ++ks) { const bf16x8 bfr = *(const LAS bf16x8*)(CN + q * 136 + 8 * fqc + 32 * ks);
#pragma unroll
                        for (int pt = 0; pt < 4; ++pt) { const bf16x8 af = *(const LAS bf16x8*)(HS + (hh * 64 + 16 * pt + frc) * 136 + 8 * fqc + 32 * ks); yacc[pt] = MFMA16(af, bfr, yacc[pt]); }
#pragma unroll
                        for (int st = 0; st < 4; ++st) { const bf16x8 af = *(const LAS bf16x8*)(BN + (16 * st + frc) * 136 + 8 * fqc + 32 * ks); cbacc[st] = MFMA16(af, bfr, cbacc[st]); } }
                    const float cq = cumS[hh * 64 + q]; const float eq = __expf(cq);
#pragma unroll
                    for (int pt = 0; pt < 4; ++pt) yacc[pt] = yacc[pt] * eq;
#pragma unroll
                    for (int ks = 0; ks < 2; ++ks) {
                        float mv[8];
#pragma unroll
                        for (int hf = 0; hf < 2; ++hf) { const int s0 = 16 * (2 * ks + hf) + 4 * fqc;
                            const f32x4 cs = *(const LAS f32x4*)(cumS + hh * 64 + s0), dd = *(const LAS f32x4*)(dtS + hh * 64 + s0); const f32x4 cb = cbacc[2 * ks + hf];
#pragma unroll
                            for (int e = 0; e < 4; ++e) { const int s = s0 + e; float t = cb[e] * __expf(fminf(cq - cs[e], 0.f)) * dd[e]; t = (s <= q) ? t : 0.f; if (s == q) t += Dh; mv[4 * hf + e] = t; } }
                        const bf16x8 mf = pack8(mv);
#pragma unroll
                        for (int pt = 0; pt < 4; ++pt) { const LAS bf16* xp = XT + (hh * 64 + 16 * pt + frc) * 72 + 32 * ks + 4 * fqc;
                            const v2u x0 = *(const LAS v2u*)xp, x1 = *(const LAS v2u*)(xp + 16); const v4u xa = {x0.x, x0.y, x1.x, x1.y};
                            yacc[pt] = MFMA16(__builtin_bit_cast(bf16x8, xa), mf, yacc[pt]); } }
                    const size_t m = row_base + 64 * c + q;
                    bf16* zp = Z + m * DI + h * 64 + 4 * fqc; float ss = 0.f;
#pragma unroll
                    for (int pt = 0; pt < 4; ++pt) { const v2u zz = zpre[pt];
                        const float y0 = yacc[pt][0] * silu_f(bflo(zz.x)), y1 = yacc[pt][1] * silu_f(bfhi(zz.x)), y2 = yacc[pt][2] * silu_f(bflo(zz.y)), y3 = yacc[pt][3] * silu_f(bfhi(zz.y));
                        ss += (y0 * y0 + y1 * y1) + (y2 * y2 + y3 * y3);
                        v2u o; o.x = pk2(y0, y1); o.y = pk2(y2, y3); *(GAS v2u*)(zp + 16 * pt) = o; }
                    ss += __shfl_xor(ss, 16); ss += __shfl_xor(ss, 32);
                    if (fqc == 0) atomicAdd(SSQ + m * 4 + grp, ss);
                }
                PROF_T(3);
                { const float dec = __expf(cendS[hh]);
#pragma unroll
                    for (int n2 = 0; n2 < 2; ++n2)
#pragma unroll
                        for (int pt = 0; pt < 4; ++pt) sacc[n2][pt] = sacc[n2][pt] * dec;
#pragma unroll
                    for (int ks = 0; ks < 2; ++ks) { const int s0 = 8 * fqc + 32 * ks;
                        const f32x4 w0 = *(const LAS f32x4*)(wS + hh * 64 + s0), w1 = *(const LAS f32x4*)(wS + hh * 64 + s0 + 4);
#pragma unroll
                        for (int n2 = 0; n2 < 2; ++n2) { const v4u rw = *(const LAS v4u*)(BT + (32 * qd + 16 * n2 + frc) * 72 + s0);
                            float bv[8]; bv[0] = bflo(rw.x) * w0[0]; bv[1] = bfhi(rw.x) * w0[1]; bv[2] = bflo(rw.y) * w0[2]; bv[3] = bfhi(rw.y) * w0[3];
                            bv[4] = bflo(rw.z) * w1[0]; bv[5] = bfhi(rw.z) * w1[1]; bv[6] = bflo(rw.w) * w1[2]; bv[7] = bfhi(rw.w) * w1[3];
                            const bf16x8 af = pack8(bv);
#pragma unroll
                            for (int pt = 0; pt < 4; ++pt) sacc[n2][pt] = MFMA16(af, xt[pt][ks], sacc[n2][pt]); } }
                }
                __syncthreads();
                PROF_T(4);
#pragma unroll
                for (int n2 = 0; n2 < 2; ++n2)
#pragma unroll
                    for (int pt = 0; pt < 4; ++pt) { v2u w; w.x = pk2(sacc[n2][pt][0], sacc[n2][pt][1]); w.y = pk2(sacc[n2][pt][2], sacc[n2][pt][3]);
                        *(LAS v2u*)(HS + (hh * 64 + 16 * pt + frc) * 136 + 32 * qd + 16 * n2 + 4 * fqc) = w; }
            }
#undef SSD_LOAD
#undef SSD_TID
            { float* so = out + (smp ? O_SSM_S : O_SSM_P);
#pragma unroll
                for (int n2 = 0; n2 < 2; ++n2)
#pragma unroll
                    for (int pt = 0; pt < 4; ++pt) *(GAS f32x4*)(so + ((size_t)((sq * NH + h) * 64 + 16 * pt + fr)) * 128 + 32 * qd + 16 * n2 + 4 * fq) = sacc[n2][pt]; }
        }
    }
    GRID_BAR();

#define GEMM1024_NORM(EPI, EPIARGS_P, EPIARGS_S, APTR, BTPTR, KDIM, FIRST, LAST, WPOST, SPLIT, SEAM) do { \
        { PHASE_PTRS pg8::Gemm g{(APTR), (BTPTR), TP, DM, (KDIM), (KDIM)}; pg8::StaticOrder S; S.init(TP, DM, G, bx); EPI E EPIARGS_P; \
          pg8::gemm_phase<EPI, pg8::StaticOrder, true, true>(L, g, S, E, wave_s); } \
        GRID_BAR(); \
        const int nsw = (SPLIT) ? 32 : 16;          \
        if (bx < nsw) { \
          { PHASE_PTRS \
          if (SPLIT) { pg8::Gemm g{(APTR) + (size_t)TP * (KDIM), (BTPTR), TS, DM, (KDIM) / 2, (KDIM)}; pg8::SplitOrder2 S{bx, (long)(KDIM)}; EpiSlab E{SLAB}; \
            pg8::gemm_phase<EpiSlab, pg8::SplitOrder2, true, true>(L, g, S, E, wave_s); } \
          else { pg8::Gemm g{(APTR) + (size_t)TP * (KDIM), (BTPTR), TS, DM, (KDIM), (KDIM)}; pg8::StaticOrder S; S.init(TS, DM, G, bx); EPI E EPIARGS_S; \
            pg8::gemm_phase<EPI, pg8::StaticOrder, true, true>(L, g, S, E, wave_s); } } \
            \
          { PHASE_IDS PHASE_PTRS \
            asm volatile("s_waitcnt vmcnt(0)" ::: "memory"); __syncthreads(); \
            if (tid == 0) { unsigned* cnt = (unsigned*)(ws + WS_CTL) + 8192 + 64 * (SEAM); \
              __builtin_amdgcn_fence(__ATOMIC_RELEASE, "agent"); asm volatile("s_waitcnt vmcnt(0)" ::: "memory"); \
              __hip_atomic_fetch_add(cnt, 1u, __ATOMIC_RELAXED, __HIP_MEMORY_SCOPE_AGENT); } } } \
        else { PHASE_IDS PHASE_PTRS const int gw2 = (bx - nsw) * NWAVES + wave, NGW2 = (G - nsw) * NWAVES; \
          for (int m = 2 * gw2; m < TP; m += 2 * NGW2) norm_row2(MB + (size_t)m * DM, nullptr, (FIRST) ? x_p + (size_t)m * DM : nullptr, XN + (size_t)m * DM, SQ + m, (LAST) ? out + O_Y + (size_t)m * DM : nullptr, (WPOST), lane); \
            \
          if (tid == 0) { unsigned* cnt = (unsigned*)(ws + WS_CTL) + 8192 + 64 * (SEAM); unsigned sp = 0; \
            while (__hip_atomic_load(cnt, __ATOMIC_RELAXED, __HIP_MEMORY_SCOPE_AGENT) < (unsigned)nsw) { __builtin_amdgcn_s_sleep(2); if (++sp > (1u << 22)) break; } \
            __builtin_amdgcn_fence(__ATOMIC_ACQUIRE, "agent"); asm volatile("s_waitcnt vmcnt(0)" ::: "memory"); } \
          __syncthreads(); \
          for (int m = TP + 2 * gw2; m < TT; m += 2 * NGW2) norm_row2(MB + (size_t)m * DM, (SPLIT) ? SLAB + (size_t)(m - TP) * DM : nullptr, (FIRST) ? x_s + (size_t)(m - TP) * DM : nullptr, XN + (size_t)m * DM, SQ + m, (LAST) ? out + O_Y + (size_t)m * DM : nullptr, (WPOST), lane); } \
    } while (0)
    GEMM1024_NORM(EpiOutProj, ({MB, DM, SSQ}), ({MB + (size_t)TP * DM, DM, SSQ + (size_t)TP * 4}), Z, Wout_t, DI, true, false, norm_w + 1 * DM, false, 0);
    GRID_BAR();

    { constexpr int layer = 0;
        { PHASE_PTRS pg8::Gemm g{XN, Wf1_t + (size_t)layer * FF2 * DM, TT, FF2, DM, DM}; pg8::StaticOrder S; S.init(TT, FF2, G, bx); EpiSwiGLU E{HB};
          pg8::gemm_phase<EpiSwiGLU, pg8::StaticOrder, true, true>(L, g, S, E, wave_s); }
        GRID_BAR();
        GEMM1024_NORM(EpiPlain, ({MB, DM}), ({MB + (size_t)TP * DM, DM}), HB, Wf2_t + (size_t)layer * DM * FF, FF, false, layer == 1, norm_w + (layer * 4 + 3) * DM, true, 2 + layer);
        if (layer == 0) GRID_BAR();
        }
    { constexpr int layer = 1;
        {
            { PHASE_PTRS pg8::Gemm g{XN, Wkq_t, TT, 2048, DM, DM};
              pg8::KqvtOrder S; S.G = G; S.c = bx; S.dA = (const char*)Wv_t - (const char*)XN; S.dB = (const char*)XN - (const char*)Wkq_t;
              EpiKQVT E{{KHp, QHp, KHs, QHs, out}, {VTp, VTs, out}, (float*)MB};
              pg8::gemm_phase<EpiKQVT, pg8::KqvtOrder, true, true>(L, g, S, E, wave_s); }
            GRID_BAR();
            {
                PHASE_IDS PHASE_PTRS
                LAS bf16* KsB = (LAS bf16*)L;
                LAS bf16* VsB = (LAS bf16*)(L + 18432);
                LAS float* biasL = (LAS float*)(L + 36864);
                PROF_RESET();
                const float* rel_bias = ap_->in[18];
                for (int i = tid; i < AH * 641; i += NTHREADS) { const int h = i / 641, j = i - h * 641; biasL[i] = rel_bias[h * 513 + (j > 512 ? 512 : j)] * 1.4426950408889634f; }
                __syncthreads();
                const int r32 = lane & 31, hi = lane >> 5;
                const int krow = (r32 & 0x13) | ((r32 & 4) << 1) | ((r32 & 8) >> 1);
                const int srow = tid >> 3, sch = tid & 7;
#define ATTN_DECODE(P, uu) const bool P##smp = (uu) >= 2048; const int P##idx = (uu) & 255, P##b = P##idx >> 4, P##hd = P##idx & 15, P##c0 = P##smp ? 8 : 4 * ((uu) >> 8); \
                const int P##kt_lo = P##c0 > 8 ? P##c0 - 8 : 0, P##Lk = P##smp ? SKV : 2048; \
                const bf16* P##KHb = P##smp ? KHs + (size_t)((P##b * AH + P##hd) * SKV) * 64 : KHp + (size_t)((P##b * AH + P##hd) * 2048) * 64; \
                const bf16* P##VTb = P##smp ? VTs + (size_t)((P##b * AH + P##hd) * 64) * SKV : VTp + (size_t)((P##b * AH + P##hd) * 64) * 2048; \
                const int P##pos0 = P##smp ? 32 * (wave & 1) : 64 * P##c0 + 32 * wave; \
                const bf16* P##Qb = P##smp ? QHs + (size_t)((P##b * AH + P##hd) * 64 + P##pos0) * 64 : QHp + (size_t)((P##b * AH + P##hd) * 2048 + P##pos0) * 64;
                { const float* cache_k = ap_->in[4]; const float* cache_v = ap_->in[5];
                  for (int u = bx; u < 2304; u += G) if (u >= 2048) { const int idx = u & 255, b = idx >> 4, hd = idx & 15;
                      { const int d8 = tid & 7, r0 = tid >> 3; f32x4 kv[8][2]; float vv[4][8];
#pragma unroll
                        for (int it = 0; it < 8; ++it) { const float* s = cache_k + ((size_t)((b * 512 + r0 + 64 * it) * 16 + hd)) * 64 + 8 * d8;
                            kv[it][0] = __builtin_nontemporal_load((const GAS f32x4*)s); kv[it][1] = __builtin_nontemporal_load((const GAS f32x4*)(s + 4)); }
#pragma unroll
                        for (int j = 0; j < 4; ++j)
#pragma unroll
                            for (int e = 0; e < 8; ++e) vv[j][e] = __builtin_nontemporal_load((const GAS float*)(cache_v + ((size_t)((b * 512 + 8 * (wave + 8 * j) + e) * 16 + hd)) * 64 + lane));
#pragma unroll
                        for (int it = 0; it < 8; ++it) { const f32x4 v0 = kv[it][0], v1 = kv[it][1];
                            v4u w; w.x = pk2(v0[0], v0[1]); w.y = pk2(v0[2], v0[3]); w.z = pk2(v1[0], v1[1]); w.w = pk2(v1[2], v1[3]);
                            *(GAS v4u*)(KHs + ((size_t)((b * AH + hd) * SKV + r0 + 64 * it)) * 64 + 8 * d8) = w; }
#pragma unroll
                        for (int j = 0; j < 4; ++j) { v4u w; w.x = pk2(vv[j][0], vv[j][1]); w.y = pk2(vv[j][2], vv[j][3]); w.z = pk2(vv[j][4], vv[j][5]); w.w = pk2(vv[j][6], vv[j][7]);
                            *(GAS v4u*)(VTs + ((size_t)((b * AH + hd) * 64 + lane)) * SKV + 8 * (wave + 8 * j)) = w; } }
                      { const float* sl = (const float*)MB; const int r = tid >> 3, c8 = tid & 7; float vv[4][8];
                        const float* pk = sl + (size_t)(b * 64 + r) * 3072 + hd * 64 + 8 * c8; const float* pv = sl + (size_t)(hd * 64 + r) * 3072 + 2048 + b * 64 + 8 * c8;
                        f32x4 sk[4][2], sq4[4][2], sv[4][2];
#pragma unroll
                        for (int j = 0; j < 4; ++j)
#pragma unroll
                            for (int e = 0; e < 8; ++e) vv[j][e] = __builtin_nontemporal_load((const GAS float*)(cache_v + ((size_t)((b * 512 + 8 * (wave + 8 * (j + 4)) + e) * 16 + hd)) * 64 + lane));
#pragma unroll
                        for (int s4 = 0; s4 < 4; ++s4) { const float* a = pk + s4 * KQS_SLAB; const float* c = pv + s4 * KQS_SLAB;
                            sk[s4][0] = *(const GAS f32x4*)a; sk[s4][1] = *(const GAS f32x4*)(a + 4); sq4[s4][0] = *(const GAS f32x4*)(a + 1024); sq4[s4][1] = *(const GAS f32x4*)(a + 1028);
                            sv[s4][0] = *(const GAS f32x4*)c; sv[s4][1] = *(const GAS f32x4*)(c + 4); }
#pragma unroll
                        for (int j = 0; j < 4; ++j) { v4u w; w.x = pk2(vv[j][0], vv[j][1]); w.y = pk2(vv[j][2], vv[j][3]); w.z = pk2(vv[j][4], vv[j][5]); w.w = pk2(vv[j][6], vv[j][7]);
                            *(GAS v4u*)(VTs + ((size_t)((b * AH + hd) * 64 + lane)) * SKV + 8 * (wave + 8 * (j + 4))) = w; }
                        const f32x4 k0 = (sk[0][0] + sk[1][0]) + (sk[2][0] + sk[3][0]), k1 = (sk[0][1] + sk[1][1]) + (sk[2][1] + sk[3][1]);
                        const f32x4 q0 = (sq4[0][0] + sq4[1][0]) + (sq4[2][0] + sq4[3][0]), q1 = (sq4[0][1] + sq4[1][1]) + (sq4[2][1] + sq4[3][1]);
                        const f32x4 v0 = (sv[0][0] + sv[1][0]) + (sv[2][0] + sv[3][0]), v1 = (sv[0][1] + sv[1][1]) + (sv[2][1] + sv[3][1]);
                        v4u w; w.x = pk2(k0[0], k0[1]); w.y = pk2(k0[2], k0[3]); w.z = pk2(k1[0], k1[1]); w.w = pk2(k1[2], k1[3]);
                        *(GAS v4u*)(KHs + ((size_t)((b * AH + hd) * SKV + 512 + r)) * 64 + 8 * c8) = w;
                        { float* o = out + O_CK_S + (size_t)(b * 64 + r) * 1024 + hd * 64 + 8 * c8; *(GAS f32x4*)o = k0; *(GAS f32x4*)(o + 4) = k1; }
                        w.x = pk2(q0[0], q0[1]); w.y = pk2(q0[2], q0[3]); w.z = pk2(q1[0], q1[1]); w.w = pk2(q1[2], q1[3]);
                        *(GAS v4u*)(QHs + ((size_t)((b * AH + hd) * 64 + r)) * 64 + 8 * c8) = w;
                        w.x = pk2(v0[0], v0[1]); w.y = pk2(v0[2], v0[3]); w.z = pk2(v1[0], v1[1]); w.w = pk2(v1[2], v1[3]);
                        *(GAS v4u*)(VTs + ((size_t)((b * AH + hd) * 64 + r)) * SKV + 512 + 8 * c8) = w;
                        LAS float* tt = (LAS float*)(L + 81920);
#pragma unroll
                        for (int e = 0; e < 4; ++e) { tt[(8 * c8 + e) * 65 + r] = v0[e]; tt[(8 * c8 + 4 + e) * 65 + r] = v1[e]; }
                        __syncthreads();
                        f32x4 o0, o1;
#pragma unroll
                        for (int e = 0; e < 4; ++e) { o0[e] = tt[r * 65 + 8 * c8 + e]; o1[e] = tt[r * 65 + 8 * c8 + 4 + e]; }
                        float* o = out + O_CV_S + (size_t)(b * 64 + r) * 1024 + hd * 64 + 8 * c8; *(GAS f32x4*)o = o0; *(GAS f32x4*)(o + 4) = o1; } }
                  asm volatile("s_waitcnt vmcnt(0)" ::: "memory"); __syncthreads(); }
                bf16x8 qf[4]; v4u kreg, vreg;
                { ATTN_DECODE(F, bx)
#pragma unroll
                  for (int ks = 0; ks < 4; ++ks) qf[ks] = *(const GAS bf16x8*)(FQb + r32 * 64 + 8 * hi + 16 * ks);
                  kreg = *(const GAS v4u*)(FKHb + (size_t)(64 * Fkt_lo + srow) * 64 + 8 * sch); vreg = *(const GAS v4u*)(FVTb + (size_t)srow * FLk + 64 * Fkt_lo + 8 * sch); }
                for (int u = bx; u < 2304; u += G) {
                    ATTN_DECODE(U, u)
                    const int kt_lo = Ukt_lo, kt_hi = Usmp ? 8 : Uc0 + 3, hd = Uhd;
                    const bool active = Usmp ? (wave < 2) : true; const int cw = Usmp ? 8 : Uc0 + (wave >> 1);
                    const size_t m0 = Usmp ? (size_t)TP + Ub * 64 + Upos0 : (size_t)Ub * 2048 + Upos0;
                    const int qloc = (Usmp ? 512 + Upos0 : Upos0) + r32;
                    const int kt_first = cw - 8 > kt_lo ? cw - 8 : kt_lo;
                    const bool hasN = u + G < 2304;
                    bf16x8 qn[4];
                    float m_run = 0.f, l_run = 0.f; f32x16 o0, o1;
#pragma unroll
                    for (int r = 0; r < 16; ++r) { o0[r] = 0.f; o1[r] = 0.f; }
                    *(LAS v4u*)(KsB + srow * 72 + 8 * sch) = kreg;
                    *(LAS v4u*)(VsB + srow * 72 + 8 * sch) = vreg;
                    __syncthreads();
                    if (hasN) { ATTN_DECODE(M, u + G)
#pragma unroll
                        for (int ks = 0; ks < 4; ++ks) qn[ks] = *(const GAS bf16x8*)(MQb + r32 * 64 + 8 * hi + 16 * ks); }
                    for (int kt = kt_lo; kt <= kt_hi; ++kt) {
                        PROF_TA(0);
                        const int buf = (kt - kt_lo) & 1;
                        if (kt < kt_hi) { kreg = *(const GAS v4u*)(UKHb + (size_t)(64 * (kt + 1) + srow) * 64 + 8 * sch); vreg = *(const GAS v4u*)(UVTb + (size_t)srow * ULk + 64 * (kt + 1) + 8 * sch); }
                        else if (hasN) {
                            ATTN_DECODE(N, u + G)
                            kreg = *(const GAS v4u*)(NKHb + (size_t)(64 * Nkt_lo + srow) * 64 + 8 * sch); vreg = *(const GAS v4u*)(NVTb + (size_t)srow * NLk + 64 * Nkt_lo + 8 * sch); (void)NQb; }
                        if (active && kt <= cw && kt + 8 >= cw) {
                            const LAS bf16* Ks = KsB + buf * (64 * 72); const LAS bf16* Vs = VsB + buf * (64 * 72);
                            f32x16 p0, p1; const float nm = -m_run; const int jj = cw - kt;
                            const bf16x8 a00 = *(const LAS bf16x8*)(Ks + krow * 72 + 8 * hi), a10 = *(const LAS bf16x8*)(Ks + (32 + krow) * 72 + 8 * hi);
                            if (jj >= 5) { const float bc = biasL[hd * 641 + 512] + nm; f32x16 bcv;
#pragma unroll
                                for (int r = 0; r < 16; ++r) bcv[r] = bc;
                                p0 = MFMA32(a00, qf[0], bcv); p1 = MFMA32(a10, qf[0], bcv); }
                            else { const int base = qloc - 64 * kt - 8 * hi + 256;
                                const LAS float* blp = biasL + hd * 641 + base - 63;
                                const f32x2_t nm2 = {nm, nm};
#define ATT_BINIT(r) { f32x2_t t0 = {blp[63 - (16 * ((r) >> 3) + ((r) & 7))], blp[62 - (16 * ((r) >> 3) + ((r) & 7))]}, t1 = {blp[31 - (16 * ((r) >> 3) + ((r) & 7))], blp[30 - (16 * ((r) >> 3) + ((r) & 7))]}; \
                                    t0 += nm2; t1 += nm2; p0[r] = t0[0]; p0[(r) + 1] = t0[1]; p1[r] = t1[0]; p1[(r) + 1] = t1[1]; }
                                ATT_BINIT(0) ATT_BINIT(2) ATT_BINIT(4) ATT_BINIT(6) ATT_BINIT(8) ATT_BINIT(10) ATT_BINIT(12) ATT_BINIT(14)
#undef ATT_BINIT
                                p0 = MFMA32(a00, qf[0], p0); p1 = MFMA32(a10, qf[0], p1); }
#pragma unroll
                            for (int ks = 1; ks < 4; ++ks) { const bf16x8 a0 = *(const LAS bf16x8*)(Ks + krow * 72 + 8 * hi + 16 * ks), a1 = *(const LAS bf16x8*)(Ks + (32 + krow) * 72 + 8 * hi + 16 * ks);
                                p0 = MFMA32(a0, qf[ks], p0); p1 = MFMA32(a1, qf[ks], p1); }
                            asm volatile("s_nop 11" : "+v"(p0), "+v"(p1));
                            float mx = max3f_(p0[0], p1[0], p0[1]), mxb = max3f_(p1[1], p0[2], p1[2]);
#pragma unroll
                            for (int r = 3; r < 15; r += 2) { mx = max3f_(mx, p0[r], p1[r]); mxb = max3f_(mxb, p0[r + 1], p1[r + 1]); }
                            mx = max3f_(mx, mxb, p0[15]); mx = max3f_(mx, p1[15], p1[15]);
                            { const auto rr = __builtin_amdgcn_permlane32_swap(__builtin_bit_cast(unsigned, mx), __builtin_bit_cast(unsigned, mx), false, false);
                              const float ma = __builtin_bit_cast(float, (unsigned)rr[0]), mb = __builtin_bit_cast(float, (unsigned)rr[1]); mx = max3f_(ma, mb, mb); }
                            const bool first = (kt == kt_first);
                            if (first) {
                                m_run = mx;
#pragma unroll
                                for (int r = 0; r < 16; ++r) { p0[r] -= mx; p1[r] -= mx; } }
#pragma unroll
                            for (int r = 0; r < 16; ++r) { p0[r] = __builtin_amdgcn_exp2f(p0[r]); p1[r] = __builtin_amdgcn_exp2f(p1[r]); }
                            f32x2_t ls2 = __builtin_shufflevector(p0, p0, 0, 1) + __builtin_shufflevector(p1, p1, 0, 1);
#define ATT_PKSUM(r) ls2 += __builtin_shufflevector(p0, p0, r, r + 1); ls2 += __builtin_shufflevector(p1, p1, r, r + 1);
                            ATT_PKSUM(2) ATT_PKSUM(4) ATT_PKSUM(6) ATT_PKSUM(8) ATT_PKSUM(10) ATT_PKSUM(12) ATT_PKSUM(14)
#undef ATT_PKSUM
                            l_run += ls2[0] + ls2[1];
                            bf16x8 pb[4];
                            { float t[8];
#pragma unroll
                              for (int j = 0; j < 8; ++j) t[j] = p0[j];
                              pb[0] = pack8(t);
#pragma unroll
                              for (int j = 0; j < 8; ++j) t[j] = p0[8 + j];
                              pb[1] = pack8(t);
#pragma unroll
                              for (int j = 0; j < 8; ++j) t[j] = p1[j];
                              pb[2] = pack8(t);
#pragma unroll
                              for (int j = 0; j < 8; ++j) t[j] = p1[8 + j];
                              pb[3] = pack8(t); }
#pragma unroll
                            for (int s4 = 0; s4 < 4; ++s4) {
                                const bf16x8 A0 = *(const LAS bf16x8*)(Vs + r32 * 72 + 16 * s4 + 8 * hi), A1 = *(const LAS bf16x8*)(Vs + (32 + r32) * 72 + 16 * s4 + 8 * hi);
                                o0 = MFMA32(A0, pb[s4], o0); o1 = MFMA32(A1, pb[s4], o1); }
                            if (!first && __any(mx > 8.f)) { const float dl = fmaxf(mx, 0.f), alpha = __builtin_amdgcn_exp2f(-dl); m_run += dl; l_run *= alpha;
#pragma unroll
                                for (int r = 0; r < 16; ++r) { o0[r] *= alpha; o1[r] *= alpha; } }
                        }
                        PROF_TA(1);
                        if (kt < kt_hi) { LAS bf16* Kn = KsB + (buf ^ 1) * (64 * 72); LAS bf16* Vn = VsB + (buf ^ 1) * (64 * 72);
                            *(LAS v4u*)(Kn + srow * 72 + 8 * sch) = kreg;
                            *(LAS v4u*)(Vn + srow * 72 + 8 * sch) = vreg; }
                        PROF_TA(2);
                        __syncthreads();
                        PROF_TA(3);
                    }
                    if (active) {
                        const float inv = 1.f / xor32_sum_(l_run);
                        bf16* op = AO + (m0 + r32) * DM + hd * 64 + 4 * hi;
#pragma unroll
                        for (int r4 = 0; r4 < 4; ++r4) { v2u w; w.x = pk2(o0[4 * r4] * inv, o0[4 * r4 + 1] * inv); w.y = pk2(o0[4 * r4 + 2] * inv, o0[4 * r4 + 3] * inv); *(GAS v2u*)(op + 8 * r4) = w;
                            v2u w2; w2.x = pk2(o1[4 * r4] * inv, o1[4 * r4 + 1] * inv); w2.y = pk2(o1[4 * r4 + 2] * inv, o1[4 * r4 + 3] * inv); *(GAS v2u*)(op + 32 + 8 * r4) = w2; }
                    }
                    if (hasN) {
#pragma unroll
                        for (int ks = 0; ks < 4; ++ks) qf[ks] = qn[ks]; }
                }
#undef ATTN_DECODE
            }
            GRID_BAR();
            GEMM1024_NORM(EpiPlain, ({MB, DM}), ({MB + (size_t)TP * DM, DM}), AO, Wo_t, DM, false, false, norm_w + (4 + 1) * DM, false, 1);
            GRID_BAR();
        }
        { PHASE_PTRS pg8::Gemm g{XN, Wf1_t + (size_t)layer * FF2 * DM, TT, FF2, DM, DM}; pg8::StaticOrder S; S.init(TT, FF2, G, bx); EpiSwiGLU E{HB};
          pg8::gemm_phase<EpiSwiGLU, pg8::StaticOrder, true, true>(L, g, S, E, wave_s); }
        GRID_BAR();
        GEMM1024_NORM(EpiPlain, ({MB, DM}), ({MB + (size_t)TP * DM, DM}), HB, Wf2_t + (size_t)layer * DM * FF, FF, false, layer == 1, norm_w + (layer * 4 + 3) * DM, true, 2 + layer);
        if (layer == 0) GRID_BAR();
        }
#if PROF_K >= 0
    {
        PHASE_IDS PHASE_PTRS
        STAMP();
        LAS float* fs = (LAS float*)(L + MISC_OFF + 512);
        __syncthreads();
        if (tid == 0) { volatile LAS unsigned long long* ts = (volatile LAS unsigned long long*)(MISC + 8); const int k0 = PROF_K % 100;
            const unsigned long long d = (k0 == 50) ? ts[n_stamp - 1] - ts[0] : (k0 == 60 || k0 == 70) ? pt_acc0 : (k0 == 61 || k0 == 71) ? pt_acc1 : (k0 == 62 || k0 == 72) ? pt_acc2 : (k0 == 63 || k0 == 73) ? pt_acc3 : ts[k0 + 1] - ts[k0]; fs[0] = 1.f + (float)d * 0.01f * (PROF_K >= 100 ? 1e-4f : 5e-4f); }
        __syncthreads();
        const float f = fs[0];
        GRID_BAR();
        for (size_t i = gtid; i < 1048576; i += gsz) out[O_CV_S + i] *= f;
    }
#endif
}

extern "C" void kernel_launch(void* const* d_in, const int* in_sizes, int n_in, void* d_out, int out_size, void* d_ws, size_t ws_size, hipStream_t stream) {
    static int grid = 0;
    if (grid == 0) {
        int dev = 0, cus = 0, per_cu = 0;
        (void)hipGetDevice(&dev);
        (void)hipDeviceGetAttribute(&cus, hipDeviceAttributeMultiprocessorCount, dev);
        (void)hipFuncSetAttribute((const void*)mk_fwd, hipFuncAttributeMaxDynamicSharedMemorySize, LDS_BYTES);
        (void)hipOccupancyMaxActiveBlocksPerMultiprocessor(&per_cu, (const void*)mk_fwd, NTHREADS, LDS_BYTES);
        fprintf(stderr, "kernel_launch: cus %d per_cu %d ws_size %zu n_in %d out_size %d\n", cus, per_cu, ws_size, n_in, out_size);
        if (ws_size < WS_END3 || n_in != 22 || (size_t)out_size != O_TOTAL) { fprintf(stderr, "kernel_launch: unexpected sizes\n"); grid = -1; return; }
        grid = cus;
    }
    if (grid < 0) return;
    (void)hipMemsetAsync((char*)d_ws + WS_CTL, 0, 1 * MiB, stream);
    Args a{};
    for (int i = 0; i < 22; ++i) a.in[i] = (const float*)d_in[i];
    a.out = (float*)d_out; a.ws = (unsigned char*)d_ws; a.dbg = 0; a.pad = 0;
    void* args[] = {&a};
    hipError_t e = hipLaunchCooperativeKernel((const void*)mk_fwd, dim3(grid), dim3(NTHREADS), args, LDS_BYTES, stream);
    if (e != hipSuccess) fprintf(stderr, "cooperative launch failed: %s (grid %d)\n", hipGetErrorString(e), grid);
}
```

```cpp
#include <hip/hip_runtime.h>
#include <hip/hip_cooperative_groups.h>
#include <cstdio>
#include <cstdint>
namespace cg = cooperative_groups;
#define PROF_K (-1)

__device__ __forceinline__ int fresh_lane() { unsigned z = 0u; asm volatile("" : "+v"(z)); return (int)__builtin_amdgcn_mbcnt_hi(~0u, __builtin_amdgcn_mbcnt_lo(~0u, z)); }
namespace pg8 {
#define PG8_LAS __attribute__((address_space(3)))
typedef unsigned short bf16_t;
typedef short bf16x8 __attribute__((ext_vector_type(8)));
typedef float f32x4 __attribute__((ext_vector_type(4)));
typedef unsigned u32x4 __attribute__((ext_vector_type(4)));
constexpr int BM = 256, BK = 64, HALF = 128, HTB = HALF * BK * 2, STAGE_BYTES = 8 * HTB, NXCD = 8, WGM = 8;

__host__ __device__ __forceinline__ int lds_byte(int r, int c) { const int st = (r >> 4) * 2 + (c >> 5), rr = r & 15, cc = c & 31, ob = rr * 64 + cc * 2; return st * 1024 + (ob ^ (((ob >> 9) & 1) << 5)); }
__host__ __device__ __forceinline__ void stage_rc(int b, int& R, int& C) { const int st = b / 1024, sb = b % 1024, swz = sb ^ (((sb >> 9) & 1) << 5); R = (st >> 1) * 16 + swz / 64; C = (st & 1) * 32 + (swz % 64) / 2; }
__host__ __device__ __forceinline__ int perm32(int rho) { const int n = rho >> 4, i = rho & 15; return 8 * (i >> 2) + 4 * n + (i & 3); }

struct Unit { int pm, pn, w; };
struct Gemm { const bf16_t* A; const bf16_t* Bt; int M, N, K, ld; };

struct StaticOrder {
    int nM, nN, nwg, G, c;
    __host__ __device__ void init(int M, int N, int G_, int c_) { nM = M / BM; nN = N / BM; nwg = nM * nN; G = G_; c = c_; }
    __host__ __device__ bool next(int i, Unit& u) const {
        const long L = (long)i * G + c; if (L >= nwg) return false;
        int wgid = (int)L; { const int q = nwg / NXCD, r = nwg % NXCD, xcd = wgid % NXCD, off = wgid / NXCD; wgid = (xcd < r ? xcd * (q + 1) : r * (q + 1) + (xcd - r) * q) + off; }
        const int nig = WGM * nN, gid = wgid / nig, fm = gid * WGM, gsz = (nM - fm) < WGM ? (nM - fm) : WGM;
        u.pm = fm + ((wgid % nig) % gsz); u.pn = (wgid % nig) / gsz; u.w = 0; return true;
    }
    __device__ __forceinline__ void a_ready(const Unit&) const {}
    __device__ __forceinline__ void done(const Unit&) const {}
    __device__ __forceinline__ long offA(const Unit&) const { return 0; }
    __device__ __forceinline__ long offB(const Unit&) const { return 0; }
    __device__ __forceinline__ int nt(const Unit&, int d) const { return d; }
};
struct SplitOrder2 {
    int c; long koff;
    __device__ __forceinline__ bool next(int i, Unit& u) const { if (i > 0 || c >= 32) return false; const int t = c >> 1; u.pm = t >> 2; u.pn = t & 3; u.w = c & 1; return true; }
    __device__ __forceinline__ void a_ready(const Unit&) const {}
    __device__ __forceinline__ void done(const Unit&) const {}
    __device__ __forceinline__ long offA(const Unit& u) const { return u.w ? koff : 0; }
    __device__ __forceinline__ long offB(const Unit& u) const { return u.w ? koff : 0; }
    __device__ __forceinline__ int nt(const Unit&, int d) const { return d; }
};
struct DualOrder {
    int nM0, nN0, nM1, nN1, n0, n1, G, c; long dA, dB;
    __device__ __forceinline__ void init(int M0, int N0, int M1, int N1, int G_, int c_) { nM0 = M0 / BM; nN0 = N0 / BM; nM1 = M1 / BM; nN1 = N1 / BM; n0 = nM0 * nN0; n1 = nM1 * nN1; G = G_; c = c_; }
    __device__ __forceinline__ bool next(int i, Unit& u) const {
        const int Lx = i * G + c; if (Lx >= n0 + n1) return false;
        const int w = Lx >= n0 ? 1 : 0; const int nwg = w ? n1 : n0, nN = w ? nN1 : nN0, nM = w ? nM1 : nM0;
        int wgid = w ? Lx - n0 : Lx; { const int q = nwg / NXCD, r = nwg % NXCD, xcd = wgid % NXCD, off = wgid / NXCD; wgid = (xcd < r ? xcd * (q + 1) : r * (q + 1) + (xcd - r) * q) + off; }
        const int nig = WGM * nN, gid = wgid / nig, fm = gid * WGM, gsz = (nM - fm) < WGM ? (nM - fm) : WGM;
        u.pm = fm + ((wgid % nig) % gsz); u.pn = (wgid % nig) / gsz; u.w = w; return true; }
    __device__ __forceinline__ void a_ready(const Unit&) const {}
    __device__ __forceinline__ void done(const Unit&) const {}
    __device__ __forceinline__ long offA(const Unit& u) const { return u.w ? dA : 0; }
    __device__ __forceinline__ long offB(const Unit& u) const { return u.w ? dB : 0; }
    __device__ __forceinline__ int nt(const Unit&, int d) const { return d; }
};
struct KqvtOrder {
    int G, c; long dA, dB;
    __device__ __forceinline__ bool next(int i, Unit& u) const {
        const int Lx = i * G + c; if (Lx >= 1728) return false;
        if (Lx >= 1536) { const int q = Lx - 1536, kq = q & 3, tile = q >> 2;
            if (tile < 32) { u.pm = 128 + (tile >> 3); u.pn = tile & 7; u.w = 2 + 2 * kq; } else { const int t2 = tile - 32; u.pm = t2 >> 2; u.pn = 128 + (t2 & 3); u.w = 3 + 2 * kq; }
            return true; }
        const int w = Lx >= 1024 ? 1 : 0; const int nwg = w ? 512 : 1024, nN = w ? 128 : 8, nM = w ? 4 : 128;
        int wgid = w ? Lx - 1024 : Lx; { const int q = nwg / NXCD, xcd = wgid % NXCD, off = wgid / NXCD; wgid = xcd * q + off; }
        const int nig = WGM * nN, gid = wgid / nig, fm = gid * WGM, gsz = (nM - fm) < WGM ? (nM - fm) : WGM;
        u.pm = fm + ((wgid % nig) % gsz); u.pn = (wgid % nig) / gsz; u.w = w; return true; }
    __device__ __forceinline__ void a_ready(const Unit&) const {}
    __device__ __forceinline__ void done(const Unit&) const {}
    __device__ __forceinline__ long offA(const Unit& u) const { return ((u.w & 1) ? dA : 0) + (u.w >= 2 ? (long)((u.w - 2) >> 1) * 512 : 0); }
    __device__ __forceinline__ long offB(const Unit& u) const { return ((u.w & 1) ? dB : 0) + (u.w >= 2 ? (long)((u.w - 2) >> 1) * 512 : 0); }
    __device__ __forceinline__ int nt(const Unit& u, int d) const { return u.w >= 2 ? 4 : d; }
};

template <class Epi, class Sched, bool ALIGN_EPI = false, bool SP2 = false>
__device__ __forceinline__ void gemm_phase(PG8_LAS unsigned char* lds, const Gemm g, const Sched& S, const Epi& E, int wave_id) {
    int tid_ = wave_id * 64 + fresh_lane(); asm volatile("" : "+v"(tid_));
    const int tid = tid_, wid = __builtin_amdgcn_readfirstlane(tid >> 6), lane = tid & 63, wr = wid >> 2, wc = wid & 3, fr = lane & 15, fq = lane >> 4;
    const int K = g.K, nt = K / BK;
    unsigned voffA[2], voffB[2];
#pragma unroll
    for (int i = 0; i < 2; ++i) { int R, C; stage_rc(tid * 16 + i * 8192, R, C); const int Rb = Epi::PERM ? ((R & ~31) + perm32(R & 31)) : R;
        voffA[i] = (unsigned)(R * g.ld + C) * 2u; voffB[i] = (unsigned)(Rb * g.ld + C) * 2u; }
    const size_t kstep = (size_t)(BK * 2);
    const size_t hstep = (size_t)HALF * g.ld * 2;
    const size_t tstep = 2 * hstep;
    const unsigned ldsw = (unsigned)wid * 1024u;
    const int aoff = lds_byte(wr * 64 + fr, fq * 8), boff = lds_byte(wc * 32 + fr, fq * 8);
#define PG8_SA(b, h) (((b) * 2 + (h)) * HTB)
#define PG8_SB(b, h) ((4 + (b) * 2 + (h)) * HTB)
#define PG8_STAGE(bufoff, gbase, voff) do { _Pragma("unroll") for (int _i = 0; _i < 2; ++_i) \
        __builtin_amdgcn_global_load_lds((const unsigned*)((const char*)(gbase) + (voff)[_i]), (PG8_LAS unsigned*)(lds + (bufoff) + ldsw + _i * 8192), 16, 0, 0); } while (0)
#define PG8_LDA(dst, b, h) do { _Pragma("unroll") for (int m = 0; m < 4; ++m) _Pragma("unroll") for (int k = 0; k < 2; ++k) dst[m][k] = *(const PG8_LAS bf16x8*)(lds + PG8_SA(b, h) + aoff + m * 2048 + k * 1024); } while (0)
#define PG8_LDB(dst, b, h) do { _Pragma("unroll") for (int n = 0; n < 2; ++n) _Pragma("unroll") for (int k = 0; k < 2; ++k) dst[n][k] = *(const PG8_LAS bf16x8*)(lds + PG8_SB(b, h) + boff + n * 2048 + k * 1024); } while (0)
#define PG8_MMA(ai, bj, At, Bt) do { __builtin_amdgcn_s_setprio(1); _Pragma("unroll") for (int m = 0; m < 4; ++m) _Pragma("unroll") for (int n = 0; n < 2; ++n) _Pragma("unroll") for (int k = 0; k < 2; ++k) \
        acc[ai][bj][m][n] = __builtin_amdgcn_mfma_f32_16x16x32_bf16(Bt[n][k], At[m][k], acc[ai][bj][m][n], 0, 0, 0); __builtin_amdgcn_s_setprio(0); } while (0)
#define PG8_WAIT_V(n) asm volatile("s_waitcnt vmcnt(" #n ")" ::: "memory")
#define PG8_WAIT_L(n) asm volatile("s_waitcnt lgkmcnt(" #n ")" ::: "memory")
#define PG8_BAR __builtin_amdgcn_s_barrier()
#define PG8_SCHED __builtin_amdgcn_sched_barrier(0)
    Unit cur, nxt; int ui = 0;
    if (!S.next(0, cur)) return;
    f32x4 acc[2][2][4][2];
#pragma unroll
    for (int a = 0; a < 2; ++a)
#pragma unroll
        for (int b = 0; b < 2; ++b)
#pragma unroll
            for (int m = 0; m < 4; ++m)
#pragma unroll
                for (int n = 0; n < 2; ++n) acc[a][b][m][n] = (f32x4){0.f, 0.f, 0.f, 0.f};
    bf16x8 At[4][2], B0[2][2], B1[2][2];
    const char* cA = (const char*)g.A + (size_t)cur.pm * tstep + S.offA(cur); const char* cB = (const char*)g.Bt + (size_t)cur.pn * tstep + S.offB(cur);
    S.a_ready(cur);
    if constexpr (SP2) {
        PG8_STAGE(PG8_SB(0, 0), cB, voffB); PG8_STAGE(PG8_SB(0, 1), cB + hstep, voffB); PG8_STAGE(PG8_SA(0, 0), cA, voffA); PG8_STAGE(PG8_SA(0, 1), cA + hstep, voffA);
        if (wr == 1) PG8_BAR;
        PG8_WAIT_V(2); PG8_BAR;
        PG8_STAGE(PG8_SB(1, 0), cB + kstep, voffB); PG8_STAGE(PG8_SA(1, 0), cA + kstep, voffA); PG8_STAGE(PG8_SB(1, 1), cB + hstep + kstep, voffB);
        PG8_WAIT_V(6); PG8_BAR;
    } else {
        PG8_STAGE(PG8_SB(0, 0), cB, voffB); PG8_STAGE(PG8_SA(0, 0), cA, voffA); PG8_STAGE(PG8_SB(0, 1), cB + hstep, voffB); PG8_STAGE(PG8_SA(0, 1), cA + hstep, voffA);
        if (wr == 1) PG8_BAR;
        PG8_WAIT_V(4); PG8_BAR;
        PG8_STAGE(PG8_SB(1, 0), cB + kstep, voffB); PG8_STAGE(PG8_SA(1, 0), cA + kstep, voffA); PG8_STAGE(PG8_SB(1, 1), cB + hstep + kstep, voffB);
        PG8_WAIT_V(6); PG8_BAR;
    }
    for (;;) {
        const bool has_next = S.next(ui + 1, nxt);
        const char* nA = has_next ? (const char*)g.A + (size_t)nxt.pm * tstep + S.offA(nxt) : cA; const char* nB = has_next ? (const char*)g.Bt + (size_t)nxt.pn * tstep + S.offB(nxt) : cB;
        const int ntc = S.nt(cur, nt);
        for (int t = 0; t < ntc; t += 2) {
            const bool last = (t == ntc - 2);
            const char* a1 = cA + (size_t)(t + 1) * kstep;
            const char* a2 = last ? nA : cA + (size_t)(t + 2) * kstep; const char* b2 = last ? nB : cB + (size_t)(t + 2) * kstep;
            const char* a3 = a2 + kstep; const char* b3 = b2 + kstep;
            if (last && has_next) S.a_ready(nxt);
            if constexpr (Epi::KSCALE) { if (t == 0) E.unit_begin(cur, ui, lds, tid); else if ((t & 7) == 0) E.kscale(acc, ui, t >> 3, lds, wr, fr); }
            if constexpr (SP2) {
            PG8_LDB(B0, 0, 0); PG8_LDB(B1, 0, 1); PG8_SCHED; PG8_LDA(At, 0, 0); PG8_STAGE(PG8_SA(1, 1), a1 + hstep, voffA);
            PG8_WAIT_V(8); PG8_WAIT_L(0); PG8_BAR; PG8_MMA(0, 0, At, B0); PG8_MMA(0, 1, At, B1); PG8_BAR; PG8_SCHED;
            PG8_LDA(At, 0, 1); PG8_STAGE(PG8_SB(0, 0), b2, voffB); PG8_STAGE(PG8_SB(0, 1), b2 + hstep, voffB); PG8_STAGE(PG8_SA(0, 0), a2, voffA);
            PG8_WAIT_V(8); PG8_WAIT_L(0); PG8_BAR; PG8_MMA(1, 0, At, B0); PG8_MMA(1, 1, At, B1); PG8_BAR; PG8_SCHED;
            PG8_LDB(B0, 1, 0); PG8_LDB(B1, 1, 1); PG8_SCHED; PG8_LDA(At, 1, 0); PG8_STAGE(PG8_SA(0, 1), a2 + hstep, voffA);
            PG8_WAIT_V(8); PG8_WAIT_L(0); PG8_BAR; PG8_MMA(0, 0, At, B0); PG8_MMA(0, 1, At, B1); PG8_BAR; PG8_SCHED;
            PG8_LDA(At, 1, 1); PG8_STAGE(PG8_SB(1, 0), b3, voffB); PG8_STAGE(PG8_SB(1, 1), b3 + hstep, voffB); PG8_STAGE(PG8_SA(1, 0), a3, voffA);
            PG8_WAIT_V(8); PG8_WAIT_L(0); PG8_BAR; PG8_MMA(1, 0, At, B0); PG8_MMA(1, 1, At, B1); PG8_BAR; PG8_SCHED;
            } else {
            PG8_LDB(B0, 0, 0); PG8_SCHED; PG8_LDA(At, 0, 0); PG8_STAGE(PG8_SA(1, 1), a1 + hstep, voffA);
            PG8_WAIT_L(8); PG8_BAR; PG8_WAIT_L(0); PG8_MMA(0, 0, At, B0); PG8_BAR; PG8_SCHED;
            PG8_LDB(B1, 0, 1); PG8_STAGE(PG8_SB(0, 0), b2, voffB);
            PG8_BAR; PG8_WAIT_L(0); PG8_MMA(0, 1, At, B1); PG8_BAR;
            PG8_LDA(At, 0, 1); PG8_STAGE(PG8_SA(0, 0), a2, voffA);
            PG8_BAR; PG8_WAIT_L(0); PG8_MMA(1, 0, At, B0); PG8_BAR; PG8_SCHED;
            PG8_STAGE(PG8_SB(0, 1), b2 + hstep, voffB);
            PG8_WAIT_V(6); PG8_BAR; PG8_MMA(1, 1, At, B1); PG8_BAR;
            PG8_LDB(B0, 1, 0); PG8_SCHED; PG8_LDA(At, 1, 0); PG8_STAGE(PG8_SA(0, 1), a2 + hstep, voffA);
            PG8_WAIT_L(8); PG8_BAR; PG8_WAIT_L(0); PG8_MMA(0, 0, At, B0); PG8_BAR; PG8_SCHED;
            PG8_LDB(B1, 1, 1); PG8_STAGE(PG8_SB(1, 0), b3, voffB);
            PG8_BAR; PG8_WAIT_L(0); PG8_MMA(0, 1, At, B1); PG8_BAR;
            PG8_LDA(At, 1, 1); PG8_STAGE(PG8_SA(1, 0), a3, voffA);
            PG8_BAR; PG8_WAIT_L(0); PG8_MMA(1, 0, At, B0); PG8_BAR; PG8_SCHED;
            PG8_STAGE(PG8_SB(1, 1), b3 + hstep, voffB);
            PG8_WAIT_V(6); PG8_BAR; PG8_MMA(1, 1, At, B1); PG8_BAR;
            }
        }
        if constexpr (ALIGN_EPI) { if (wr == 0) PG8_BAR; }
        if constexpr (Epi::KSCALE) E.final(acc, cur, ui, lds, wr, wc, fr, fq); else E(acc, cur, wr, wc, fr, fq);
        S.done(cur);
        if (!has_next) break;
#pragma unroll
        for (int a = 0; a < 2; ++a)
#pragma unroll
            for (int b = 0; b < 2; ++b)
#pragma unroll
                for (int m = 0; m < 4; ++m)
#pragma unroll
                    for (int n = 0; n < 2; ++n) acc[a][b][m][n] = (f32x4){0.f, 0.f, 0.f, 0.f};
        cur = nxt; cA = nA; cB = nB; ++ui;
        if constexpr (ALIGN_EPI) { if (wr == 1) PG8_BAR; }
    }
    PG8_WAIT_V(0);
    if constexpr (!ALIGN_EPI) { if (wr == 0) PG8_BAR; }
    PG8_BAR;
#undef PG8_SA
#undef PG8_SB
#undef PG8_STAGE
#undef PG8_LDA
#undef PG8_LDB
#undef PG8_MMA
#undef PG8_WAIT_V
#undef PG8_WAIT_L
#undef PG8_BAR
#undef PG8_SCHED
}
}

constexpr int NTHREADS = 512, NWAVES = 8;
constexpr int LDS_BYTES = 147456;
constexpr int DM = 1024, TP = 32768, TS = 1024, TT = TP + TS;
constexpr int DI = 2048, NH = 32, HD = 64, NG = 4, NS = 128, CONVD = 3072, INPROJ = 5152, INPROJ_PAD = 5376;
constexpr int FF = 2816, FF2 = 5632;
constexpr int AH = 16;
constexpr float EPS = 1e-6f;
constexpr size_t O_Y = 0, O_SSM_P = 34603008, O_CONV_P = 38797312, O_CK_P = 38944768, O_CV_P = 47333376,
                 O_SSM_S = 55721984, O_CONV_S = 59916288, O_CK_S = 60063744, O_CV_S = 61112320, O_TOTAL = 62160896;
constexpr size_t MiB = 1u << 20;
constexpr size_t WS_CTL = 0;
constexpr size_t WS_WIN = 2 * MiB;
constexpr size_t WS_WOUT = WS_WIN + (size_t)INPROJ_PAD * DM * 2;
constexpr size_t WS_WF1 = WS_WOUT + (size_t)DM * DI * 2;
constexpr size_t WS_WF2 = WS_WF1 + 2 * (size_t)FF2 * DM * 2;
constexpr size_t WS_WKQ = WS_WF2 + 2 * (size_t)DM * FF * 2;
constexpr size_t WS_WV = WS_WKQ + (size_t)2048 * DM * 2;
constexpr size_t WS_WO = WS_WV + (size_t)DM * DM * 2;
constexpr size_t WS_WEND = WS_WO + (size_t)DM * DM * 2;
constexpr size_t WS_SSQ = 60 * MiB;
constexpr size_t WS_XN = 64 * MiB;
constexpr size_t WS_R = 130 * MiB;
constexpr size_t WS_Z = WS_R;
constexpr size_t WS_XBC = WS_R + 132 * MiB;
constexpr size_t WS_DT = WS_R + 330 * MiB;
constexpr size_t WS_END = WS_R + 336 * MiB;
constexpr size_t WS_M = WS_R + 264 * MiB;
constexpr size_t WS_H = WS_R;
constexpr size_t WS_KHP = WS_R, WS_QHP = WS_R + 64 * MiB, WS_VTP = WS_R + 128 * MiB;
constexpr size_t WS_KHS = WS_END, WS_VTS = WS_END + 18 * MiB, WS_QHS = WS_END + 36 * MiB, WS_END2 = WS_END + 38 * MiB, WS_SLAB = WS_END2, WS_END3 = WS_END2 + 8 * MiB;
constexpr size_t WS_AO = WS_R + 192 * MiB;
constexpr size_t WS_SQ = 61 * MiB;
constexpr int SKV = 576;
static_assert(WS_WEND <= WS_SSQ, "weights overflow");

#define GAS __attribute__((address_space(1)))
#define LAS __attribute__((address_space(3)))
typedef unsigned short bf16;
typedef unsigned v4u __attribute__((ext_vector_type(4)));
typedef unsigned v2u __attribute__((ext_vector_type(2)));
typedef float f32x4 __attribute__((ext_vector_type(4)));
typedef short bf16x8 __attribute__((ext_vector_type(8)));
#define LDS_WAIT() asm volatile("s_waitcnt lgkmcnt(0)" ::: "memory")

__device__ __forceinline__ unsigned f2bf(float f) { unsigned u = __builtin_bit_cast(unsigned, f); return (u + 0x7fffu + ((u >> 16) & 1u)) >> 16; }
typedef float f32x2_t __attribute__((ext_vector_type(2))); typedef __bf16 bf16x2_t __attribute__((ext_vector_type(2)));
__device__ __forceinline__ unsigned pk2(float lo, float hi) { const f32x2_t v = {lo, hi}; const bf16x2_t b = __builtin_convertvector(v, bf16x2_t); return __builtin_bit_cast(unsigned, b); }
__device__ __forceinline__ float bflo(unsigned u) { return __builtin_bit_cast(float, u << 16); }
__device__ __forceinline__ float bfhi(unsigned u) { return __builtin_bit_cast(float, u & 0xffff0000u); }
__device__ __forceinline__ float wave_sum(float v) {
#pragma unroll
    for (int o = 1; o < 64; o <<= 1) v += __shfl_xor(v, o);
    return v;
}

__device__ __forceinline__ float xor32_f(float v) { const auto rr = __builtin_amdgcn_permlane32_swap(__builtin_bit_cast(unsigned, v), __builtin_bit_cast(unsigned, v), false, false); const unsigned lo = rr[0], hi = rr[1];
    return __builtin_bit_cast(float, (fresh_lane() & 32) ? lo : hi); }
#define DPP_ADD(x, ctrl, rmask) ((x) + __builtin_bit_cast(float, __builtin_amdgcn_update_dpp(0, __builtin_bit_cast(int, (x)), (ctrl), (rmask), 0xf, false)))
__device__ __forceinline__ float wave_scan_incl(float x) {
    x = DPP_ADD(x, 0x111, 0xf); x = DPP_ADD(x, 0x112, 0xf); x = DPP_ADD(x, 0x114, 0xf); x = DPP_ADD(x, 0x118, 0xf);
    x = DPP_ADD(x, 0x142, 0xa); x = DPP_ADD(x, 0x143, 0xc); return x; }
__device__ __forceinline__ float xor32_max_(float v) { const auto rr = __builtin_amdgcn_permlane32_swap(__builtin_bit_cast(unsigned, v), __builtin_bit_cast(unsigned, v), false, false); return fmaxf(__builtin_bit_cast(float, (unsigned)rr[0]), __builtin_bit_cast(float, (unsigned)rr[1])); }
__device__ __forceinline__ float xor32_sum_(float v) { const auto rr = __builtin_amdgcn_permlane32_swap(__builtin_bit_cast(unsigned, v), __builtin_bit_cast(unsigned, v), false, false); return __builtin_bit_cast(float, (unsigned)rr[0]) + __builtin_bit_cast(float, (unsigned)rr[1]); }
__device__ __forceinline__ float max3f_(float a, float b, float c) { float r; asm("v_max3_f32 %0, %1, %2, %3" : "=v"(r) : "v"(a), "v"(b), "v"(c)); return r; }
struct Args { const float* in[22]; float* out; unsigned char* ws; int dbg; int pad; };

__device__ __forceinline__ void tr_item(const float* W, int Nsrc, int K, bf16* WT, int r0, int c0, int k0, const float* kscale, float cmul, LAS float* scr, int lane) {
    const int kq = lane >> 3, n4 = (lane & 7) * 4;
    f32x4 v[8]; float sc[8];
#pragma unroll
    for (int i = 0; i < 8; ++i) { const int kk = kq + 8 * i;
        v[i] = (c0 >= 0) ? __builtin_nontemporal_load((const GAS f32x4*)(W + (size_t)(k0 + kk) * Nsrc + c0 + n4)) : (f32x4){0.f, 0.f, 0.f, 0.f};
        sc[i] = kscale ? kscale[k0 + kk] * cmul : cmul; }
#pragma unroll
    for (int i = 0; i < 8; ++i) { const int kk = kq + 8 * i; LAS float* d = scr + kk * 33 + n4; d[0] = v[i][0] * sc[i]; d[1] = v[i][1] * sc[i]; d[2] = v[i][2] * sc[i]; d[3] = v[i][3] * sc[i]; }
    LDS_WAIT(); asm volatile("" ::: "memory");
    const int c = lane & 7;
#pragma unroll
    for (int j = 0; j < 4; ++j) { const int n = (lane >> 3) + 8 * j; const LAS float* s = scr + (8 * c) * 33 + n;
        v4u o; o.x = pk2(s[0 * 33], s[1 * 33]); o.y = pk2(s[2 * 33], s[3 * 33]); o.z = pk2(s[4 * 33], s[5 * 33]); o.w = pk2(s[6 * 33], s[7 * 33]);
        *(GAS v4u*)(WT + (size_t)(r0 + n) * K + k0 + 8 * c) = o; }
    LDS_WAIT(); asm volatile("" ::: "memory");
}
__device__ __forceinline__ void rms_row2_to_bf16(const float* xrow, bf16* orow, int lane) {
    f32x4 v[2][4]; float s[2] = {0.f, 0.f};
#pragma unroll
    for (int r = 0; r < 2; ++r)
#pragma unroll
        for (int j = 0; j < 4; ++j) { v[r][j] = __builtin_nontemporal_load((const GAS f32x4*)(xrow + r * DM + 4 * lane + 256 * j)); s[r] += (v[r][j].x * v[r][j].x + v[r][j].y * v[r][j].y) + (v[r][j].z * v[r][j].z + v[r][j].w * v[r][j].w); }
#pragma unroll
    for (int r = 0; r < 2; ++r) { const float rstd = __builtin_amdgcn_rsqf(wave_sum(s[r]) * (1.f / DM) + EPS);
#pragma unroll
        for (int j = 0; j < 4; ++j) { v2u o; o.x = pk2(v[r][j].x * rstd, v[r][j].y * rstd); o.y = pk2(v[r][j].z * rstd, v[r][j].w * rstd); *(GAS v2u*)(orow + r * DM + 4 * lane + 256 * j) = o; } }
}

struct EpiInProj {
    static constexpr bool PERM = true, KSCALE = false;
    bf16* Z; bf16* XBC; float* DT; float* out;
    __device__ __forceinline__ void operator()(const f32x4 (&acc)[2][2][4][2], const pg8::Unit& u, int wr, int wc, int fr, int fq) const {
        const int row0 = u.pm * 256 + wr * 64 + fr; const int ct = u.pn; const int cl = wc * 32 + 8 * fq;
#pragma unroll
        for (int ai = 0; ai < 2; ++ai)
#pragma unroll
            for (int m = 0; m < 4; ++m) {
                const int row = row0 + ai * 128 + m * 16;
#pragma unroll
                for (int bj = 0; bj < 2; ++bj) {
                    const f32x4 v0 = acc[ai][bj][m][0], v1 = acc[ai][bj][m][1];
                    v4u w; w.x = pk2(v0[0], v0[1]); w.y = pk2(v0[2], v0[3]); w.z = pk2(v1[0], v1[1]); w.w = pk2(v1[2], v1[3]);
                    const int c = bj * 128 + cl;
                    if (ct < 8) { *(GAS v4u*)(Z + (size_t)row * DI + ct * 256 + c) = w; }
                    else if (ct < 20) {
                        const int col = (ct - 8) * 256 + c;
                        *(GAS v4u*)(XBC + (size_t)row * CONVD + col) = w;
                        int pos, b; size_t ob; int L;
                        if (row < TP) { b = row >> 11; pos = row & 2047; L = 2048; ob = O_CONV_P; } else { b = (row - TP) >> 6; pos = (row - TP) & 63; L = 64; ob = O_CONV_S; }
                        if (pos >= L - 3) { float* o = out + ob + (size_t)(b * 3 + (pos - (L - 3))) * CONVD + col; *(GAS f32x4*)o = v0; *(GAS f32x4*)(o + 4) = v1; }
                    } else {
                        if (bj == 0 && wc == 0) { float* o = DT + (size_t)row * 32 + 8 * fq; *(GAS f32x4*)o = v0; *(GAS f32x4*)(o + 4) = v1; }
                    }
                }
            }
    }
};

struct EpiPlain {
    static constexpr bool PERM = true, KSCALE = false;
    bf16* O; int ldc;
    __device__ __forceinline__ void operator()(const f32x4 (&acc)[2][2][4][2], const pg8::Unit& u, int wr, int wc, int fr, int fq) const {
        const int row0 = u.pm * 256 + wr * 64 + fr, col0 = u.pn * 256 + wc * 32 + 8 * fq;
#pragma unroll
        for (int ai = 0; ai < 2; ++ai)
#pragma unroll
            for (int m = 0; m < 4; ++m) { bf16* rowp = O + (size_t)(row0 + ai * 128 + m * 16) * ldc + col0;
#pragma unroll
                for (int bj = 0; bj < 2; ++bj) { const f32x4 v0 = acc[ai][bj][m][0], v1 = acc[ai][bj][m][1];
                    v4u w; w.x = pk2(v0[0], v0[1]); w.y = pk2(v0[2], v0[3]); w.z = pk2(v1[0], v1[1]); w.w = pk2(v1[2], v1[3]);
                    *(GAS v4u*)(rowp + bj * 128) = w; } }
    }
};
constexpr int KS_OFF = 135168;
struct EpiOutProj {
    static constexpr bool PERM = true, KSCALE = true;
    bf16* O; int ldc; const float* ssq;
    __device__ __forceinline__ void unit_begin(const pg8::Unit& u, int ui, PG8_LAS unsigned char* lds, int tid) const {
        asm volatile("" : "+v"(tid));
        if (tid < 256) { const f32x4 v = *(const GAS f32x4*)(ssq + (size_t)(u.pm * 256 + tid) * 4);
            const float a0 = v[0] * (1.f / 512.f) + EPS, a1 = v[1] * (1.f / 512.f) + EPS, a2 = v[2] * (1.f / 512.f) + EPS, a3 = v[3] * (1.f / 512.f) + EPS;
            f32x4 r; r[0] = __builtin_amdgcn_rsqf(a0) * __builtin_amdgcn_sqrtf(a1); r[1] = __builtin_amdgcn_rsqf(a1) * __builtin_amdgcn_sqrtf(a2); r[2] = __builtin_amdgcn_rsqf(a2) * __builtin_amdgcn_sqrtf(a3); r[3] = __builtin_amdgcn_rsqf(a3);
            *(PG8_LAS f32x4*)(lds + KS_OFF + (ui & 1) * 4096 + tid * 16) = r; }
    }
    __device__ __forceinline__ void kscale(f32x4 (&acc)[2][2][4][2], int ui, int g, PG8_LAS unsigned char* lds, int wr, int fr) const {
        asm volatile("" : "+v"(fr));
        const PG8_LAS float* rt = (const PG8_LAS float*)(lds + KS_OFF + (ui & 1) * 4096) + (wr * 64 + fr) * 4 + (g - 1);
#pragma unroll
        for (int ai = 0; ai < 2; ++ai)
#pragma unroll
            for (int m = 0; m < 4; ++m) { const float ratio = rt[(ai * 128 + m * 16) * 4];
#pragma unroll
                for (int bj = 0; bj < 2; ++bj)
#pragma unroll
                    for (int n = 0; n < 2; ++n) acc[ai][bj][m][n] = acc[ai][bj][m][n] * ratio; }
    }
    __device__ __forceinline__ void final(const f32x4 (&acc)[2][2][4][2], const pg8::Unit& u, int ui, PG8_LAS unsigned char* lds, int wr, int wc, int fr, int fq) const {
        asm volatile("" : "+v"(fr), "+v"(fq));
        const int row0 = u.pm * 256 + wr * 64 + fr, col0 = u.pn * 256 + wc * 32 + 8 * fq;
        const PG8_LAS float* rt = (const PG8_LAS float*)(lds + KS_OFF + (ui & 1) * 4096) + (wr * 64 + fr) * 4 + 3;
#pragma unroll
        for (int ai = 0; ai < 2; ++ai)
#pragma unroll
            for (int m = 0; m < 4; ++m) { const int row = row0 + ai * 128 + m * 16; bf16* rowp = O + (size_t)row * ldc + col0;
                const float s3 = rt[(ai * 128 + m * 16) * 4];
#pragma unroll
                for (int bj = 0; bj < 2; ++bj) { const f32x4 v0 = acc[ai][bj][m][0] * s3, v1 = acc[ai][bj][m][1] * s3;
                    v4u w; w.x = pk2(v0[0], v0[1]); w.y = pk2(v0[2], v0[3]); w.z = pk2(v1[0], v1[1]); w.w = pk2(v1[2], v1[3]);
                    *(GAS v4u*)(rowp + bj * 128) = w; } }
    }
    __device__ __forceinline__ void operator()(const f32x4 (&acc)[2][2][4][2], const pg8::Unit& u, int wr, int wc, int fr, int fq) const {}
};
__device__ __forceinline__ float silu_f(float v) { return v * __builtin_amdgcn_rcpf(1.f + __expf(-v)); }
struct EpiSwiGLU {
    static constexpr bool PERM = true, KSCALE = false;
    bf16* H;
    __device__ __forceinline__ void operator()(const f32x4 (&acc)[2][2][4][2], const pg8::Unit& u, int wr, int wc, int fr, int fq) const {
        const int row0 = u.pm * 256 + wr * 64 + fr, col0 = u.pn * 128 + wc * 32 + 8 * fq;
#pragma unroll
        for (int ai = 0; ai < 2; ++ai)
#pragma unroll
            for (int m = 0; m < 4; ++m) {
                const f32x4 g0 = acc[ai][0][m][0], g1 = acc[ai][0][m][1], u0 = acc[ai][1][m][0], u1 = acc[ai][1][m][1];
                v4u w; w.x = pk2(silu_f(g0[0]) * u0[0], silu_f(g0[1]) * u0[1]); w.y = pk2(silu_f(g0[2]) * u0[2], silu_f(g0[3]) * u0[3]);
                w.z = pk2(silu_f(g1[0]) * u1[0], silu_f(g1[1]) * u1[1]); w.w = pk2(silu_f(g1[2]) * u1[2], silu_f(g1[3]) * u1[3]);
                *(GAS v4u*)(H + (size_t)(row0 + ai * 128 + m * 16) * FF + col0) = w; }
    }
};
struct EpiKQ {
    static constexpr bool PERM = true, KSCALE = false;
    bf16 *KHp, *QHp, *KHs, *QHs; float* out;
    __device__ __forceinline__ void operator()(const f32x4 (&acc)[2][2][4][2], const pg8::Unit& u, int wr, int wc, int fr, int fq) const {
        const int row_t = u.pm * 256, b = row_t >> 11, pos_t = row_t & 2047; const bool isK = u.pn < 4, cache = isK && pos_t >= 1536;
        const int hd0 = (u.pn & 3) * 4 + (wc >> 1), d = (wc & 1) * 32 + 8 * fq, ro = wr * 64 + fr;
        bf16* dstb = (isK ? KHp : QHp) + ((size_t)((b * AH + hd0) * 2048 + pos_t + ro)) * 64 + d;
        float* ob = out + O_CK_P + (size_t)(b * 512 + pos_t - 1536 + ro) * 1024 + u.pn * 256 + wc * 32 + 8 * fq;
#pragma unroll
        for (int ai = 0; ai < 2; ++ai)
#pragma unroll
            for (int m = 0; m < 4; ++m)
#pragma unroll
                for (int bj = 0; bj < 2; ++bj) {
                    const f32x4 v0 = acc[ai][bj][m][0], v1 = acc[ai][bj][m][1];
                    v4u w; w.x = pk2(v0[0], v0[1]); w.y = pk2(v0[2], v0[3]); w.z = pk2(v1[0], v1[1]); w.w = pk2(v1[2], v1[3]);
                    *(GAS v4u*)(dstb + (size_t)(bj * 2 * 2048 + ai * 128 + m * 16) * 64) = w;
                    if (cache) { float* o = ob + (size_t)(ai * 128 + m * 16) * 1024 + bj * 128; *(GAS f32x4*)o = v0; *(GAS f32x4*)(o + 4) = v1; }
                }
    }
};
struct EpiVT {
    static constexpr bool PERM = true, KSCALE = false;
    bf16 *VTp, *VTs; float* out;
    __device__ __forceinline__ void operator()(const f32x4 (&acc)[2][2][4][2], const pg8::Unit& u, int wr, int wc, int fr, int fq) const {
        const int b = u.pn >> 3, pos_t = (u.pn & 7) * 256; const bool cache = pos_t >= 1536;
        const int hd0 = u.pm * 4 + wr, po = wc * 32 + 8 * fq;
        bf16* dstb = VTp + ((size_t)((b * AH + hd0) * 64 + fr)) * 2048 + pos_t + po;
        float* ob = out + O_CV_P + (size_t)(b * 512 + pos_t - 1536 + po) * 1024 + u.pm * 256 + wr * 64 + fr;
#pragma unroll
        for (int ai = 0; ai < 2; ++ai)
#pragma unroll
            for (int m = 0; m < 4; ++m)
#pragma unroll
                for (int bj = 0; bj < 2; ++bj) {
                    const f32x4 v0 = acc[ai][bj][m][0], v1 = acc[ai][bj][m][1];
                    v4u w; w.x = pk2(v0[0], v0[1]); w.y = pk2(v0[2], v0[3]); w.z = pk2(v1[0], v1[1]); w.w = pk2(v1[2], v1[3]);
                    *(GAS v4u*)(dstb + (size_t)((ai * 2 * 64 + m * 16) * 2048 + bj * 128)) = w;
                    if (cache) { float* o = ob + (size_t)(bj * 128) * 1024 + ai * 128 + m * 16;
#pragma unroll
                        for (int e = 0; e < 4; ++e) { o[(size_t)e * 1024] = v0[e]; o[(size_t)(e + 4) * 1024] = v1[e]; } }
                }
    }
};

struct EpiSlab {
    static constexpr bool PERM = true, KSCALE = false;
    float* slab;
    __device__ __forceinline__ void operator()(const f32x4 (&acc)[2][2][4][2], const pg8::Unit& u, int wr, int wc, int fr, int fq) const {
        const int row0 = u.pm * 256 + wr * 64 + fr, col0 = u.pn * 256 + wc * 32 + 8 * fq; float* base = slab + (size_t)u.w * (TS * DM);
#pragma unroll
        for (int ai = 0; ai < 2; ++ai)
#pragma unroll
            for (int m = 0; m < 4; ++m) { float* rowp = base + (size_t)(row0 + ai * 128 + m * 16) * DM + col0;
#pragma unroll
                for (int bj = 0; bj < 2; ++bj) { *(GAS f32x4*)(rowp + bj * 128) = acc[ai][bj][m][0]; *(GAS f32x4*)(rowp + bj * 128 + 4) = acc[ai][bj][m][1]; } }
    }
};
constexpr size_t KQS_SLAB = (size_t)TS * 3072;
struct EpiKQVT {
    static constexpr bool PERM = true, KSCALE = false;
    EpiKQ kq; EpiVT vt; float* slab;
    __device__ __forceinline__ void operator()(const f32x4 (&acc)[2][2][4][2], const pg8::Unit& u, int wr, int wc, int fr, int fq) const {
        if (u.w == 0) kq(acc, u, wr, wc, fr, fq); else if (u.w == 1) vt(acc, u, wr, wc, fr, fq);
        else { const bool isv = u.w & 1; const int row0 = (isv ? u.pm : u.pm - 128) * 256 + wr * 64 + fr, col0 = (isv ? 2048 + (u.pn - 128) * 256 : u.pn * 256) + wc * 32 + 8 * fq;
            float* base = slab + (size_t)((u.w - 2) >> 1) * KQS_SLAB;
#pragma unroll
            for (int ai = 0; ai < 2; ++ai)
#pragma unroll
                for (int m = 0; m < 4; ++m) { float* rowp = base + (size_t)(row0 + ai * 128 + m * 16) * 3072 + col0;
#pragma unroll
                    for (int bj = 0; bj < 2; ++bj) { *(GAS f32x4*)(rowp + bj * 128) = acc[ai][bj][m][0]; *(GAS f32x4*)(rowp + bj * 128 + 4) = acc[ai][bj][m][1]; } } }
    }
};
__device__ __forceinline__ void norm_row2(const bf16* Mrow, const float* mf, const float* xf, bf16* xn, float* sq, float* yout, const float* wpost, int lane) {
    f32x4 mv[2][4], xv[2][4], wv[4]; float s[2] = {0.f, 0.f};
#pragma unroll
    for (int j = 0; j < 4; ++j) wv[j] = *(const GAS f32x4*)(wpost + 4 * lane + 256 * j);
#pragma unroll
    for (int r = 0; r < 2; ++r) {
        const float sqr = xf ? 1.f : sq[r];
#pragma unroll
        for (int j = 0; j < 4; ++j) {
            if (mf) mv[r][j] = *(const GAS f32x4*)(mf + r * DM + 4 * lane + 256 * j) + *(const GAS f32x4*)(mf + (size_t)TS * DM + r * DM + 4 * lane + 256 * j);
            else { const v2u mm = __builtin_nontemporal_load((const GAS v2u*)(Mrow + r * DM + 4 * lane + 256 * j)); mv[r][j] = (f32x4){bflo(mm.x), bfhi(mm.x), bflo(mm.y), bfhi(mm.y)}; }
            if (xf) xv[r][j] = __builtin_nontemporal_load((const GAS f32x4*)(xf + r * DM + 4 * lane + 256 * j));
            else { const v2u xx = *(const GAS v2u*)(xn + r * DM + 4 * lane + 256 * j); xv[r][j] = (f32x4){bflo(xx.x) * sqr, bfhi(xx.x) * sqr, bflo(xx.y) * sqr, bfhi(xx.y) * sqr}; }
            s[r] += (mv[r][j].x * mv[r][j].x + mv[r][j].y * mv[r][j].y) + (mv[r][j].z * mv[r][j].z + mv[r][j].w * mv[r][j].w); } }
    float s2[2] = {0.f, 0.f};
#pragma unroll
    for (int r = 0; r < 2; ++r) { const float r1 = __builtin_amdgcn_rsqf(wave_sum(s[r]) * (1.f / DM) + EPS);
#pragma unroll
        for (int j = 0; j < 4; ++j) { xv[r][j] = xv[r][j] + mv[r][j] * r1 * wv[j];
            if (yout) *(GAS f32x4*)(yout + r * DM + 4 * lane + 256 * j) = xv[r][j];
            s2[r] += (xv[r][j].x * xv[r][j].x + xv[r][j].y * xv[r][j].y) + (xv[r][j].z * xv[r][j].z + xv[r][j].w * xv[r][j].w); } }
    if (!yout) {
#pragma unroll
        for (int r = 0; r < 2; ++r) { const float ms = wave_sum(s2[r]) * (1.f / DM) + EPS; const float r2 = __builtin_amdgcn_rsqf(ms);
            if (lane == 0) sq[r] = ms * r2;
#pragma unroll
            for (int j = 0; j < 4; ++j) { v2u o; o.x = pk2(xv[r][j].x * r2, xv[r][j].y * r2); o.y = pk2(xv[r][j].z * r2, xv[r][j].w * r2); *(GAS v2u*)(xn + r * DM + 4 * lane + 256 * j) = o; } } }
}

typedef float f32x16 __attribute__((ext_vector_type(16)));
__device__ __forceinline__ bf16x8 pack8(const float* v) { v4u w; w.x = pk2(v[0], v[1]); w.y = pk2(v[2], v[3]); w.z = pk2(v[4], v[5]); w.w = pk2(v[6], v[7]); return __builtin_bit_cast(bf16x8, w); }
#define MFMA16(a, b, c) __builtin_amdgcn_mfma_f32_16x16x32_bf16((a), (b), (c), 0, 0, 0)
#define MFMA32(a, b, c) __builtin_amdgcn_mfma_f32_32x32x16_bf16((a), (b), (c), 0, 0, 0)
constexpr int S_XT = 0, S_BT = 18432, S_BN = 36864, S_CN = 54272, S_CB = 71680, S_HS = 89088, S_DT = 123904, S_CUM = 124416, S_W = 124928, S_CEND = 125440;


#define XB_TMO      128
#define XB_XCNT(j)  (256  + 64 * (j))
#define XB_XSUB(j)  (1280 + 64 * (j))
#define XB_XGEN(j)  (2304 + 64 * (j))
#define XB_TOP      3328
#define XB_TOPGEN   3392
#define XCD_BAR_WORDS 3456
#define XB_SPIN_CAP (1u << 22)
__device__ __forceinline__ unsigned xb_ld(unsigned* p)              { return __hip_atomic_load(p, __ATOMIC_RELAXED, __HIP_MEMORY_SCOPE_AGENT); }
__device__ __forceinline__ unsigned xb_add(unsigned* p, unsigned v) { return __hip_atomic_fetch_add(p, v, __ATOMIC_RELAXED, __HIP_MEMORY_SCOPE_AGENT); }
__device__ __forceinline__ unsigned xb_xcc_id() { return (unsigned)__builtin_amdgcn_s_getreg((3 << 11) | 20) & 0xFu; }
#define XB_SPIN(cond, bar) do { unsigned _sp = 0; while (cond) { __builtin_amdgcn_s_sleep(1); \
    if ((++_sp & 255u) == 0u) { if (xb_ld(&(bar)[XB_TMO])) break; if (_sp > XB_SPIN_CAP) { atomicAdd(&(bar)[XB_TMO], 1u); break; } } } } while (0)
struct XcdBarrier { unsigned* bar; unsigned x; volatile LAS unsigned* st; };
__device__ __forceinline__ bool is_thread0(int wave_id) { return wave_id == 0 && fresh_lane() == 0; }
__device__ __forceinline__ XcdBarrier xcd_barrier_post(unsigned* bar, volatile LAS unsigned* st, int wave_id) {
    XcdBarrier b; b.bar = bar; b.x = xb_xcc_id(); b.st = st;
    if (is_thread0(wave_id)) (void)xb_add(&bar[XB_XCNT(b.x)], 1u);
    return b;
}
__device__ __forceinline__ void xcd_barrier_complete(unsigned* bar, unsigned x, unsigned& nloc, unsigned& nx) {
    const unsigned G = gridDim.x * gridDim.y * gridDim.z;
    unsigned sum, cnt, mine, sp = 0u;
    for (;;) {
        sum = 0u; cnt = 0u; mine = 0u;
#pragma unroll
        for (unsigned j = 0; j < 16; ++j) { const unsigned c = xb_ld(&bar[XB_XCNT(j)]); sum += c; cnt += (c > 0u) ? 1u : 0u; mine = (j == x) ? c : mine; }
        if (sum == G) break;
        __builtin_amdgcn_s_sleep(1);
        if ((++sp & 255u) == 0u) { if (xb_ld(&bar[XB_TMO])) break; if (sp > XB_SPIN_CAP) { atomicAdd(&bar[XB_TMO], 1u); break; } }
    }
    nloc = mine > 0u ? mine : 1u; nx = cnt > 0u ? cnt : 1u;
}
__device__ __forceinline__ void xcd_barrier(const XcdBarrier& b, int wave_id) {
    asm volatile("s_waitcnt vmcnt(0)" ::: "memory");
    __syncthreads();
    if (is_thread0(wave_id)) {
        unsigned* bar = b.bar;
        __builtin_amdgcn_s_waitcnt(0);
        unsigned nloc = b.st[0], nx = b.st[1];
        if (nloc == 0u) { xcd_barrier_complete(bar, b.x, nloc, nx); b.st[0] = nloc; b.st[1] = nx; }
        const unsigned old = xb_add(&bar[XB_XSUB(b.x)], 1u);
        const unsigned gen = old / nloc;
        if (old + 1u == (gen + 1u) * nloc) {
            __builtin_amdgcn_fence(__ATOMIC_RELEASE, "agent");
            asm volatile("s_waitcnt vmcnt(0)" ::: "memory");
            const unsigned og = xb_add(&bar[XB_TOP], 1u);
            const unsigned tg = og / nx;
            if (og + 1u == (tg + 1u) * nx) xb_add(&bar[XB_TOPGEN], 1u);
            else XB_SPIN(xb_ld(&bar[XB_TOPGEN]) == tg, bar);
            __builtin_amdgcn_fence(__ATOMIC_ACQUIRE, "agent");
            xb_add(&bar[XB_XGEN(b.x)], 1u);
            asm volatile("s_waitcnt vmcnt(0)" ::: "memory");
        } else {
            XB_SPIN(xb_ld(&bar[XB_XGEN(b.x)]) == gen, bar);
            __builtin_amdgcn_fence(__ATOMIC_ACQUIRE, "agent");
            asm volatile("s_waitcnt vmcnt(0)" ::: "memory");
        }
    }
    __syncthreads();
}
constexpr int MISC_OFF = 146432;

__global__ void __launch_bounds__(NTHREADS, 2) mk_fwd(Args a) {
    extern __shared__ __attribute__((aligned(16))) unsigned char lds[];
    cg::grid_group grid = cg::this_grid();
    const int wave_s = __builtin_amdgcn_readfirstlane((int)threadIdx.x >> 6);
    const int G = gridDim.x, bx = blockIdx.x, NGW = G * NWAVES;
    const size_t gsz = (size_t)G * NTHREADS;
#define PHASE_IDS int tid = wave_s * 64 + fresh_lane(); asm volatile("" : "+v"(tid)); const int lane = tid & 63, wave = __builtin_amdgcn_readfirstlane(tid >> 6), gw = bx * NWAVES + wave; const size_t gtid = (size_t)bx * NTHREADS + tid; (void)lane; (void)gw; (void)gtid;
#define PHASE_PTRS const Args __attribute__((address_space(4)))* ap_ = (const Args __attribute__((address_space(4)))*)__builtin_amdgcn_kernarg_segment_ptr(); asm volatile("" : "+s"(ap_)); \
    unsigned char* ws = ap_->ws; float* out = ap_->out; (void)out; const float* x_p = ap_->in[0]; const float* x_s = ap_->in[1]; const float* norm_w = ap_->in[6]; (void)x_p; (void)x_s; (void)norm_w; \
    bf16* Win_t = (bf16*)(ws + WS_WIN); bf16* Wout_t = (bf16*)(ws + WS_WOUT); bf16* Wf1_t = (bf16*)(ws + WS_WF1); bf16* Wf2_t = (bf16*)(ws + WS_WF2); \
    bf16* Wkq_t = (bf16*)(ws + WS_WKQ); bf16* Wv_t = (bf16*)(ws + WS_WV); bf16* Wo_t = (bf16*)(ws + WS_WO); \
    bf16* XN = (bf16*)(ws + WS_XN); bf16* Z = (bf16*)(ws + WS_Z); bf16* XBC = (bf16*)(ws + WS_XBC); float* DT = (float*)(ws + WS_DT); \
    float* SSQ = (float*)(ws + WS_SSQ); float* SQ = (float*)(ws + WS_SQ); (void)SQ; float* SLAB = (float*)(ws + WS_SLAB); (void)SLAB; bf16* MB = (bf16*)(ws + WS_M); bf16* HB = (bf16*)(ws + WS_H); \
    bf16* KHp = (bf16*)(ws + WS_KHP); bf16* QHp = (bf16*)(ws + WS_QHP); bf16* VTp = (bf16*)(ws + WS_VTP); \
    bf16* KHs = (bf16*)(ws + WS_KHS); bf16* QHs = (bf16*)(ws + WS_QHS); bf16* VTs = (bf16*)(ws + WS_VTS); bf16* AO = (bf16*)(ws + WS_AO); \
    (void)Win_t; (void)Wout_t; (void)Wf1_t; (void)Wf2_t; (void)Wkq_t; (void)Wv_t; (void)Wo_t; (void)XN; (void)Z; (void)XBC; (void)DT; (void)SSQ; (void)MB; (void)HB; \
    (void)KHp; (void)QHp; (void)VTp; (void)KHs; (void)QHs; (void)VTs; (void)AO;
#define AIN(k) (ap_->in[k])
    LAS unsigned char* L = (LAS unsigned char*)lds;
    volatile LAS unsigned* MISC = (volatile LAS unsigned*)(L + MISC_OFF);
    if (wave_s == 0) MISC[fresh_lane()] = 0u;
    __syncthreads();
    const XcdBarrier xbar = xcd_barrier_post((unsigned*)(a.ws + WS_CTL) + 4096, MISC, wave_s);
#if PROF_K >= 0
    int n_stamp = 0;
#endif
#if PROF_K >= 0
#define STAMP() do { if (is_thread0(wave_s) && n_stamp < 24) ((volatile LAS unsigned long long*)(MISC + 8))[n_stamp] = __builtin_amdgcn_s_memrealtime(); ++n_stamp; } while (0)
#else
#define STAMP() do { } while (0)
#endif
#define GRID_BAR() do { xcd_barrier(xbar, wave_s); STAMP(); } while (0)
    STAMP();

    {
        PHASE_IDS PHASE_PTRS
        LAS float* scr = (LAS float*)(L + wave * 16384);
        constexpr float C2 = 0.125f * 1.4426950408889634f;
        constexpr int I_IN = (INPROJ_PAD / 32) * (DM / 64);
        constexpr int I_OUT = (DM / 32) * (DI / 64);
        constexpr int I_F1 = (FF2 / 32) * (DM / 64);
        constexpr int I_F2 = (DM / 32) * (FF / 64);
        constexpr int I_KQ = (2048 / 32) * (DM / 64);
        constexpr int I_V = (DM / 32) * (DM / 64);
        constexpr int NITEMS = I_IN + I_OUT + 2 * I_F1 + 2 * I_F2 + I_KQ + 2 * I_V;
        for (int it = gw; it < NITEMS; it += NGW) {
            int r = it;
            if (r < I_IN) { const int rb = r / 16, kb = r % 16, r0 = rb * 32; tr_item(ap_->in[7], INPROJ, DM, Win_t, r0, r0 < INPROJ ? r0 : -1, kb * 64, norm_w, 1.f, scr, lane); continue; } r -= I_IN;
            if (r < I_OUT) { const int rb = r / 32, kb = r % 32, r0 = rb * 32; tr_item(ap_->in[14], DM, DI, Wout_t, r0, r0, kb * 64, ap_->in[13], 1.f, scr, lane); continue; } r -= I_OUT;
            if (r < 2 * I_F1) { const int l = r / I_F1; r -= l * I_F1; const int rb = r / 16, kb = r % 16, r0 = rb * 32;
                const int c0 = ((r0 >> 7) & 1) * FF + (r0 >> 8) * 128 + (r0 & 127);
                tr_item(ap_->in[20] + (size_t)l * DM * FF2, FF2, DM, Wf1_t + (size_t)l * FF2 * DM, r0, c0, kb * 64, norm_w + (l * 4 + 2) * DM, 1.f, scr, lane); continue; } r -= 2 * I_F1;
            if (r < 2 * I_F2) { const int l = r / I_F2; r -= l * I_F2; const int rb = r / 44, kb = r % 44, r0 = rb * 32;
                tr_item(ap_->in[21] + (size_t)l * FF * DM, DM, FF, Wf2_t + (size_t)l * DM * FF, r0, r0, kb * 64, nullptr, 1.f, scr, lane); continue; } r -= 2 * I_F2;
            if (r < I_KQ) { const int rb = r / 16, kb = r % 16, r0 = rb * 32;
                if (r0 < 1024) tr_item(ap_->in[16], 2048, DM, Wkq_t, r0, r0, kb * 64, ap_->in[15], 1.f, scr, lane);
                else tr_item(ap_->in[17], DM, DM, Wkq_t, r0, r0 - 1024, kb * 64, norm_w + 4 * DM, C2, scr, lane);
                continue; } r -= I_KQ;
            if (r < I_V) { const int rb = r / 16, kb = r % 16, r0 = rb * 32; tr_item(ap_->in[16], 2048, DM, Wv_t, r0, 1024 + r0, kb * 64, ap_->in[15], 1.f, scr, lane); continue; } r -= I_V;
            { const int rb = r / 16, kb = r % 16, r0 = rb * 32; tr_item(ap_->in[19], DM, DM, Wo_t, r0, r0, kb * 64, nullptr, 1.f, scr, lane); }
        }
        for (int m = 2 * gw; m < TT; m += 2 * NGW) rms_row2_to_bf16(m < TP ? x_p + (size_t)m * DM : x_s + (size_t)(m - TP) * DM, XN + (size_t)m * DM, lane);
        for (size_t i = gtid; i < (size_t)TT * 4; i += gsz) SSQ[i] = 0.f;
    }
    __syncthreads();
    grid.sync(); STAMP();

    {
        PHASE_PTRS
        pg8::Gemm g{XN, Win_t, TT, INPROJ_PAD, DM, DM}; pg8::StaticOrder S; S.init(TT, INPROJ_PAD, G, bx);
        EpiInProj E{Z, XBC, DT, out};
        pg8::gemm_phase<EpiInProj, pg8::StaticOrder, true, true>(L, g, S, E, wave_s);
    }
    GRID_BAR();

#if PROF_K >= 0
    unsigned long long pt_last = 0ull, pt_acc0 = 0ull, pt_acc1 = 0ull, pt_acc2 = 0ull, pt_acc3 = 0ull;
#define PROF_T(k) do { const unsigned long long t_ = __builtin_amdgcn_s_memrealtime(); \
        if ((k) == 1) pt_acc0 += t_ - pt_last; else if ((k) == 2) pt_acc1 += t_ - pt_last; else if ((k) == 3) pt_acc2 += t_ - pt_last; else if ((k) == 4) pt_acc3 += t_ - pt_last; pt_last = t_; } while (0)
#define PROF_RESET() do { if (PROF_K < 70) { pt_acc0 = 0ull; pt_acc1 = 0ull; pt_acc2 = 0ull; pt_acc3 = 0ull; } } while (0)
#define PROF_TA(k) do { if (PROF_K < 70) PROF_T(k); } while (0)
#else
#define PROF_TA(k) do { } while (0)
#define PROF_T(k) do { } while (0)
#define PROF_RESET() do { } while (0)
#endif
    {
        PHASE_IDS PHASE_PTRS
        LAS bf16* XT = (LAS bf16*)(L + S_XT); LAS bf16* BT = (LAS bf16*)(L + S_BT); LAS bf16* BN = (LAS bf16*)(L + S_BN); LAS bf16* CN = (LAS bf16*)(L + S_CN);
        LAS float* CBs = (LAS float*)(L + S_CB); LAS bf16* HS = (LAS bf16*)(L + S_HS);
        LAS float* dtS = (LAS float*)(L + S_DT); LAS float* cumS = (LAS float*)(L + S_CUM); LAS float* wS = (LAS float*)(L + S_W); LAS float* cendS = (LAS float*)(L + S_CEND);
        const float* conv_w = ap_->in[8]; const float* conv_b = ap_->in[9]; const float* dt_bias = ap_->in[10]; const float* A_log = ap_->in[11]; const float* Dskip = ap_->in[12];
        const float* state_ssm = ap_->in[2]; const float* state_conv = ap_->in[3];
        const int fr = lane & 15, fq = lane >> 4, hh = wave >> 2, qd = wave & 3;
        for (int wi = bx; wi < 512; wi += G) {
            const bool smp = wi >= 256;
            const int xq = wi & 7, kq = (wi >> 3) & 31, sidx = xq * 8 + (kq >> 2), sq = sidx >> 2, grp = sidx & 3, hp = grp * 4 + (kq & 3), h0 = 2 * hp, h = h0 + hh;
            const int nchunk = smp ? 1 : 32;
            const size_t row_base = smp ? (size_t)TP + sq * 64 : (size_t)sq * 2048;
            const float Dh = Dskip[h];
            f32x4 sacc[2][4];
#pragma unroll
            for (int n2 = 0; n2 < 2; ++n2)
#pragma unroll
                for (int pt = 0; pt < 4; ++pt) {
                    const int p = 16 * pt + fr, n = 32 * qd + 16 * n2 + 4 * fq;
                    sacc[n2][pt] = smp ? *(const GAS f32x4*)(state_ssm + ((size_t)((sq * NH + h) * 64 + p)) * 128 + n) : (f32x4){0.f, 0.f, 0.f, 0.f};
                    v2u w; w.x = pk2(sacc[n2][pt][0], sacc[n2][pt][1]); w.y = pk2(sacc[n2][pt][2], sacc[n2][pt][3]);
                    *(LAS v2u*)(HS + (hh * 64 + p) * 136 + n) = w;
                }
            unsigned raw[3][11]; float dtraw = 0.f;
#define SSD_LOAD(c) do { \
              \
              \
            const __amdgpu_buffer_rsrc_t xr_ = __builtin_amdgcn_make_buffer_rsrc((void*)(XBC - 3 * CONVD), 0, (int)((size_t)(TT + 3) * CONVD * 2), 0x00020000); \
            _Pragma("unroll") for (int i = 0; i < 3; ++i) { const int it = SSD_TID + 512 * i, cp = it % 192; const int sb = __builtin_amdgcn_readfirstlane(it / 192); \
                const int col = cp < 64 ? h0 * 64 + 2 * cp : (cp < 128 ? DI + grp * 128 + 2 * (cp - 64) : DI + 512 + grp * 128 + 2 * (cp - 128)); \
                const int so0 = ((int)row_base + 64 * (c) + 8 * sb) * (CONVD * 2); \
                _Pragma("unroll") for (int r = 0; r < 11; ++r) raw[i][r] = __builtin_amdgcn_raw_buffer_load_b32(xr_, col * 2, so0 + r * (CONVD * 2), 0); } \
            if (wave < 2) dtraw = DT[(row_base + 64 * (c) + lane) * 32 + h0 + wave]; } while (0)
#define SSD_TID tid
            SSD_LOAD(0);
#undef SSD_TID
#define SSD_TID tidc
            if (!smp && tid < 192) { raw[0][0] = 0u; raw[0][1] = 0u; raw[0][2] = 0u; }
            if (smp && tid < 192) {
                const int cp = tid; const int col = cp < 64 ? h0 * 64 + 2 * cp : (cp < 128 ? DI + grp * 128 + 2 * (cp - 64) : DI + 512 + grp * 128 + 2 * (cp - 128));
#pragma unroll
                for (int r = 0; r < 3; ++r) { const float* sc = state_conv + (size_t)(sq * 3 + r) * CONVD + col; raw[0][r] = pk2(sc[0], sc[1]); } }
            for (int c = 0; c < nchunk; ++c) {
                PROF_T(0);
                int frc = fr, fqc = fq, tidc = tid; asm volatile("" : "+v"(frc), "+v"(fqc), "+v"(tidc));
                const float* cw_ = conv_w; const float* cb_ = conv_b; asm volatile("" : "+s"(cw_), "+s"(cb_));
#pragma unroll
                for (int i = 0; i < 3; ++i) { const int it = tidc + 512 * i, cp = it % 192, sb = it / 192, typ = cp >> 6, cl = 2 * (cp & 63);
                    const int col = cp < 64 ? h0 * 64 + 2 * cp : (cp < 128 ? DI + grp * 128 + 2 * (cp - 64) : DI + 512 + grp * 128 + 2 * (cp - 128));
                    float w0[4], w1[4];
#pragma unroll
                    for (int k = 0; k < 4; ++k) { w0[k] = cw_[k * CONVD + col]; w1[k] = cw_[k * CONVD + col + 1]; }
                    const float b0 = cb_[col], b1 = cb_[col + 1];
                    float o0[8], o1[8];
#pragma unroll
                    for (int s = 0; s < 8; ++s) { float a0 = b0, a1 = b1;
#pragma unroll
                        for (int k = 0; k < 4; ++k) { const unsigned uu = raw[i][s + k]; a0 += w0[k] * bflo(uu); a1 += w1[k] * bfhi(uu); }
                        o0[s] = silu_f(a0); o1[s] = silu_f(a1); }
                    if (typ == 0) { *(LAS bf16x8*)(XT + cl * 72 + 8 * sb) = pack8(o0); *(LAS bf16x8*)(XT + (cl + 1) * 72 + 8 * sb) = pack8(o1); }
                    else if (typ == 1) { *(LAS bf16x8*)(BT + cl * 72 + 8 * sb) = pack8(o0); *(LAS bf16x8*)(BT + (cl + 1) * 72 + 8 * sb) = pack8(o1);
#pragma unroll
                        for (int s = 0; s < 8; ++s) *(LAS unsigned*)(BN + (8 * sb + s) * 136 + cl) = pk2(o0[s], o1[s]); }
                    else {
#pragma unroll
                        for (int s = 0; s < 8; ++s) *(LAS unsigned*)(CN + (8 * sb + s) * 136 + cl) = pk2(o0[s], o1[s]); }
                }
                if (wave < 2) { const int hd = h0 + wave;
                    const float xx = dtraw + dt_bias[hd];
                    const float dtv = fmaxf(xx, 0.f) + __logf(1.f + __expf(-fabsf(xx)));
                    const float Ah = -__expf(A_log[hd]);
                    const float cum = wave_scan_incl(dtv * Ah);
                    const float cend = __builtin_bit_cast(float, __builtin_amdgcn_readlane(__builtin_bit_cast(int, cum), 63));
                    dtS[wave * 64 + lane] = dtv; cumS[wave * 64 + lane] = cum; wS[wave * 64 + lane] = dtv * __expf(cend - cum);
                    if (lane == 63) cendS[wave] = cend; }
                __syncthreads();
                PROF_T(1);
                if (c + 1 < nchunk) SSD_LOAD(c + 1);
                v2u zpre[4];
                { const size_t mz = row_base + 64 * c + 16 * qd + frc; const bf16* zp0 = Z + mz * DI + h * 64 + 4 * fqc;
#pragma unroll
                  for (int pt = 0; pt < 4; ++pt) zpre[pt] = *(const GAS v2u*)(zp0 + 16 * pt); }
                PROF_T(2);
                bf16x8 xt[4][2];
#pragma unroll
                for (int pt = 0; pt < 4; ++pt)
#pragma unroll
                    for (int ks = 0; ks < 2; ++ks) xt[pt][ks] = *(const LAS bf16x8*)(XT + (hh * 64 + 16 * pt + frc) * 72 + 8 * fqc + 32 * ks);
                { f32x4 yacc[4], cbacc[4];
#pragma unroll
                    for (int pt = 0; pt < 4; ++pt) { yacc[pt] = (f32x4){0.f, 0.f, 0.f, 0.f}; cbacc[pt] = (f32x4){0.f, 0.f, 0.f, 0.f}; }
                    const int q = 16 * qd + frc;
#pragma unroll
                    for (int ks = 0; ks < 4; ++ks) { const bf16x8 bfr = *(const LAS bf16x8*)(CN + q * 136 + 8 * fqc + 32 * ks);
#pragma unroll
                        for (int pt = 0; pt < 4; ++pt) { const bf16x8 af = *(const LAS bf16x8*)(HS + (hh * 64 + 16 * pt + frc) * 136 + 8 * fqc + 32 * ks); yacc[pt] = MFMA16(af, bfr, yacc[pt]); }
#pragma unroll
                        for (int st = 0; st < 4; ++st) { const bf16x8 af = *(const LAS bf16x8*)(BN + (16 * st + frc) * 136 + 8 * fqc + 32 * ks); cbacc[st] = MFMA16(af, bfr, cbacc[st]); } }
                    const float cq = cumS[hh * 64 + q]; const float eq = __expf(cq);
#pragma unroll
                    for (int pt = 0; pt < 4; ++pt) yacc[pt] = yacc[pt] * eq;
#pragma unroll
                    for (int ks = 0; ks < 2; ++ks) {
                        float mv[8];
#pragma unroll
                        for (int hf = 0; hf < 2; ++hf) { const int s0 = 16 * (2 * ks + hf) + 4 * fqc;
                            const f32x4 cs = *(const LAS f32x4*)(cumS + hh * 64 + s0), dd = *(const LAS f32x4*)(dtS + hh * 64 + s0); const f32x4 cb = cbacc[2 * ks + hf];
#pragma unroll
                            for (int e = 0; e < 4; ++e) { const int s = s0 + e; float t = cb[e] * __expf(fminf(cq - cs[e], 0.f)) * dd[e]; t = (s <= q) ? t : 0.f; if (s == q) t += Dh; mv[4 * hf + e] = t; } }
                        const bf16x8 mf = pack8(mv);
#pragma unroll
                        for (int pt = 0; pt < 4; ++pt) { const LAS bf16* xp = XT + (hh * 64 + 16 * pt + frc) * 72 + 32 * ks + 4 * fqc;
                            const v2u x0 = *(const LAS v2u*)xp, x1 = *(const LAS v2u*)(xp + 16); const v4u xa = {x0.x, x0.y, x1.x, x1.y};
                            yacc[pt] = MFMA16(__builtin_bit_cast(bf16x8, xa), mf, yacc[pt]); } }
                    const size_t m = row_base + 64 * c + q;
                    bf16* zp = Z + m * DI + h * 64 + 4 * fqc; float ss = 0.f;
#pragma unroll
                    for (int pt = 0; pt < 4; ++pt) { const v2u zz = zpre[pt];
                        const float y0 = yacc[pt][0] * silu_f(bflo(zz.x)), y1 = yacc[pt][1] * silu_f(bfhi(zz.x)), y2 = yacc[pt][2] * silu_f(bflo(zz.y)), y3 = yacc[pt][3] * silu_f(bfhi(zz.y));
                        ss += (y0 * y0 + y1 * y1) + (y2 * y2 + y3 * y3);
                        v2u o; o.x = pk2(y0, y1); o.y = pk2(y2, y3); *(GAS v2u*)(zp + 16 * pt) = o; }
                    ss += __shfl_xor(ss, 16); ss += __shfl_xor(ss, 32);
                    if (fqc == 0) atomicAdd(SSQ + m * 4 + grp, ss);
                }
                PROF_T(3);
                { const float dec = __expf(cendS[hh]);
#pragma unroll
                    for (int n2 = 0; n2 < 2; ++n2)
#pragma unroll
                        for (int pt = 0; pt < 4; ++pt) sacc[n2][pt] = sacc[n2][pt] * dec;
#pragma unroll
                    for (int ks = 0; ks < 2; ++ks) { const int s0 = 8 * fqc + 32 * ks;
                        const f32x4 w0 = *(const LAS f32x4*)(wS + hh * 64 + s0), w1 = *(const LAS f32x4*)(wS + hh * 64 + s0 + 4);
#pragma unroll
                        for (int n2 = 0; n2 < 2; ++n2) { const v4u rw = *(const LAS v4u*)(BT + (32 * qd + 16 * n2 + frc) * 72 + s0);
                            float bv[8]; bv[0] = bflo(rw.x) * w0[0]; bv[1] = bfhi(rw.x) * w0[1]; bv[2] = bflo(rw.y) * w0[2]; bv[3] = bfhi(rw.y) * w0[3];
                            bv[4] = bflo(rw.z) * w1[0]; bv[5] = bfhi(rw.z) * w1[1]; bv[6] = bflo(rw.w) * w1[2]; bv[7] = bfhi(rw.w) * w1[3];
                            const bf16x8 af = pack8(bv);
#pragma unroll
                            for (int pt = 0; pt < 4; ++pt) sacc[n2][pt] = MFMA16(af, xt[pt][ks], sacc[n2][pt]); } }
                }
                __syncthreads();
                PROF_T(4);
#pragma unroll
                for (int n2 = 0; n2 < 2; ++n2)
#pragma unroll
                    for (int pt = 0; pt < 4; ++pt) { v2u w; w.x = pk2(sacc[n2][pt][0], sacc[n2][pt][1]); w.y = pk2(sacc[n2][pt][2], sacc[n2][pt][3]);
                        *(LAS v2u*)(HS + (hh * 64 + 16 * pt + frc) * 136 + 32 * qd + 16 * n2 + 4 * fqc) = w; }
            }
#undef SSD_LOAD
#undef SSD_TID
            { float* so = out + (smp ? O_SSM_S : O_SSM_P);
#pragma unroll
                for (int n2 = 0; n2 < 2; ++n2)
#pragma unroll
                    for (int pt = 0; pt < 4; ++pt) *(GAS f32x4*)(so + ((size_t)((sq * NH + h) * 64 + 16 * pt + fr)) * 128 + 32 * qd + 16 * n2 + 4 * fq) = sacc[n2][pt]; }
        }
    }
    GRID_BAR();

#define GEMM1024_NORM(EPI, EPIARGS_P, EPIARGS_S, APTR, BTPTR, KDIM, FIRST, LAST, WPOST, SPLIT, SEAM) do { \
        { PHASE_PTRS pg8::Gemm g{(APTR), (BTPTR), TP, DM, (KDIM), (KDIM)}; pg8::StaticOrder S; S.init(TP, DM, G, bx); EPI E EPIARGS_P; \
          pg8::gemm_phase<EPI, pg8::StaticOrder, true, true>(L, g, S, E, wave_s); } \
        GRID_BAR(); \
        const int nsw = (SPLIT) ? 32 : 16;          \
        if (bx < nsw) { \
          { PHASE_PTRS \
          if (SPLIT) { pg8::Gemm g{(APTR) + (size_t)TP * (KDIM), (BTPTR), TS, DM, (KDIM) / 2, (KDIM)}; pg8::SplitOrder2 S{bx, (long)(KDIM)}; EpiSlab E{SLAB}; \
            pg8::gemm_phase<EpiSlab, pg8::SplitOrder2, true, true>(L, g, S, E, wave_s); } \
          else { pg8::Gemm g{(APTR) + (size_t)TP * (KDIM), (BTPTR), TS, DM, (KDIM), (KDIM)}; pg8::StaticOrder S; S.init(TS, DM, G, bx); EPI E EPIARGS_S; \
            pg8::gemm_phase<EPI, pg8::StaticOrder, true, true>(L, g, S, E, wave_s); } } \
            \
          { PHASE_IDS PHASE_PTRS \
            asm volatile("s_waitcnt vmcnt(0)" ::: "memory"); __syncthreads(); \
            if (tid == 0) { unsigned* cnt = (unsigned*)(ws + WS_CTL) + 8192 + 64 * (SEAM); \
              __builtin_amdgcn_fence(__ATOMIC_RELEASE, "agent"); asm volatile("s_waitcnt vmcnt(0)" ::: "memory"); \
              __hip_atomic_fetch_add(cnt, 1u, __ATOMIC_RELAXED, __HIP_MEMORY_SCOPE_AGENT); } } } \
        else { PHASE_IDS PHASE_PTRS const int gw2 = (bx - nsw) * NWAVES + wave, NGW2 = (G - nsw) * NWAVES; \
          for (int m = 2 * gw2; m < TP; m += 2 * NGW2) norm_row2(MB + (size_t)m * DM, nullptr, (FIRST) ? x_p + (size_t)m * DM : nullptr, XN + (size_t)m * DM, SQ + m, (LAST) ? out + O_Y + (size_t)m * DM : nullptr, (WPOST), lane); \
            \
          if (tid == 0) { unsigned* cnt = (unsigned*)(ws + WS_CTL) + 8192 + 64 * (SEAM); unsigned sp = 0; \
            while (__hip_atomic_load(cnt, __ATOMIC_RELAXED, __HIP_MEMORY_SCOPE_AGENT) < (unsigned)nsw) { __builtin_amdgcn_s_sleep(2); if (++sp > (1u << 22)) break; } \
            __builtin_amdgcn_fence(__ATOMIC_ACQUIRE, "agent"); asm volatile("s_waitcnt vmcnt(0)" ::: "memory"); } \
          __syncthreads(); \
          for (int m = TP + 2 * gw2; m < TT; m += 2 * NGW2) norm_row2(MB + (size_t)m * DM, (SPLIT) ? SLAB + (size_t)(m - TP) * DM : nullptr, (FIRST) ? x_s + (size_t)(m - TP) * DM : nullptr, XN + (size_t)m * DM, SQ + m, (LAST) ? out + O_Y + (size_t)m * DM : nullptr, (WPOST), lane); } \
    } while (0)
    GEMM1024_NORM(EpiOutProj, ({MB, DM, SSQ}), ({MB + (size_t)TP * DM, DM, SSQ + (size_t)TP * 4}), Z, Wout_t, DI, true, false, norm_w + 1 * DM, false, 0);
    GRID_BAR();

    { constexpr int layer = 0;
        { PHASE_PTRS pg8::Gemm g{XN, Wf1_t + (size_t)layer * FF2 * DM, TT, FF2, DM, DM}; pg8::StaticOrder S; S.init(TT, FF2, G, bx); EpiSwiGLU E{HB};
          pg8::gemm_phase<EpiSwiGLU, pg8::StaticOrder, true, true>(L, g, S, E, wave_s); }
        GRID_BAR();
        GEMM1024_NORM(EpiPlain, ({MB, DM}), ({MB + (size_t)TP * DM, DM}), HB, Wf2_t + (size_t)layer * DM * FF, FF, false, layer == 1, norm_w + (layer * 4 + 3) * DM, true, 2 + layer);
        if (layer == 0) GRID_BAR();
        }
    { constexpr int layer = 1;
        {
            { PHASE_PTRS pg8::Gemm g{XN, Wkq_t, TT, 2048, DM, DM};
              pg8::KqvtOrder S; S.G = G; S.c = bx; S.dA = (const char*)Wv_t - (const char*)XN; S.dB = (const char*)XN - (const char*)Wkq_t;
              EpiKQVT E{{KHp, QHp, KHs, QHs, out}, {VTp, VTs, out}, (float*)MB};
              pg8::gemm_phase<EpiKQVT, pg8::KqvtOrder, true, true>(L, g, S, E, wave_s); }
            GRID_BAR();
            {
                PHASE_IDS PHASE_PTRS
                LAS bf16* KsB = (LAS bf16*)L;
                LAS bf16* VsB = (LAS bf16*)(L + 18432);
                LAS float* biasL = (LAS float*)(L + 36864);
                PROF_RESET();
                const float* rel_bias = ap_->in[18];
                for (int i = tid; i < AH * 641; i += NTHREADS) { const int h = i / 641, j = i - h * 641; biasL[i] = rel_bias[h * 513 + (j > 512 ? 512 : j)] * 1.4426950408889634f; }
                __syncthreads();
                const int r32 = lane & 31, hi = lane >> 5;
                const int krow = (r32 & 0x13) | ((r32 & 4) << 1) | ((r32 & 8) >> 1);
                const int srow = tid >> 3, sch = tid & 7;
#define ATTN_DECODE(P, uu) const bool P##smp = (uu) >= 2048; const int P##idx = (uu) & 255, P##b = P##idx >> 4, P##hd = P##idx & 15, P##c0 = P##smp ? 8 : 4 * ((uu) >> 8); \
                const int P##kt_lo = P##c0 > 8 ? P##c0 - 8 : 0, P##Lk = P##smp ? SKV : 2048; \
                const bf16* P##KHb = P##smp ? KHs + (size_t)((P##b * AH + P##hd) * SKV) * 64 : KHp + (size_t)((P##b * AH + P##hd) * 2048) * 64; \
                const bf16* P##VTb = P##smp ? VTs + (size_t)((P##b * AH + P##hd) * 64) * SKV : VTp + (size_t)((P##b * AH + P##hd) * 64) * 2048; \
                const int P##pos0 = P##smp ? 32 * (wave & 1) : 64 * P##c0 + 32 * wave; \
                const bf16* P##Qb = P##smp ? QHs + (size_t)((P##b * AH + P##hd) * 64 + P##pos0) * 64 : QHp + (size_t)((P##b * AH + P##hd) * 2048 + P##pos0) * 64;
                { const float* cache_k = ap_->in[4]; const float* cache_v = ap_->in[5];
                  for (int u = bx; u < 2304; u += G) if (u >= 2048) { const int idx = u & 255, b = idx >> 4, hd = idx & 15;
                      { const int d8 = tid & 7, r0 = tid >> 3; f32x4 kv[8][2]; float vv[4][8];
#pragma unroll
                        for (int it = 0; it < 8; ++it) { const float* s = cache_k + ((size_t)((b * 512 + r0 + 64 * it) * 16 + hd)) * 64 + 8 * d8;
                            kv[it][0] = __builtin_nontemporal_load((const GAS f32x4*)s); kv[it][1] = __builtin_nontemporal_load((const GAS f32x4*)(s + 4)); }
#pragma unroll
                        for (int j = 0; j < 4; ++j)
#pragma unroll
                            for (int e = 0; e < 8; ++e) vv[j][e] = __builtin_nontemporal_load((const GAS float*)(cache_v + ((size_t)((b * 512 + 8 * (wave + 8 * j) + e) * 16 + hd)) * 64 + lane));
#pragma unroll
                        for (int it = 0; it < 8; ++it) { const f32x4 v0 = kv[it][0], v1 = kv[it][1];
                            v4u w; w.x = pk2(v0[0], v0[1]); w.y = pk2(v0[2], v0[3]); w.z = pk2(v1[0], v1[1]); w.w = pk2(v1[2], v1[3]);
                            *(GAS v4u*)(KHs + ((size_t)((b * AH + hd) * SKV + r0 + 64 * it)) * 64 + 8 * d8) = w; }
#pragma unroll
                        for (int j = 0; j < 4; ++j) { v4u w; w.x = pk2(vv[j][0], vv[j][1]); w.y = pk2(vv[j][2], vv[j][3]); w.z = pk2(vv[j][4], vv[j][5]); w.w = pk2(vv[j][6], vv[j][7]);
                            *(GAS v4u*)(VTs + ((size_t)((b * AH + hd) * 64 + lane)) * SKV + 8 * (wave + 8 * j)) = w; } }
                      { const float* sl = (const float*)MB; const int r = tid >> 3, c8 = tid & 7; float vv[4][8];
                        const float* pk = sl + (size_t)(b * 64 + r) * 3072 + hd * 64 + 8 * c8; const float* pv = sl + (size_t)(hd * 64 + r) * 3072 + 2048 + b * 64 + 8 * c8;
                        f32x4 sk[4][2], sq4[4][2], sv[4][2];
#pragma unroll
                        for (int j = 0; j < 4; ++j)
#pragma unroll
                            for (int e = 0; e < 8; ++e) vv[j][e] = __builtin_nontemporal_load((const GAS float*)(cache_v + ((size_t)((b * 512 + 8 * (wave + 8 * (j + 4)) + e) * 16 + hd)) * 64 + lane));
#pragma unroll
                        for (int s4 = 0; s4 < 4; ++s4) { const float* a = pk + s4 * KQS_SLAB; const float* c = pv + s4 * KQS_SLAB;
                            sk[s4][0] = *(const GAS f32x4*)a; sk[s4][1] = *(const GAS f32x4*)(a + 4); sq4[s4][0] = *(const GAS f32x4*)(a + 1024); sq4[s4][1] = *(const GAS f32x4*)(a + 1028);
                            sv[s4][0] = *(const GAS f32x4*)c; sv[s4][1] = *(const GAS f32x4*)(c + 4); }
#pragma unroll
                        for (int j = 0; j < 4; ++j) { v4u w; w.x = pk2(vv[j][0], vv[j][1]); w.y = pk2(vv[j][2], vv[j][3]); w.z = pk2(vv[j][4], vv[j][5]); w.w = pk2(vv[j][6], vv[j][7]);
                            *(GAS v4u*)(VTs + ((size_t)((b * AH + hd) * 64 + lane)) * SKV + 8 * (wave + 8 * (j + 4))) = w; }
                        const f32x4 k0 = (sk[0][0] + sk[1][0]) + (sk[2][0] + sk[3][0]), k1 = (sk[0][1] + sk[1][1]) + (sk[2][1] + sk[3][1]);
                        const f32x4 q0 = (sq4[0][0] + sq4[1][0]) + (sq4[2][0] + sq4[3][0]), q1 = (sq4[0][1] + sq4[1][1]) + (sq4[2][1] + sq4[3][1]);
                        const f32x4 v0 = (sv[0][0] + sv[1][0]) + (sv[2][0] + sv[3][0]), v1 = (sv[0][1] + sv[1][1]) + (sv[2][1] + sv[3][1]);
                        v4u w; w.x = pk2(k0[0], k0[1]); w.y = pk2(k0[2], k0[3]); w.z = pk2(k1[0], k1[1]); w.w = pk2(k1[2], k1[3]);
                        *(GAS v4u*)(KHs + ((size_t)((b * AH + hd) * SKV + 512 + r)) * 64 + 8 * c8) = w;
                        { float* o = out + O_CK_S + (size_t)(b * 64 + r) * 1024 + hd * 64 + 8 * c8; *(GAS f32x4*)o = k0; *(GAS f32x4*)(o + 4) = k1; }
                        w.x = pk2(q0[0], q0[1]); w.y = pk2(q0[2], q0[3]); w.z = pk2(q1[0], q1[1]); w.w = pk2(q1[2], q1[3]);
                        *(GAS v4u*)(QHs + ((size_t)((b * AH + hd) * 64 + r)) * 64 + 8 * c8) = w;
                        w.x = pk2(v0[0], v0[1]); w.y = pk2(v0[2], v0[3]); w.z = pk2(v1[0], v1[1]); w.w = pk2(v1[2], v1[3]);
                        *(GAS v4u*)(VTs + ((size_t)((b * AH + hd) * 64 + r)) * SKV + 512 + 8 * c8) = w;
                        LAS float* tt = (LAS float*)(L + 81920);
#pragma unroll
                        for (int e = 0; e < 4; ++e) { tt[(8 * c8 + e) * 65 + r] = v0[e]; tt[(8 * c8 + 4 + e) * 65 + r] = v1[e]; }
                        __syncthreads();
                        f32x4 o0, o1;
#pragma unroll
                        for (int e = 0; e < 4; ++e) { o0[e] = tt[r * 65 + 8 * c8 + e]; o1[e] = tt[r * 65 + 8 * c8 + 4 + e]; }
                        float* o = out + O_CV_S + (size_t)(b * 64 + r) * 1024 + hd * 64 + 8 * c8; *(GAS f32x4*)o = o0; *(GAS f32x4*)(o + 4) = o1; } }
                  asm volatile("s_waitcnt vmcnt(0)" ::: "memory"); __syncthreads(); }
                bf16x8 qf[4]; v4u kreg, vreg;
                { ATTN_DECODE(F, bx)
#pragma unroll
                  for (int ks = 0; ks < 4; ++ks) qf[ks] = *(const GAS bf16x8*)(FQb + r32 * 64 + 8 * hi + 16 * ks);
                  kreg = *(const GAS v4u*)(FKHb + (size_t)(64 * Fkt_lo + srow) * 64 + 8 * sch); vreg = *(const GAS v4u*)(FVTb + (size_t)srow * FLk + 64 * Fkt_lo + 8 * sch); }
                for (int u = bx; u < 2304; u += G) {
                    ATTN_DECODE(U, u)
                    const int kt_lo = Ukt_lo, kt_hi = Usmp ? 8 : Uc0 + 3, hd = Uhd;
                    const bool active = Usmp ? (wave < 2) : true; const int cw = Usmp ? 8 : Uc0 + (wave >> 1);
                    const size_t m0 = Usmp ? (size_t)TP + Ub * 64 + Upos0 : (size_t)Ub * 2048 + Upos0;
                    const int qloc = (Usmp ? 512 + Upos0 : Upos0) + r32;
                    const int kt_first = cw - 8 > kt_lo ? cw - 8 : kt_lo;
                    const bool hasN = u + G < 2304;
                    bf16x8 qn[4];
                    float m_run = 0.f, l_run = 0.f; f32x16 o0, o1;
#pragma unroll
                    for (int r = 0; r < 16; ++r) { o0[r] = 0.f; o1[r] = 0.f; }
                    *(LAS v4u*)(KsB + srow * 72 + 8 * sch) = kreg;
                    *(LAS v4u*)(VsB + srow * 72 + 8 * sch) = vreg;
                    __syncthreads();
                    if (hasN) { ATTN_DECODE(M, u + G)
#pragma unroll
                        for (int ks = 0; ks < 4; ++ks) qn[ks] = *(const GAS bf16x8*)(MQb + r32 * 64 + 8 * hi + 16 * ks); }
                    for (int kt = kt_lo; kt <= kt_hi; ++kt) {
                        PROF_TA(0);
                        const int buf = (kt - kt_lo) & 1;
                        if (kt < kt_hi) { kreg = *(const GAS v4u*)(UKHb + (size_t)(64 * (kt + 1) + srow) * 64 + 8 * sch); vreg = *(const GAS v4u*)(UVTb + (size_t)srow * ULk + 64 * (kt + 1) + 8 * sch); }
                        else if (hasN) {
                            ATTN_DECODE(N, u + G)
                            kreg = *(const GAS v4u*)(NKHb + (size_t)(64 * Nkt_lo + srow) * 64 + 8 * sch); vreg = *(const GAS v4u*)(NVTb + (size_t)srow * NLk + 64 * Nkt_lo + 8 * sch); (void)NQb; }
                        if (active && kt <= cw && kt + 8 >= cw) {
                            const LAS bf16* Ks = KsB + buf * (64 * 72); const LAS bf16* Vs = VsB + buf * (64 * 72);
                            f32x16 p0, p1; const float nm = -m_run; const int jj = cw - kt;
                            const bf16x8 a00 = *(const LAS bf16x8*)(Ks + krow * 72 + 8 * hi), a10 = *(const LAS bf16x8*)(Ks + (32 + krow) * 72 + 8 * hi);
                            if (jj >= 5) { const float bc = biasL[hd * 641 + 512] + nm; f32x16 bcv;
#pragma unroll
                                for (int r = 0; r < 16; ++r) bcv[r] = bc;
                                p0 = MFMA32(a00, qf[0], bcv); p1 = MFMA32(a10, qf[0], bcv); }
                            else { const int base = qloc - 64 * kt - 8 * hi + 256;
                                const LAS float* blp = biasL + hd * 641 + base - 63;
                                const f32x2_t nm2 = {nm, nm};
#define ATT_BINIT(r) { f32x2_t t0 = {blp[63 - (16 * ((r) >> 3) + ((r) & 7))], blp[62 - (16 * ((r) >> 3) + ((r) & 7))]}, t1 = {blp[31 - (16 * ((r) >> 3) + ((r) & 7))], blp[30 - (16 * ((r) >> 3) + ((r) & 7))]}; \
                                    t0 += nm2; t1 += nm2; p0[r] = t0[0]; p0[(r) + 1] = t0[1]; p1[r] = t1[0]; p1[(r) + 1] = t1[1]; }
                                ATT_BINIT(0) ATT_BINIT(2) ATT_BINIT(4) ATT_BINIT(6) ATT_BINIT(8) ATT_BINIT(10) ATT_BINIT(12) ATT_BINIT(14)
#undef ATT_BINIT
                                p0 = MFMA32(a00, qf[0], p0); p1 = MFMA32(a10, qf[0], p1); }
#pragma unroll
                            for (int ks = 1; ks < 4; ++ks) { const bf16x8 a0 = *(const LAS bf16x8*)(Ks + krow * 72 + 8 * hi + 16 * ks), a1 = *(const LAS bf16x8*)(Ks + (32 + krow) * 72 + 8 * hi + 16 * ks);
                                p0 = MFMA32(a0, qf[ks], p0); p1 = MFMA32(a1, qf[ks], p1); }
                            const bool first = (kt == kt_first);
                            if (first) {
                                asm volatile("s_nop 11" : "+v"(p0), "+v"(p1));
                                float mx = max3f_(p0[0], p1[0], p0[1]), mxb = max3f_(p1[1], p0[2], p1[2]);
#pragma unroll
                                for (int r = 3; r < 15; r += 2) { mx = max3f_(mx, p0[r], p1[r]); mxb = max3f_(mxb, p0[r + 1], p1[r + 1]); }
                                mx = max3f_(mx, mxb, p0[15]); mx = max3f_(mx, p1[15], p1[15]);
                                { const auto rr = __builtin_amdgcn_permlane32_swap(__builtin_bit_cast(unsigned, mx), __builtin_bit_cast(unsigned, mx), false, false);
                                  const float ma = __builtin_bit_cast(float, (unsigned)rr[0]), mb = __builtin_bit_cast(float, (unsigned)rr[1]); mx = max3f_(ma, mb, mb); }
                                m_run = mx;
#pragma unroll
                                for (int r = 0; r < 16; ++r) { p0[r] -= mx; p1[r] -= mx; } }
#pragma unroll
                            for (int r = 0; r < 16; ++r) { p0[r] = __builtin_amdgcn_exp2f(p0[r]); p1[r] = __builtin_amdgcn_exp2f(p1[r]); }
                            f32x2_t ls2 = __builtin_shufflevector(p0, p0, 0, 1) + __builtin_shufflevector(p1, p1, 0, 1);
#define ATT_PKSUM(r) ls2 += __builtin_shufflevector(p0, p0, r, r + 1); ls2 += __builtin_shufflevector(p1, p1, r, r + 1);
                            ATT_PKSUM(2) ATT_PKSUM(4) ATT_PKSUM(6) ATT_PKSUM(8) ATT_PKSUM(10) ATT_PKSUM(12) ATT_PKSUM(14)
#undef ATT_PKSUM
                            const float ls = ls2[0] + ls2[1]; l_run += ls;
                            bf16x8 pb[4];
                            { float t[8];
#pragma unroll
                              for (int j = 0; j < 8; ++j) t[j] = p0[j];
                              pb[0] = pack8(t);
#pragma unroll
                              for (int j = 0; j < 8; ++j) t[j] = p0[8 + j];
                              pb[1] = pack8(t);
#pragma unroll
                              for (int j = 0; j < 8; ++j) t[j] = p1[j];
                              pb[2] = pack8(t);
#pragma unroll
                              for (int j = 0; j < 8; ++j) t[j] = p1[8 + j];
                              pb[3] = pack8(t); }
#pragma unroll
                            for (int s4 = 0; s4 < 4; ++s4) {
                                const bf16x8 A0 = *(const LAS bf16x8*)(Vs + r32 * 72 + 16 * s4 + 8 * hi), A1 = *(const LAS bf16x8*)(Vs + (32 + r32) * 72 + 16 * s4 + 8 * hi);
                                o0 = MFMA32(A0, pb[s4], o0); o1 = MFMA32(A1, pb[s4], o1); }
                            if (!first && __any(ls > 256.f)) { const float dl = fmaxf(__builtin_amdgcn_logf(xor32_sum_(ls)), 0.f), alpha = __builtin_amdgcn_exp2f(-dl); m_run += dl; l_run *= alpha;
#pragma unroll
                                for (int r = 0; r < 16; ++r) { o0[r] *= alpha; o1[r] *= alpha; } }
                        }
                        PROF_TA(1);
                        if (kt < kt_hi) { LAS bf16* Kn = KsB + (buf ^ 1) * (64 * 72); LAS bf16* Vn = VsB + (buf ^ 1) * (64 * 72);
                            *(LAS v4u*)(Kn + srow * 72 + 8 * sch) = kreg;
                            *(LAS v4u*)(Vn + srow * 72 + 8 * sch) = vreg; }
                        PROF_TA(2);
                        __syncthreads();
                        PROF_TA(3);
                    }
                    if (active) {
                        const float inv = 1.f / xor32_sum_(l_run);
                        bf16* op = AO + (m0 + r32) * DM + hd * 64 + 4 * hi;
#pragma unroll
                        for (int r4 = 0; r4 < 4; ++r4) { v2u w; w.x = pk2(o0[4 * r4] * inv, o0[4 * r4 + 1] * inv); w.y = pk2(o0[4 * r4 + 2] * inv, o0[4 * r4 + 3] * inv); *(GAS v2u*)(op + 8 * r4) = w;
                            v2u w2; w2.x = pk2(o1[4 * r4] * inv, o1[4 * r4 + 1] * inv); w2.y = pk2(o1[4 * r4 + 2] * inv, o1[4 * r4 + 3] * inv); *(GAS v2u*)(op + 32 + 8 * r4) = w2; }
                    }
                    if (hasN) {
#pragma unroll
                        for (int ks = 0; ks < 4; ++ks) qf[ks] = qn[ks]; }
                }
#undef ATTN_DECODE
            }
            GRID_BAR();
            GEMM1024_NORM(EpiPlain, ({MB, DM}), ({MB + (size_t)TP * DM, DM}), AO, Wo_t, DM, false, false, norm_w + (4 + 1) * DM, false, 1);
            GRID_BAR();
        }
        { PHASE_PTRS pg8::Gemm g{XN, Wf1_t + (size_t)layer * FF2 * DM, TT, FF2, DM, DM}; pg8::StaticOrder S; S.init(TT, FF2, G, bx); EpiSwiGLU E{HB};
          pg8::gemm_phase<EpiSwiGLU, pg8::StaticOrder, true, true>(L, g, S, E, wave_s); }
        GRID_BAR();
        GEMM1024_NORM(EpiPlain, ({MB, DM}), ({MB + (size_t)TP * DM, DM}), HB, Wf2_t + (size_t)layer * DM * FF, FF, false, layer == 1, norm_w + (layer * 4 + 3) * DM, true, 2 + layer);
        if (layer == 0) GRID_BAR();
        }
#if PROF_K >= 0
    {
        PHASE_IDS PHASE_PTRS
        STAMP();
        LAS float* fs = (LAS float*)(L + MISC_OFF + 512);
        __syncthreads();
        if (tid == 0) { volatile LAS unsigned long long* ts = (volatile LAS unsigned long long*)(MISC + 8); const int k0 = PROF_K % 100;
            const unsigned long long d = (k0 == 50) ? ts[n_stamp - 1] - ts[0] : (k0 == 60 || k0 == 70) ? pt_acc0 : (k0 == 61 || k0 == 71) ? pt_acc1 : (k0 == 62 || k0 == 72) ? pt_acc2 : (k0 == 63 || k0 == 73) ? pt_acc3 : ts[k0 + 1] - ts[k0]; fs[0] = 1.f + (float)d * 0.01f * (PROF_K >= 100 ? 1e-4f : 5e-4f); }
        __syncthreads();
        const float f = fs[0];
        GRID_BAR();
        for (size_t i = gtid; i < 1048576; i += gsz) out[O_CV_S + i] *= f;
    }
#endif
}

extern "C" void kernel_launch(void* const* d_in, const int* in_sizes, int n_in, void* d_out, int out_size, void* d_ws, size_t ws_size, hipStream_t stream) {
    static int grid = 0;
    if (grid == 0) {
        int dev = 0, cus = 0, per_cu = 0;
        (void)hipGetDevice(&dev);
        (void)hipDeviceGetAttribute(&cus, hipDeviceAttributeMultiprocessorCount, dev);
        (void)hipFuncSetAttribute((const void*)mk_fwd, hipFuncAttributeMaxDynamicSharedMemorySize, LDS_BYTES);
        (void)hipOccupancyMaxActiveBlocksPerMultiprocessor(&per_cu, (const void*)mk_fwd, NTHREADS, LDS_BYTES);
        fprintf(stderr, "kernel_launch: cus %d per_cu %d ws_size %zu n_in %d out_size %d\n", cus, per_cu, ws_size, n_in, out_size);
        if (ws_size < WS_END3 || n_in != 22 || (size_t)out_size != O_TOTAL) { fprintf(stderr, "kernel_launch: unexpected sizes\n"); grid = -1; return; }
        grid = cus;
    }
    if (grid < 0) return;
    (void)hipMemsetAsync((char*)d_ws + WS_CTL, 0, 1 * MiB, stream);
    Args a{};
    for (int i = 0; i < 22; ++i) a.in[i] = (const float*)d_in[i];
    a.out = (float*)d_out; a.ws = (unsigned char*)d_ws; a.dbg = 0; a.pad = 0;
    void* args[] = {&a};
    hipError_t e = hipLaunchCooperativeKernel((const void*)mk_fwd, dim3(grid), dim3(NTHREADS), args, LDS_BYTES, stream);
    if (e != hipSuccess) fprintf(stderr, "cooperative launch failed: %s (grid %d)\n", hipGetErrorString(e), grid);
}
```
